# Optimizing an MI355X kernel written in HIP

```python
import math
import jax, jax.numpy as jnp
from jax import lax
import numpy as np

D_MODEL = 1024
BATCH = 8
SEQ = 4096
DEPTH = 2

N_HEADS = 16
HEAD_DIM = D_MODEL // N_HEADS
ROPE_DIM = HEAD_DIM // 4
ROPE_THETA = 500000.0
ATTN_SCALE = HEAD_DIM ** -0.5
DILATED_PAIRS = ((128, 1), (512, 4), (2048, 16))
N_DIL = len(DILATED_PAIRS)
BAND_BLOCK = 128
MOBA_BLOCK = 256
MOBA_TOPK = 3
MOBA_QCHUNK = 128
D_FF = 2816
CONV_WIDTH = 3
RMS_EPS = 1e-6
N_LAYERS_A = (DEPTH + 1) // 2
N_LAYERS_B = DEPTH // 2

kernel_name = "hybrid_dilated_moba_convffn"


def rmsnorm(x, gain):
    xf = x.astype(jnp.float32)
    y = xf * lax.rsqrt(jnp.mean(xf * xf, axis=-1, keepdims=True) + RMS_EPS)
    return (y * gain.astype(jnp.float32)).astype(x.dtype)


def rope_tables(seq_len):
    pos = jnp.arange(seq_len, dtype=jnp.float32)
    inv_freq = ROPE_THETA ** (-jnp.arange(0, ROPE_DIM, 2, dtype=jnp.float32) / ROPE_DIM)
    ang = pos[:, None] * inv_freq[None, :]
    return jnp.cos(ang), jnp.sin(ang)


def apply_partial_rope(x, cos, sin):
    extra = x.ndim - 3
    c = cos.reshape((cos.shape[0],) + (1,) * extra + (cos.shape[1],)).astype(x.dtype)
    s = sin.reshape((sin.shape[0],) + (1,) * extra + (sin.shape[1],)).astype(x.dtype)
    half = ROPE_DIM // 2
    x1, x2, xp = x[..., :half], x[..., half:ROPE_DIM], x[..., ROPE_DIM:]
    return jnp.concatenate([x1 * c - x2 * s, x2 * c + x1 * s, xp], axis=-1)


def band_attention(q, k, v, dil, window):
    S, H, hd = q.shape
    reach = window // dil
    assert reach <= BAND_BLOCK
    span = dil * BAND_BLOCK
    s_pad = -(-S // span) * span
    L = s_pad // dil
    nb = L // BAND_BLOCK

    def to_res(t):
        t = jnp.pad(t, ((0, s_pad - S), (0, 0), (0, 0)))
        return t.reshape(L, dil, H, hd).transpose(1, 0, 2, 3).reshape(dil, nb, BAND_BLOCK, H, hd)

    qr, kr, vr = to_res(q), to_res(k), to_res(v)

    def with_prev(t):
        prev = jnp.concatenate([jnp.zeros_like(t[:, :1]), t[:, :-1]], axis=1)
        return jnp.concatenate([prev, t], axis=2)

    kc, vc = with_prev(kr), with_prev(vr)
    scores = jnp.einsum('rnqhd,rnkhd->rnhqk', qr, kc).astype(jnp.float32) * ATTN_SCALE
    qi = jnp.arange(BAND_BLOCK)
    kj = jnp.arange(2 * BAND_BLOCK)
    dist = qi[:, None] + BAND_BLOCK - kj[None, :]
    kpos = jnp.arange(nb)[:, None] * BAND_BLOCK - BAND_BLOCK + kj[None, :]
    mask = ((dist >= 0) & (dist <= reach))[None] & (kpos >= 0)[:, None, :]
    scores = jnp.where(mask[None, :, None], scores, -jnp.inf)
    m = scores.max(axis=-1)
    p = jnp.exp(scores - m[..., None])
    den = p.sum(axis=-1)
    num = jnp.einsum('rnhqk,rnkhd->rnqhd', p, vc.astype(jnp.float32))
    m_t = m.transpose(0, 1, 3, 2)
    den_t = den.transpose(0, 1, 3, 2)
    o = num / den_t[..., None]

    def from_res(t):
        t = t.reshape((dil, L) + t.shape[3:])
        t = jnp.swapaxes(t, 0, 1)
        return t.reshape((s_pad,) + t.shape[2:])[:S]

    return from_res(o), from_res(m_t), from_res(den_t)


def mixer_dilated(h, w_qkv, q_gain, k_gain, w_o, cos, sin):
    B, S, _ = h.shape
    qkv = (h @ w_qkv).reshape(B, S, 3, N_DIL, N_HEADS, HEAD_DIM)
    q = apply_partial_rope(rmsnorm(qkv[:, :, 0], q_gain[:, None, :]), cos, sin)
    k = apply_partial_rope(rmsnorm(qkv[:, :, 1], k_gain[:, None, :]), cos, sin)
    v = qkv[:, :, 2]

    def one_sequence(args):
        qb, kb, vb = args
        outs, maxes, dens = [], [], []
        for g, (window, dil) in enumerate(DILATED_PAIRS):
            o, m, d = band_attention(qb[:, g], kb[:, g], vb[:, g], dil, window)
            outs.append(o)
            maxes.append(m)
            dens.append(d)
        o = jnp.stack(outs)
        m = jnp.stack(maxes)
        d = jnp.stack(dens)
        wgt = d * jnp.exp(m - m.max(axis=0, keepdims=True))
        wgt = wgt / wgt.sum(axis=0, keepdims=True)
        return jnp.einsum('gsh,gshd->shd', wgt, o)

    attn = lax.map(one_sequence, (q, k, v))
    return attn.reshape(B, S, N_HEADS * HEAD_DIM).astype(h.dtype) @ w_o


def mixer_moba(h, w_qkv, q_gain, k_gain, w_o, cos, sin):
    B, S, _ = h.shape
    qkv = (h @ w_qkv).reshape(B, S, 3, N_HEADS, HEAD_DIM)
    q = apply_partial_rope(rmsnorm(qkv[:, :, 0], q_gain), cos, sin)
    k = apply_partial_rope(rmsnorm(qkv[:, :, 1], k_gain), cos, sin)
    v = qkv[:, :, 2]
    s_pad = -(-S // MOBA_BLOCK) * MOBA_BLOCK
    nblk = s_pad // MOBA_BLOCK
    n_chunk = s_pad // MOBA_QCHUNK
    topk = min(MOBA_TOPK, nblk)

    def to_bhsd(t):
        return jnp.pad(t, ((0, 0), (0, s_pad - S), (0, 0), (0, 0))).transpose(0, 2, 1, 3)

    q, k, v = to_bhsd(q), to_bhsd(k), to_bhsd(v)
    k_blocks = k.reshape(B, N_HEADS, nblk, MOBA_BLOCK, HEAD_DIM)
    v_blocks = v.reshape(B, N_HEADS, nblk, MOBA_BLOCK, HEAD_DIM)
    k_mean = k_blocks.astype(jnp.float32).mean(axis=3)
    gate = jnp.einsum('bhsd,bhnd->bhsn', q.astype(jnp.float32), k_mean)
    own_blk = jnp.arange(s_pad) // MOBA_BLOCK
    fully_past = jnp.arange(nblk)[None, :] < own_blk[:, None]
    gate = jnp.where(fully_past, gate, -jnp.inf)
    _, sel = lax.top_k(gate, topk)

    def to_chunks(t):
        t = t.reshape(B, N_HEADS, n_chunk, MOBA_QCHUNK, t.shape[-1])
        return t.transpose(0, 2, 1, 3, 4).reshape(B * n_chunk, N_HEADS, MOBA_QCHUNK, t.shape[-1])

    q_chunks = to_chunks(q)
    sel_chunks = to_chunks(sel)
    chunk_ids = jnp.arange(B * n_chunk, dtype=jnp.int32)
    n_sel = topk * MOBA_BLOCK

    def one_chunk(args):
        qc, selc, cid = args
        b = cid // n_chunk
        c = cid % n_chunk
        kb = k_blocks[b]
        vb = v_blocks[b]
        qpos = c * MOBA_QCHUNK + jnp.arange(MOBA_QCHUNK)
        ob = (c * MOBA_QCHUNK) // MOBA_BLOCK
        h_idx = jnp.arange(N_HEADS)[:, None, None]
        k_sel = kb[h_idx, selc]
        v_sel = vb[h_idx, selc]
        s_sel = jnp.einsum('hqd,hqnkd->hqnk', qc, k_sel).astype(jnp.float32) * ATTN_SCALE
        valid = jnp.arange(topk) < ob
        s_sel = jnp.where(valid[None, None, :, None], s_sel, -jnp.inf)
        s_sel = s_sel.reshape(N_HEADS, MOBA_QCHUNK, n_sel)
        k_own = lax.dynamic_index_in_dim(kb, ob, axis=1, keepdims=False)
        v_own = lax.dynamic_index_in_dim(vb, ob, axis=1, keepdims=False)
        s_own = jnp.einsum('hqd,hkd->hqk', qc, k_own).astype(jnp.float32) * ATTN_SCALE
        kpos = ob * MOBA_BLOCK + jnp.arange(MOBA_BLOCK)
        s_own = jnp.where((kpos[None, :] <= qpos[:, None])[None], s_own, -jnp.inf)
        p = jax.nn.softmax(jnp.concatenate([s_sel, s_own], axis=-1), axis=-1).astype(v_sel.dtype)
        o = jnp.einsum('hqn,hqnd->hqd', p[..., :n_sel],
                       v_sel.reshape(N_HEADS, MOBA_QCHUNK, n_sel, HEAD_DIM))
        return o + jnp.einsum('hqk,hkd->hqd', p[..., n_sel:], v_own)

    out = lax.map(one_chunk, (q_chunks, sel_chunks, chunk_ids))
    out = out.reshape(B, n_chunk, N_HEADS, MOBA_QCHUNK, HEAD_DIM).transpose(0, 1, 3, 2, 4)
    out = out.reshape(B, s_pad, N_HEADS * HEAD_DIM)[:, :S]
    return out.astype(h.dtype) @ w_o


def conv_ffn(h, w_up, conv_w, conv_b, w_down):
    S = h.shape[1]
    u = h @ w_up
    up = jnp.pad(u, ((0, 0), (CONV_WIDTH - 1, 0), (0, 0)))
    uc = conv_b + sum(conv_w[j] * up[:, j:j + S] for j in range(CONV_WIDTH))
    gate, val = uc[..., :D_FF], uc[..., D_FF:]
    return (jax.nn.silu(gate) * val) @ w_down


def setup_inputs(seed: int = 0) -> dict:
    key = jax.random.key(seed)
    ks = jax.random.split(key, 16)
    hd_all = N_HEADS * HEAD_DIM

    def w(k, shape, fan_in):
        return jax.random.normal(k, shape, jnp.float32) * fan_in ** -0.5

    def gain(k, shape):
        return 1.0 + 0.1 * jax.random.normal(k, shape, jnp.float32)

    return {
        'x': jax.random.normal(ks[0], (BATCH, SEQ, D_MODEL), jnp.float32),
        'attn_norm': gain(ks[1], (DEPTH, D_MODEL)),
        'a_w_qkv': w(ks[2], (N_LAYERS_A, D_MODEL, 3 * N_DIL * hd_all), D_MODEL),
        'a_q_norm': gain(ks[3], (N_LAYERS_A, N_DIL, HEAD_DIM)),
        'a_k_norm': gain(ks[4], (N_LAYERS_A, N_DIL, HEAD_DIM)),
        'a_w_o': w(ks[5], (N_LAYERS_A, hd_all, D_MODEL), hd_all),
        'b_w_qkv': w(ks[6], (N_LAYERS_B, D_MODEL, 3 * hd_all), D_MODEL),
        'b_q_norm': gain(ks[7], (N_LAYERS_B, HEAD_DIM)),
        'b_k_norm': gain(ks[8], (N_LAYERS_B, HEAD_DIM)),
        'b_w_o': w(ks[9], (N_LAYERS_B, hd_all, D_MODEL), hd_all),
        'ffn_norm': gain(ks[10], (DEPTH, D_MODEL)),
        'ffn_w_up': w(ks[11], (DEPTH, D_MODEL, 2 * D_FF), D_MODEL),
        'ffn_conv_w': w(ks[12], (DEPTH, CONV_WIDTH, 2 * D_FF), CONV_WIDTH),
        'ffn_conv_b': 0.01 * jax.random.normal(ks[13], (DEPTH, 2 * D_FF), jnp.float32),
        'ffn_w_down': w(ks[14], (DEPTH, D_FF, D_MODEL), D_FF),
    }


def reference(x, attn_norm, a_w_qkv, a_q_norm, a_k_norm, a_w_o,
              b_w_qkv, b_q_norm, b_k_norm, b_w_o,
              ffn_norm, ffn_w_up, ffn_conv_w, ffn_conv_b, ffn_w_down):
    cos, sin = rope_tables(x.shape[1])
    for i in range(DEPTH):
        hn = rmsnorm(x, attn_norm[i])
        if i % 2 == 0:
            j = i // 2
            x = x + mixer_dilated(hn, a_w_qkv[j], a_q_norm[j], a_k_norm[j], a_w_o[j], cos, sin)
        else:
            j = i // 2
            x = x + mixer_moba(hn, b_w_qkv[j], b_q_norm[j], b_k_norm[j], b_w_o[j], cos, sin)
        hn = rmsnorm(x, ffn_norm[i])
        x = x + conv_ffn(hn, ffn_w_up[i], ffn_conv_w[i], ffn_conv_b[i], ffn_w_down[i])
    return x
```

```cpp
#include <hip/hip_runtime.h>
#include <hip/hip_bf16.h>
#include <hip/hip_cooperative_groups.h>
#include <cstdio>
#include <cstdint>
#include <cmath>
namespace cg = cooperative_groups;

__device__ __forceinline__ int fresh_lane() { unsigned z = 0u; asm volatile("" : "+v"(z)); return (int)__builtin_amdgcn_mbcnt_hi(~0u, __builtin_amdgcn_mbcnt_lo(~0u, z)); }
#ifndef PROBE_K2
#define PROBE_K2 0
#endif
namespace pg8 {
#define PG8_LAS __attribute__((address_space(3)))
typedef unsigned short bf16_t;
typedef short bf16x8 __attribute__((ext_vector_type(8)));
typedef float f32x4 __attribute__((ext_vector_type(4)));
typedef unsigned u32x4 __attribute__((ext_vector_type(4)));
typedef unsigned u32x2 __attribute__((ext_vector_type(2)));
constexpr int BM = 256, BK = 64, HALF = 128, HTB = HALF * BK * 2  , STAGE_BYTES = 8 * HTB, NXCD = 8, WGM = 4;

__host__ __device__ __forceinline__ int lds_byte(int r, int c) { const int st = (r >> 4) * 2 + (c >> 5), rr = r & 15, cc = c & 31, ob = rr * 64 + cc * 2; return st * 1024 + (ob ^ (((ob >> 9) & 1) << 5)); }
__host__ __device__ __forceinline__ void stage_rc(int b, int& R, int& C) { const int st = b / 1024, sb = b % 1024, swz = sb ^ (((sb >> 9) & 1) << 5); R = (st >> 1) * 16 + swz / 64; C = (st & 1) * 32 + (swz % 64) / 2; }
__host__ __device__ __forceinline__ int perm32(int rho) { const int n = rho >> 4, i = rho & 15; return 8 * (i >> 2) + 4 * n + (i & 3); }

struct Unit { int pm, pn; };
struct Gemm { const bf16_t* A; const bf16_t* Bt; int M, N, K; };

struct StaticOrder {
    int nM, nN, nwg, G, c;
    __device__ __forceinline__ void init(int M, int N, int G_, int c_) { nM = M / BM; nN = N / BM; nwg = nM * nN; G = G_; c = c_; }
    __device__ __forceinline__ bool next(int i, Unit& u) const {
        const long L = (long)i * G + c; if (L >= nwg) return false;
        int wgid = (int)L; { const int q = nwg / NXCD, r = nwg % NXCD, xcd = wgid % NXCD, off = wgid / NXCD; wgid = (xcd < r ? xcd * (q + 1) : r * (q + 1) + (xcd - r) * q) + off; }
        const int nig = WGM * nN, gid = wgid / nig, fm = gid * WGM, gsz = (nM - fm) < WGM ? (nM - fm) : WGM;
        u.pm = fm + ((wgid % nig) % gsz); u.pn = (wgid % nig) / gsz; return true;
    }
};

__device__ __forceinline__ unsigned cvt_pk_bf16(float lo, float hi) { unsigned r; asm volatile("v_cvt_pk_bf16_f32 %0, %1, %2" : "=v"(r) : "v"(lo), "v"(hi)); return r; }

template <class Epi, class Sched>
__device__ __forceinline__ void gemm_phase(const int tid, PG8_LAS unsigned char* lds, PG8_LAS unsigned char* xlds, const Gemm g, const Sched& S, const Epi& E) {
    const int wid = __builtin_amdgcn_readfirstlane(tid >> 6), lane = tid & 63, wr = wid >> 2, wc = wid & 3, fr = lane & 15, fq = lane >> 4;
    const int K = g.K, nt = K / BK;
    unsigned voffA, voffB;
    { int R, C; stage_rc(tid * 16, R, C); const int Rb = ((R & ~31) + perm32(R & 31));
      const int Ra = Epi::AROWPERM ? ((R & ~63) + 4 * (R & 15) + ((R >> 4) & 3)) : R;
      voffA = (unsigned)(Ra * K + C) * 2u; voffB = (unsigned)(Rb * K + C) * 2u; }
    const unsigned qstep = 64u * (unsigned)K * 2u;
    const unsigned kstep = (unsigned)(BK * 2);
    const unsigned hstep = (unsigned)HALF * (unsigned)K * 2u;
    const unsigned tstep = 2u * hstep;
    const char* const gA = (const char*)g.A; const char* const gB = (const char*)g.Bt;
    const unsigned ldsw = (unsigned)wid * 1024u;
    const int aoff = lds_byte(wr * 64 + fr, fq * 8), boff = lds_byte(wc * 32 + fr, fq * 8);
    unsigned ldsA_ = (unsigned)(uintptr_t)lds + (unsigned)aoff, ldsB_ = (unsigned)(uintptr_t)lds + 4u * HTB + (unsigned)boff; asm volatile("" : "+v"(ldsA_), "+v"(ldsB_));
    const PG8_LAS unsigned char* const ldsA = (const PG8_LAS unsigned char*)(uintptr_t)ldsA_; const PG8_LAS unsigned char* const ldsB = (const PG8_LAS unsigned char*)(uintptr_t)ldsB_;
#define PG8_SA(b, h) (((b) * 2 + (h)) * HTB)
#define PG8_SB(b, h) ((4 + (b) * 2 + (h)) * HTB)
#define PG8_STAGE(bufoff, gptr, goff, voff) do { _Pragma("unroll") for (int _i = 0; _i < 2; ++_i) \
        __builtin_amdgcn_global_load_lds((const unsigned*)((gptr) + (unsigned)((goff) + _i * qstep + (voff))), (PG8_LAS unsigned*)(lds + (bufoff) + ldsw + _i * 8192), 16, 0, 0); } while (0)
#define PG8_LDA(dst, b, h) do { _Pragma("unroll") for (int m = 0; m < 4; ++m) _Pragma("unroll") for (int k = 0; k < 2; ++k) dst[m][k] = *(const PG8_LAS bf16x8*)(ldsA + (PG8_SA(b, h) + m * 2048 + k * 1024)); } while (0)
#define PG8_LDB(dst, b, h) do { _Pragma("unroll") for (int n = 0; n < 2; ++n) _Pragma("unroll") for (int k = 0; k < 2; ++k) dst[n][k] = *(const PG8_LAS bf16x8*)(ldsB + (PG8_SB(b, h) - 4 * HTB + n * 2048 + k * 1024)); } while (0)
#define PG8_MMA(ai, bj, At, Bt) do { __builtin_amdgcn_s_setprio(1); _Pragma("unroll") for (int m = 0; m < 4; ++m) _Pragma("unroll") for (int n = 0; n < 2; ++n) _Pragma("unroll") for (int k = 0; k < 2; ++k) \
        acc[ai][bj][m][n] = __builtin_amdgcn_mfma_f32_16x16x32_bf16(Bt[n][k], At[m][k], acc[ai][bj][m][n], 0, 0, 0); __builtin_amdgcn_s_setprio(0); } while (0)
#define PG8_WAIT_V(n) asm volatile("s_waitcnt vmcnt(" #n ")" ::: "memory")
#define PG8_WAIT_L(n) asm volatile("s_waitcnt lgkmcnt(" #n ")" ::: "memory")
#define PG8_BAR __builtin_amdgcn_s_barrier()
#define PG8_SCHED __builtin_amdgcn_sched_barrier(0)
    Unit cur, nxt; int ui = 0;
    if (!S.next(0, cur)) return;
    f32x4 acc[2][2][4][2];
#pragma unroll
    for (int a = 0; a < 2; ++a)
#pragma unroll
        for (int b = 0; b < 2; ++b)
#pragma unroll
            for (int m = 0; m < 4; ++m)
#pragma unroll
                for (int n = 0; n < 2; ++n) acc[a][b][m][n] = (f32x4){0.f, 0.f, 0.f, 0.f};
    bf16x8 At[4][2], B0[2][2], B1[2][2];
    unsigned cA = (unsigned)cur.pm * tstep, cB = (unsigned)cur.pn * tstep;
    PG8_STAGE(PG8_SB(0, 0), gB, cB, voffB); PG8_STAGE(PG8_SB(0, 1), gB, cB + hstep, voffB); PG8_STAGE(PG8_SA(0, 0), gA, cA, voffA); PG8_STAGE(PG8_SA(0, 1), gA, cA + hstep, voffA);
    if (wr == 1) PG8_BAR;
    PG8_WAIT_V(2); PG8_BAR;
    PG8_STAGE(PG8_SB(1, 0), gB, cB + kstep, voffB); PG8_STAGE(PG8_SA(1, 0), gA, cA + kstep, voffA); PG8_STAGE(PG8_SB(1, 1), gB, cB + hstep + kstep, voffB);
    PG8_WAIT_V(0); PG8_BAR;
    for (;;) {
        PG8_BAR; { const int ln_ = fresh_lane(); E.prefetch(cur, xlds, wid, ln_); }
        const bool has_next = S.next(ui + 1, nxt);
        const unsigned nA = has_next ? (unsigned)nxt.pm * tstep : cA, nB = has_next ? (unsigned)nxt.pn * tstep : cB;
#if PROBE_K2
        for (int rep = 0; rep < 2; ++rep)
#endif
        for (int t = 0; t < nt; t += 2) {
            const bool last = (t == nt - 2);
            const unsigned a1 = cA + (unsigned)(t + 1) * kstep;
#if PROBE_K2
            const unsigned a2 = last ? (rep == 0 ? cA : nA) : cA + (unsigned)(t + 2) * kstep, b2 = last ? (rep == 0 ? cB : nB) : cB + (unsigned)(t + 2) * kstep;
#else
            const unsigned a2 = last ? nA : cA + (unsigned)(t + 2) * kstep, b2 = last ? nB : cB + (unsigned)(t + 2) * kstep;
#endif
            const unsigned a3 = a2 + kstep, b3 = b2 + kstep;
            const bool relax = (t == 0);
            PG8_LDB(B0, 0, 0); PG8_LDB(B1, 0, 1); PG8_SCHED; PG8_LDA(At, 0, 0); PG8_STAGE(PG8_SA(1, 1), gA, a1 + hstep, voffA);
            if (!relax) PG8_WAIT_V(8); PG8_WAIT_L(0); PG8_BAR; PG8_MMA(0, 0, At, B0); PG8_MMA(0, 1, At, B1); PG8_BAR; PG8_SCHED;
            PG8_LDA(At, 0, 1); PG8_STAGE(PG8_SB(0, 0), gB, b2, voffB); PG8_STAGE(PG8_SB(0, 1), gB, b2 + hstep, voffB); PG8_STAGE(PG8_SA(0, 0), gA, a2, voffA);
            if (!relax) PG8_WAIT_V(8); PG8_WAIT_L(0); PG8_BAR; PG8_MMA(1, 0, At, B0); PG8_MMA(1, 1, At, B1); PG8_BAR; PG8_SCHED;
            PG8_LDB(B0, 1, 0); PG8_LDB(B1, 1, 1); PG8_SCHED; PG8_LDA(At, 1, 0); PG8_STAGE(PG8_SA(0, 1), gA, a2 + hstep, voffA);
            PG8_WAIT_V(8); PG8_WAIT_L(0); PG8_BAR; PG8_MMA(0, 0, At, B0); PG8_MMA(0, 1, At, B1); PG8_BAR; PG8_SCHED;
            PG8_LDA(At, 1, 1); PG8_STAGE(PG8_SB(1, 0), gB, b3, voffB); PG8_STAGE(PG8_SB(1, 1), gB, b3 + hstep, voffB); PG8_STAGE(PG8_SA(1, 0), gA, a3, voffA);
            PG8_WAIT_V(8); PG8_WAIT_L(0); PG8_BAR; PG8_MMA(1, 0, At, B0); PG8_MMA(1, 1, At, B1); PG8_BAR; PG8_SCHED;
        }
#if PROBE_K2
#pragma unroll
        for (int a = 0; a < 2; ++a)
#pragma unroll
            for (int b = 0; b < 2; ++b)
#pragma unroll
                for (int m = 0; m < 4; ++m)
#pragma unroll
                    for (int n = 0; n < 2; ++n) acc[a][b][m][n] = acc[a][b][m][n] * 0.5f;
#endif
        if (wr == 0) PG8_BAR;
        PG8_WAIT_V(0);
        { const int ln_ = fresh_lane(); const int fr_ = ln_ & 15, fq_ = ln_ >> 4; E(acc, cur, wr, wc, fr_, fq_, xlds); if constexpr (Epi::PROBE2) { { const int l2_ = fresh_lane(); E(acc, cur, wr, wc, l2_ & 15, l2_ >> 4, xlds); } } }
        if (!has_next) break;
#pragma unroll
        for (int a = 0; a < 2; ++a)
#pragma unroll
            for (int b = 0; b < 2; ++b)
#pragma unroll
                for (int m = 0; m < 4; ++m)
#pragma unroll
                    for (int n = 0; n < 2; ++n) acc[a][b][m][n] = (f32x4){0.f, 0.f, 0.f, 0.f};
        cur = nxt; cA = nA; cB = nB; ++ui;
        if (wr == 1) PG8_BAR;
    }
    PG8_WAIT_V(0);
    PG8_BAR;
#undef PG8_SA
#undef PG8_SB
#undef PG8_STAGE
#undef PG8_LDA
#undef PG8_LDB
#undef PG8_MMA
#undef PG8_WAIT_V
#undef PG8_WAIT_L
#undef PG8_BAR
#undef PG8_SCHED
}
}

constexpr int BATCH = 8, SEQ = 4096, DMODEL = 1024, NHEADS = 16, HDIM = 64, DFF = 2816, NUP = 2 * DFF;
constexpr int MTOK = BATCH * SEQ;
constexpr float RMS_EPS = 1e-6f;
constexpr float QSCALE = 0.125f * 1.4426950408889634f;
constexpr int XL_EX = 0, XL_SS = 8192, XL_GAIN = XL_SS + 1024, XL_COS = XL_GAIN + 256, XL_SIN = XL_COS + 8192, XL_CW = XL_COS, XL_END = XL_SIN + 8192;

typedef unsigned short bf16;
typedef float f32x4 __attribute__((ext_vector_type(4)));
typedef float f32x2 __attribute__((ext_vector_type(2)));
typedef unsigned u32x4 __attribute__((ext_vector_type(4)));
typedef unsigned u32x2 __attribute__((ext_vector_type(2)));
#define LAS __attribute__((address_space(3)))

__device__ __forceinline__ float shx(float v, int m) { return __shfl_xor(v, m); }
__device__ __forceinline__ float xsum16(float v) { auto r = __builtin_amdgcn_permlane16_swap(__float_as_uint(v), __float_as_uint(v), false, false); return __uint_as_float(r[0]) + __uint_as_float(r[1]); }
__device__ __forceinline__ float xsum32(float v) { auto r = __builtin_amdgcn_permlane32_swap(__float_as_uint(v), __float_as_uint(v), false, false); return __uint_as_float(r[0]) + __uint_as_float(r[1]); }
__device__ __forceinline__ float fqsum(float v) { return xsum32(xsum16(v)); }
__device__ __forceinline__ float rsq(float v) { return __builtin_amdgcn_rsqf(v); }
__device__ __forceinline__ float bf2f(unsigned short b) { return __uint_as_float(((unsigned)b) << 16); }
__device__ __forceinline__ float sum4(f32x4 v) { return (v[0] + v[1]) + (v[2] + v[3]); }
__device__ __forceinline__ float dot4(f32x4 v) { return (v[0] * v[0] + v[1] * v[1]) + (v[2] * v[2] + v[3] * v[3]); }

__device__ __forceinline__ void dma1k(const void* src, LAS unsigned char* dst, unsigned voff) {
    __builtin_amdgcn_global_load_lds((const unsigned*)((const char*)src + voff), (LAS unsigned*)dst, 16, 0, 0); }
__device__ __forceinline__ float lds_rstd(LAS unsigned char* xlds, int r) { return rsq(((LAS float*)(xlds + XL_SS))[r] * (1.0f / DMODEL) + RMS_EPS); }
#ifndef PROBE_EPI2
#define PROBE_EPI2 0
#endif
template <int CTRL> __device__ __forceinline__ float dpp_ror(float v) { return __builtin_bit_cast(float, __builtin_amdgcn_update_dpp(0, __builtin_bit_cast(int, v), CTRL, 0xf, 0xf, false)); }
template <bool KMSUM> struct EpiQKV {
    static constexpr bool PROBE2 = (PROBE_EPI2 & 1) != 0, AROWPERM = false;
    float* kmsum;
    bf16 *Q; size_t qkv_stride; const float* ss; const float *qg, *kg; const float *cosT, *sinT;
    __device__ __forceinline__ void prefetch(const pg8::Unit& u, LAS unsigned char* xlds, int wid, int lane) const {
        const int which = u.pn >> 2; const unsigned l16 = (unsigned)lane * 16u;
        if (wid == 0) dma1k(ss + u.pm * 256, xlds + XL_SS, l16);
        if (which < 2) {
            const int pos0 = (u.pm * 256) & (SEQ - 1);
            dma1k(cosT + pos0 * 8 + wid * 256, xlds + XL_COS + wid * 1024, l16);
            dma1k(sinT + pos0 * 8 + wid * 256, xlds + XL_SIN + wid * 1024, l16);
            if (wid == 1 && lane < 16) dma1k((which == 0) ? qg : kg, xlds + XL_GAIN, l16);
        }
    }
    __device__ __forceinline__ void operator()(const f32x4 (&acc)[2][2][4][2], const pg8::Unit& u, int wr, int wc, int fr, int fq, LAS unsigned char* xlds) const {
        const int which = u.pn >> 2, head = (u.pn & 3) * 4 + wc;
        bf16* dst = Q + (size_t)which * qkv_stride;
        f32x4 g[2][2];
        if (which < 2) {
            const LAS float* gn = (const LAS float*)(xlds + XL_GAIN);
            const int b0 = (fq < 2) ? 4 * fq : 8 * fq, b1 = (fq < 2) ? 8 + 4 * fq : 8 * fq + 4;
            g[0][0] = *(const LAS f32x4*)(gn + b0); g[0][1] = *(const LAS f32x4*)(gn + b1);
            g[1][0] = *(const LAS f32x4*)(gn + 32 + 8 * fq); g[1][1] = *(const LAS f32x4*)(gn + 32 + 8 * fq + 4);
        }
        const float post = (which == 0) ? QSCALE : 1.0f;
        const bool ropeq = (which < 2) && (fq < 2);
        f32x4 ks[2][2];
        if (KMSUM) {
#pragma unroll
            for (int bj = 0; bj < 2; ++bj)
#pragma unroll
                for (int n = 0; n < 2; ++n) ks[bj][n] = (f32x4){0.f, 0.f, 0.f, 0.f};
        }
#pragma unroll
        for (int ai = 0; ai < 2; ++ai) {
#pragma unroll
            for (int m = 0; m < 4; ++m) {
                const int row = u.pm * 256 + ai * 128 + wr * 64 + m * 16 + fr;
                f32x4 cs = (f32x4){1.f, 1.f, 1.f, 1.f}, sn = (f32x4){0.f, 0.f, 0.f, 0.f};
                if (ropeq) { const int r = ai * 128 + wr * 64 + m * 16 + fr; cs = *(const LAS f32x4*)(xlds + XL_COS + r * 32 + 16 * fq); sn = *(const LAS f32x4*)(xlds + XL_SIN + r * 32 + 16 * fq); }
                const float rstd = lds_rstd(xlds, ai * 128 + wr * 64 + m * 16 + fr);
                f32x4 v[2][2];
                if (which < 2) {
                    const float q = fqsum((dot4(acc[ai][0][m][0]) + dot4(acc[ai][0][m][1])) + (dot4(acc[ai][1][m][0]) + dot4(acc[ai][1][m][1])));
                    const float sc = post * rstd * rsq(q * (rstd * rstd) * (1.0f / HDIM) + RMS_EPS);
#pragma unroll
                    for (int bj = 0; bj < 2; ++bj)
#pragma unroll
                        for (int n = 0; n < 2; ++n) v[bj][n] = acc[ai][bj][m][n] * (g[bj][n] * sc);
                    const f32x4 x1 = v[0][0], x2 = v[0][1];
                    v[0][0] = (x1 * cs - x2 * sn); v[0][1] = (x2 * cs + x1 * sn);
                    if (KMSUM && which == 1) {
#pragma unroll
                        for (int bj = 0; bj < 2; ++bj)
#pragma unroll
                            for (int n = 0; n < 2; ++n) ks[bj][n] += v[bj][n];
                    }
                } else {
#pragma unroll
                    for (int bj = 0; bj < 2; ++bj)
#pragma unroll
                        for (int n = 0; n < 2; ++n) v[bj][n] = acc[ai][bj][m][n] * rstd;
                }
                bf16* rowp = dst + (size_t)row * DMODEL + head * 64 + 8 * fq;
#pragma unroll
                for (int bj = 0; bj < 2; ++bj) {
                    u32x4 w; w.x = pg8::cvt_pk_bf16(v[bj][0][0], v[bj][0][1]); w.y = pg8::cvt_pk_bf16(v[bj][0][2], v[bj][0][3]);
                    w.z = pg8::cvt_pk_bf16(v[bj][1][0], v[bj][1][1]); w.w = pg8::cvt_pk_bf16(v[bj][1][2], v[bj][1][3]);
                    *(u32x4*)(rowp + bj * 32) = w;
                }
            }
            asm volatile("" ::: "memory");
        }
        if (KMSUM && which == 1) {
#pragma unroll
            for (int bj = 0; bj < 2; ++bj)
#pragma unroll
                for (int n = 0; n < 2; ++n)
#pragma unroll
                    for (int e = 0; e < 4; ++e) {
                        float x = ks[bj][n][e];
                        x += dpp_ror<0x128>(x); x += dpp_ror<0x124>(x); x += dpp_ror<0x122>(x); x += dpp_ror<0x121>(x);
                        ks[bj][n][e] = x;
                    }
            if (fr == 0) {
                float* kp = kmsum + ((size_t)((u.pm >> 4) * NHEADS + head) * 16 + (u.pm & 15)) * 64 + 8 * fq;
#pragma unroll
                for (int bj = 0; bj < 2; ++bj)
#pragma unroll
                    for (int n = 0; n < 2; ++n)
#pragma unroll
                        for (int e = 0; e < 4; ++e) atomicAdd(kp + bj * 32 + 4 * n + e, ks[bj][n][e]);
            }
        }
    }
};

__device__ __forceinline__ f32x4 bf_lo2(unsigned a, unsigned b) { return (f32x4){__uint_as_float(a << 16), __uint_as_float(a & 0xffff0000u), __uint_as_float(b << 16), __uint_as_float(b & 0xffff0000u)}; }
template <bool RES_F32, bool OUT_F32> struct EpiRes {
    static constexpr bool PROBE2 = false, AROWPERM = false;
    const void* resid; void* out; float* ss;
    __device__ __forceinline__ void prefetch(const pg8::Unit&, LAS unsigned char*, int, int) const {}
    __device__ __forceinline__ void operator()(const f32x4 (&acc)[2][2][4][2], const pg8::Unit& u, int wr, int wc, int fr, int fq, LAS unsigned char*) const {
        const int col0 = u.pn * 256 + wc * 32 + 8 * fq;
        if constexpr (!RES_F32) {
            u32x4 rb[2][4][2];
#pragma unroll
            for (int ai = 0; ai < 2; ++ai)
#pragma unroll
                for (int m = 0; m < 4; ++m) {
                    const size_t off = (size_t)(u.pm * 256 + ai * 128 + wr * 64 + m * 16 + fr) * DMODEL + col0;
#pragma unroll
                    for (int bj = 0; bj < 2; ++bj) rb[ai][m][bj] = __builtin_nontemporal_load((const u32x4*)((const bf16*)resid + off + bj * 128));
                }
            asm volatile("" ::: "memory");
#pragma unroll
            for (int ai = 0; ai < 2; ++ai)
#pragma unroll
                for (int m = 0; m < 4; ++m) {
                    const int row = u.pm * 256 + ai * 128 + wr * 64 + m * 16 + fr;
                    const size_t off = (size_t)row * DMODEL + col0;
                    float q = 0.f;
#pragma unroll
                    for (int bj = 0; bj < 2; ++bj) {
                        const f32x4 x0 = bf_lo2(rb[ai][m][bj].x, rb[ai][m][bj].y) + acc[ai][bj][m][0], x1 = bf_lo2(rb[ai][m][bj].z, rb[ai][m][bj].w) + acc[ai][bj][m][1];
                        q += dot4(x0) + dot4(x1);
                        if (OUT_F32) { *(f32x4*)((float*)out + off + bj * 128) = x0; *(f32x4*)((float*)out + off + bj * 128 + 4) = x1; }
                        else { u32x4 w; w.x = pg8::cvt_pk_bf16(x0[0], x0[1]); w.y = pg8::cvt_pk_bf16(x0[2], x0[3]); w.z = pg8::cvt_pk_bf16(x1[0], x1[1]); w.w = pg8::cvt_pk_bf16(x1[2], x1[3]);
                            *(u32x4*)((bf16*)out + off + bj * 128) = w; }
                    }
                    if (ss) { q = fqsum(q); if (fq == 0) atomicAdd(ss + row, q); }
                }
        } else {
#pragma unroll
            for (int ai = 0; ai < 2; ++ai)
#pragma unroll
                for (int mp = 0; mp < 4; mp += 2) {
                    f32x4 rr[2][2][2];
#pragma unroll
                    for (int mm = 0; mm < 2; ++mm) {
                        const size_t off = (size_t)(u.pm * 256 + ai * 128 + wr * 64 + (mp + mm) * 16 + fr) * DMODEL + col0;
#pragma unroll
                        for (int bj = 0; bj < 2; ++bj) { rr[mm][bj][0] = *(const f32x4*)((const float*)resid + off + bj * 128); rr[mm][bj][1] = *(const f32x4*)((const float*)resid + off + bj * 128 + 4); }
                    }
#pragma unroll
                    for (int mm = 0; mm < 2; ++mm) {
                        const int m = mp + mm;
                        const int row = u.pm * 256 + ai * 128 + wr * 64 + m * 16 + fr;
                        const size_t off = (size_t)row * DMODEL + col0;
                        float q = 0.f;
#pragma unroll
                        for (int bj = 0; bj < 2; ++bj) {
                            const f32x4 x0 = rr[mm][bj][0] + acc[ai][bj][m][0], x1 = rr[mm][bj][1] + acc[ai][bj][m][1];
                            q += dot4(x0) + dot4(x1);
                            if (OUT_F32) { *(f32x4*)((float*)out + off + bj * 128) = x0; *(f32x4*)((float*)out + off + bj * 128 + 4) = x1; }
                            else { u32x4 w; w.x = pg8::cvt_pk_bf16(x0[0], x0[1]); w.y = pg8::cvt_pk_bf16(x0[2], x0[3]); w.z = pg8::cvt_pk_bf16(x1[0], x1[1]); w.w = pg8::cvt_pk_bf16(x1[2], x1[3]);
                                *(u32x4*)((bf16*)out + off + bj * 128) = w; }
                        }
                        if (ss) { q = fqsum(q); if (fq == 0) atomicAdd(ss + row, q); }
                    }
                    asm volatile("" ::: "memory");
                }
        }
    }
};

__device__ __forceinline__ void shr1_into(f32x4& d, const f32x4 s) {
    float d0 = d[0], d1 = d[1], d2 = d[2], d3 = d[3];
    asm volatile("s_nop 1\n\tv_mov_b32_dpp %0, %4 row_shr:1 row_mask:0xf bank_mask:0xf\n\tv_mov_b32_dpp %1, %5 row_shr:1 row_mask:0xf bank_mask:0xf\n\t"
                 "v_mov_b32_dpp %2, %6 row_shr:1 row_mask:0xf bank_mask:0xf\n\tv_mov_b32_dpp %3, %7 row_shr:1 row_mask:0xf bank_mask:0xf"
                 : "+v"(d0), "+v"(d1), "+v"(d2), "+v"(d3) : "v"(s[0]), "v"(s[1]), "v"(s[2]), "v"(s[3]));
    d = (f32x4){d0, d1, d2, d3};
}
__device__ __forceinline__ f32x4 ror1(f32x4 v) { return (f32x4){dpp_ror<0x121>(v[0]), dpp_ror<0x121>(v[1]), dpp_ror<0x121>(v[2]), dpp_ror<0x121>(v[3])}; }
__device__ __forceinline__ f32x4 ror2(f32x4 v) { return (f32x4){dpp_ror<0x122>(v[0]), dpp_ror<0x122>(v[1]), dpp_ror<0x122>(v[2]), dpp_ror<0x122>(v[3])}; }
__device__ __forceinline__ float silu_mul(float gte, float val) { const float e = __builtin_amdgcn_exp2f(gte * -1.4426950408889634f); return gte * __builtin_amdgcn_rcpf(1.0f + e) * val; }
constexpr int EDGE_ROWS = 4;
struct EpiUpConv {
    static constexpr bool PROBE2 = (PROBE_EPI2 & 2) != 0, AROWPERM = true;
    const float* ss; const float* cw; const float* cb; bf16* Hh; float* edge;
    __device__ __forceinline__ void prefetch(const pg8::Unit& u, LAS unsigned char* xlds, int wid, int lane) const {
        const unsigned l16 = (unsigned)lane * 16u;
        if (wid == 0) dma1k(ss + u.pm * 256, xlds + XL_SS, l16);
        if (wid >= 1 && wid <= 4) {
            const float* src = ((wid == 4) ? cb : cw + (size_t)(wid - 1) * NUP) + u.pn * 128;
            dma1k(src, xlds + XL_CW + (wid - 1) * 1024, l16 + ((lane < 32) ? 0u : (unsigned)(DFF - 128) * 4u));
        }
    }
    __device__ __forceinline__ void operator()(const f32x4 (&acc)[2][2][4][2], const pg8::Unit& u, int wr, int wc, int fr, int fq, LAS unsigned char* xlds) const {
        float rs[2][4];
#pragma unroll
        for (int ai = 0; ai < 2; ++ai)
#pragma unroll
            for (int m = 0; m < 4; ++m) rs[ai][m] = lds_rstd(xlds, ai * 128 + wr * 64 + 4 * fr + m);
        LAS f32x4* EX = (LAS f32x4*)(xlds + XL_EX);
        if (fr == 15) {
#pragma unroll
            for (int ai = 0; ai < 2; ++ai)
#pragma unroll
                for (int mm = 0; mm < 2; ++mm)
#pragma unroll
                    for (int bj = 0; bj < 2; ++bj)
#pragma unroll
                        for (int n = 0; n < 2; ++n) EX[((((ai * 2 + wr) * 4 + wc) * 2 + mm) * 4 + fq) * 4 + bj * 2 + n] = acc[ai][bj][2 + mm][n] * rs[ai][2 + mm];
        }
        {
            const int pcol = u.pn * 256 + wc * 32 + 8 * fq;
            float* eb = edge + (size_t)u.pm * EDGE_ROWS * NUP + pcol;
            if (wr == 0 && fr == 0) {
#pragma unroll
                for (int mm = 0; mm < 2; ++mm)
#pragma unroll
                    for (int bj = 0; bj < 2; ++bj)
#pragma unroll
                        for (int n = 0; n < 2; ++n) *(f32x4*)(eb + (size_t)mm * NUP + bj * 128 + 4 * n) = acc[0][bj][mm][n] * rs[0][mm];
            }
            if (wr == 1 && fr == 15) {
#pragma unroll
                for (int mm = 0; mm < 2; ++mm)
#pragma unroll
                    for (int bj = 0; bj < 2; ++bj)
#pragma unroll
                        for (int n = 0; n < 2; ++n) *(f32x4*)(eb + (size_t)(2 + mm) * NUP + bj * 128 + 4 * n) = acc[1][bj][2 + mm][n] * rs[1][2 + mm];
            }
        }
        asm volatile("s_waitcnt lgkmcnt(0)" ::: "memory"); __builtin_amdgcn_s_barrier(); asm volatile("" ::: "memory");
        const bool seq_start = (u.pm & 15) == 0;
        const int jg0 = u.pn * 128 + wc * 32 + 8 * fq;
        u32x2 hold[2][4];
#pragma unroll
        for (int n = 0; n < 2; ++n) {
            f32x4 w0[2], w1[2], w2[2], bb[2];
#pragma unroll
            for (int bj = 0; bj < 2; ++bj) {
                const int pc = (bj * 128 + wc * 32 + 8 * fq + 4 * n) * 4;
                w0[bj] = *(const LAS f32x4*)(xlds + XL_CW + pc); w1[bj] = *(const LAS f32x4*)(xlds + XL_CW + 1024 + pc); w2[bj] = *(const LAS f32x4*)(xlds + XL_CW + 2048 + pc); bb[bj] = *(const LAS f32x4*)(xlds + XL_CW + 3072 + pc);
            }
#pragma unroll
            for (int ai = 0; ai < 2; ++ai) {
                f32x4 uc[2][4];
#pragma unroll
                for (int bj = 0; bj < 2; ++bj) {
                    f32x4 h62, h63;
                    if (ai == 0 && wr == 0) { h62 = (f32x4){0.f, 0.f, 0.f, 0.f}; h63 = h62; }
                    else { const int sa = (wr == 1) ? ai : ai - 1, sw = (wr == 1) ? 0 : 1;
                        h62 = EX[((((sa * 2 + sw) * 4 + wc) * 2 + 0) * 4 + fq) * 4 + bj * 2 + n]; h63 = EX[((((sa * 2 + sw) * 4 + wc) * 2 + 1) * 4 + fq) * 4 + bj * 2 + n]; }
                    f32x4 c[4];
#pragma unroll
                    for (int m = 0; m < 4; ++m) c[m] = acc[ai][bj][m][n] * rs[ai][m];
                    f32x4 x1 = h63, x2 = h62;
                    shr1_into(x1, c[3]); shr1_into(x2, c[2]);
                    uc[bj][0] = bb[bj] + w0[bj] * x2 + w1[bj] * x1 + w2[bj] * c[0];
                    uc[bj][1] = bb[bj] + w0[bj] * x1 + w1[bj] * c[0] + w2[bj] * c[1];
                    uc[bj][2] = bb[bj] + w0[bj] * c[0] + w1[bj] * c[1] + w2[bj] * c[2];
                    uc[bj][3] = bb[bj] + w0[bj] * c[1] + w1[bj] * c[2] + w2[bj] * c[3];
                }
#pragma unroll
                for (int m = 0; m < 4; ++m) {
                    const unsigned lo = pg8::cvt_pk_bf16(silu_mul(uc[0][m][0], uc[1][m][0]), silu_mul(uc[0][m][1], uc[1][m][1]));
                    const unsigned hi = pg8::cvt_pk_bf16(silu_mul(uc[0][m][2], uc[1][m][2]), silu_mul(uc[0][m][3], uc[1][m][3]));
                    if (n == 0) { hold[ai][m] = (u32x2){lo, hi}; }
                    else {
                        const int row = u.pm * 256 + ai * 128 + wr * 64 + 4 * fr + m;
                        const bool skip = (!seq_start) && ai == 0 && wr == 0 && m < 2 && fr == 0;
                        if (!skip) { u32x4 w; w.x = hold[ai][m].x; w.y = hold[ai][m].y; w.z = lo; w.w = hi; *(u32x4*)(Hh + (size_t)row * DFF + jg0) = w; }
                    }
                }
                asm volatile("" ::: "memory");
            }
        }
    }
};

namespace attn {
using bf16x8 = __attribute__((ext_vector_type(8))) short;
using s16x4 = __attribute__((ext_vector_type(4))) short;
using f32x16 = __attribute__((ext_vector_type(16))) float;
using u32x4 = ::u32x4;
constexpr int DM = 1024, NW = 8, QBLK = 32, QB = 256, KVBLK = 64;
constexpr int NSLOT = 3, SLOTB = 8192;
constexpr int LDS_K = 0, LDS_V = NSLOT * SLOTB, LDS_WS = 2 * NSLOT * SLOTB, LDS_OST = LDS_WS + NW * 64 * 4, LDS_BYTES = LDS_OST + NW * 4096;
constexpr int THRL = 8;
enum { OUT_FINAL = 0, OUT_PART = 1, OUT_MERGE = 2 };
struct Job {
    const bf16* Q; const bf16* K; const bf16* V;
    bf16* O;
    long rs;
    int q0, k0, NT;
    int ob;
    const float* kmean;
    float kbound;
    float* stat;
    const bf16* num0; const bf16* num1; const float* stat0; const float* stat1;
    long srs;
};
__device__ __forceinline__ int crow(int r, int hi) { return (r & 3) + 8 * (r >> 2) + 4 * hi; }
#define SBAR() __builtin_amdgcn_sched_barrier(0)
__device__ __forceinline__ void glds16_nt(const void* gsrc, unsigned lds_dst) { unsigned keep;
    asm volatile("s_mov_b32 %0, m0\n\ts_mov_b32 m0, %2\n\ts_nop 0\n\tglobal_load_lds_dwordx4 %1, off nt\n\ts_mov_b32 m0, %0" : "=&s"(keep) : "v"(gsrc), "s"(lds_dst) : "memory"); }
__device__ __forceinline__ void glds16(const void* gsrc, unsigned lds_dst) { unsigned keep;
    asm volatile("s_mov_b32 %0, m0\n\ts_mov_b32 m0, %2\n\ts_nop 0\n\tglobal_load_lds_dwordx4 %1, off\n\ts_mov_b32 m0, %0" : "=&s"(keep) : "v"(gsrc), "s"(lds_dst) : "memory"); }
typedef float f32x2_t __attribute__((ext_vector_type(2))); typedef __bf16 bf16x2_t __attribute__((ext_vector_type(2)));
__device__ __forceinline__ unsigned cvtpk_s(float lo, float hi) { f32x2_t v = {lo, hi}; bf16x2_t b = __builtin_convertvector(v, bf16x2_t); return __builtin_bit_cast(unsigned, b); }
#define WAIT_BAR(N) asm volatile("s_waitcnt vmcnt(" #N ") lgkmcnt(0)\n\ts_barrier" ::: "memory")
typedef __attribute__((address_space(3))) const char* lds_cptr;
typedef short v4i16_t __attribute__((ext_vector_type(4)));
__device__ __forceinline__ void kload8(bf16x8* kf, lds_cptr kp) {
    kf[0] = *(const __attribute__((address_space(3))) bf16x8*)(kp);        kf[1] = *(const __attribute__((address_space(3))) bf16x8*)(kp + 512);
    kf[2] = *(const __attribute__((address_space(3))) bf16x8*)(kp + 2048); kf[3] = *(const __attribute__((address_space(3))) bf16x8*)(kp + 2560);
    kf[4] = *(const __attribute__((address_space(3))) bf16x8*)(kp + 4096); kf[5] = *(const __attribute__((address_space(3))) bf16x8*)(kp + 4608);
    kf[6] = *(const __attribute__((address_space(3))) bf16x8*)(kp + 6144); kf[7] = *(const __attribute__((address_space(3))) bf16x8*)(kp + 6656);
}
__device__ __forceinline__ void kload2(bf16x8* kf, lds_cptr kp, int j) { kf[2 * j] = *(const __attribute__((address_space(3))) bf16x8*)(kp + j * 2048); kf[2 * j + 1] = *(const __attribute__((address_space(3))) bf16x8*)(kp + j * 2048 + 512); }
__device__ __forceinline__ s16x4 vtr(lds_cptr p) { return __builtin_bit_cast(s16x4, __builtin_amdgcn_ds_read_tr16_b64_v4i16((__attribute__((address_space(3))) v4i16_t*)p)); }
#define MX3(a, b, c) __builtin_fmaxf(__builtin_fmaxf((a), (b)), (c))
__device__ __forceinline__ float rowmax32(const f32x16& p0, const f32x16& p1) {
    float a = MX3(p0[0], p0[1], p1[0]), b = MX3(p0[2], p0[3], p1[1]); a = MX3(a, p1[2], p1[3]);
#pragma unroll
    for (int r = 4; r < 16; r += 4) { a = MX3(a, p0[r], p0[r + 1]); b = MX3(b, p0[r + 2], p0[r + 3]); a = MX3(a, p1[r], p1[r + 1]); b = MX3(b, p1[r + 2], p1[r + 3]); }
    float m = __builtin_fmaxf(a, b); auto rr = __builtin_amdgcn_permlane32_swap(__float_as_uint(m), __float_as_uint(m), false, false);
    return __builtin_fmaxf(__uint_as_float(rr[0]), __uint_as_float(rr[1]));
}
__device__ __forceinline__ float halves_sum(float v) { auto rr = __builtin_amdgcn_permlane32_swap(__float_as_uint(v), __float_as_uint(v), false, false); return __uint_as_float(rr[0]) + __uint_as_float(rr[1]); }
__device__ __forceinline__ void bmask(f32x16& p0, f32x16& p1, int Dt, unsigned lim) {
#pragma unroll
    for (int r = 0; r < 16; ++r) { const int x = Dt - ((r & 3) + 8 * (r >> 2)); if ((unsigned)x > lim) p0[r] = -INFINITY; if ((unsigned)(x - 32) > lim) p1[r] = -INFINITY; }
}
__device__ __forceinline__ void pv(f32x16* o, int vb, bf16x8 pa0, bf16x8 pa1, bf16x8 pa2, bf16x8 pa3) {
#pragma unroll
    for (int d0 = 0; d0 < 2; ++d0) { s16x4 lo[4], hi[4];
#pragma unroll
        for (int ks = 0; ks < 4; ++ks) {
            asm volatile("ds_read_b64_tr_b16 %0,%1 offset:%c2" : "=&v"(lo[ks]) : "v"(vb), "i"(d0 * 4096 + ks * 1024) : "memory");
            asm volatile("ds_read_b64_tr_b16 %0,%1 offset:%c2" : "=&v"(hi[ks]) : "v"(vb), "i"(d0 * 4096 + ks * 1024 + 512) : "memory"); }
        asm volatile("s_waitcnt lgkmcnt(0)" ::: "memory"); SBAR();
#define PK(k) (bf16x8){lo[k][0], lo[k][1], lo[k][2], lo[k][3], hi[k][0], hi[k][1], hi[k][2], hi[k][3]}
        o[d0] = __builtin_amdgcn_mfma_f32_32x32x16_bf16(pa0, PK(0), o[d0], 0, 0, 0);
        o[d0] = __builtin_amdgcn_mfma_f32_32x32x16_bf16(pa1, PK(1), o[d0], 0, 0, 0);
        o[d0] = __builtin_amdgcn_mfma_f32_32x32x16_bf16(pa2, PK(2), o[d0], 0, 0, 0);
        o[d0] = __builtin_amdgcn_mfma_f32_32x32x16_bf16(pa3, PK(3), o[d0], 0, 0, 0);
#undef PK
    }
}

template <int OUT> __device__ __forceinline__ void unit_epilogue(const Job& J, float* wsf, unsigned short* stg  , int wid, int lane, float l_reg, float mhat, const f32x16 (&o)[2]) {
    const int r32 = lane & 31, hi = lane >> 5; const long rs = J.rs;
    l_reg = halves_sum(l_reg);
    if (hi == 0) { wsf[32 + r32] = l_reg; wsf[r32] = mhat; }
    asm volatile("s_waitcnt lgkmcnt(0)" ::: "memory");
    const long orow0 = (long)(J.q0 + wid * QBLK);
    if (OUT == OUT_PART) { if (hi == 0) { float* sp = J.stat + (orow0 + r32) * J.srs; *(f32x2*)sp = (f32x2){l_reg, mhat}; } }
#pragma unroll
    for (int hf = 0; hf < 2; ++hf) {
#pragma unroll
        for (int rr = 0; rr < 8; ++rr) { const int r = 8 * hf + rr; const int orow = crow(rr, hi);
            const float sc = (OUT == OUT_FINAL) ? __builtin_amdgcn_rcpf(wsf[32 + crow(r, hi)]) : 1.0f;
#pragma unroll
            for (int d0 = 0; d0 < 2; ++d0) stg[orow * 64 + d0 * 32 + r32] = (unsigned short)(cvtpk_s(o[d0][r] * sc, 0.f) & 0xffffu); }
        asm volatile("s_waitcnt lgkmcnt(0)" ::: "memory");
#pragma unroll
        for (int i = 0; i < 2; ++i) {
            const int srow = i * 8 + (lane >> 3), row = 16 * hf + srow, ch = lane & 7;
            const u32x4 v = *(const u32x4*)(stg + srow * 64 + ch * 8);
            const long go = (orow0 + row) * rs + ch * 8;
            if (OUT == OUT_MERGE) {
                const float l2 = wsf[32 + row], m2 = wsf[row];
                const f32x2 s0 = *(const f32x2*)(J.stat0 + (orow0 + row) * J.srs), s1 = *(const f32x2*)(J.stat1 + (orow0 + row) * J.srs);
                const u32x4 n0 = *(const u32x4*)(J.num0 + go), n1 = *(const u32x4*)(J.num1 + go);
                const float mx = MX3(s0.y, s1.y, m2);
                const float w0 = __builtin_amdgcn_exp2f(s0.y - mx), w1 = __builtin_amdgcn_exp2f(s1.y - mx), w2 = __builtin_amdgcn_exp2f(m2 - mx);
                const float inv = 1.0f / (w0 * s0.x + w1 * s1.x + w2 * l2);
                const float a0 = w0 * inv, a1 = w1 * inv, a2 = w2 * inv;
                u32x4 w;
#pragma unroll
                for (int e = 0; e < 4; ++e) {
                    const float lo = a0 * __uint_as_float(n0[e] << 16) + a1 * __uint_as_float(n1[e] << 16) + a2 * __uint_as_float(v[e] << 16);
                    const float hh = a0 * __uint_as_float(n0[e] & 0xffff0000u) + a1 * __uint_as_float(n1[e] & 0xffff0000u) + a2 * __uint_as_float(v[e] & 0xffff0000u);
                    w[e] = cvtpk_s(lo, hh);
                }
                *(u32x4*)(J.O + go) = w;
            } else {
                if (OUT == OUT_PART) __builtin_nontemporal_store(v, (u32x4*)(J.O + go));
                else *(u32x4*)(J.O + go) = v;
            }
        }
        asm volatile("s_waitcnt lgkmcnt(0)" ::: "memory");
    }
}

__device__ __forceinline__ void ring_issue(const int tid, const Job& J, char* shm) {
    const int lane = tid & 63; const int wid = __builtin_amdgcn_readfirstlane(tid >> 6);
    const long rs = J.rs;
    const bf16* Kh = J.K + (long)J.k0 * rs; const bf16* Vh = J.V + (long)J.k0 * rs;
    const unsigned lds0 = (unsigned)(uintptr_t)shm;
    const bf16* ksrc = Kh + (long)lane * rs + wid * 8;
    const bf16* vsrc = Vh + (long)(16 * (wid & 3) + (lane >> 2)) * rs + (wid >> 2) * 32 + (lane & 3) * 8;
    const unsigned kdst = lds0 + LDS_K + wid * 1024, vdst = lds0 + LDS_V + wid * 1024;
    glds16(ksrc, (unsigned)__builtin_amdgcn_readfirstlane(kdst)); glds16(vsrc, (unsigned)__builtin_amdgcn_readfirstlane(vdst));
    glds16(ksrc + (long)KVBLK * rs, (unsigned)__builtin_amdgcn_readfirstlane(kdst + SLOTB)); glds16(ksrc + (long)2 * KVBLK * rs, (unsigned)__builtin_amdgcn_readfirstlane(kdst + 2 * SLOTB));
}
template <bool MOBA, bool FIXED = false> __device__ __forceinline__ void attn_unit(const int tid, const Job& J, char* shm, float& l_out, float& m_out, f32x16 (&o)[2]) {
    const int lane = tid & 63, r32 = lane & 31, hi = lane >> 5; const int wid = __builtin_amdgcn_readfirstlane(tid >> 6);
    const long rs = J.rs; const int NT = J.NT;
    const bf16* Qw = J.Q + (long)(J.q0 + wid * QBLK) * rs;
    const bf16* Kh = J.K + (long)J.k0 * rs; const bf16* Vh = J.V + (long)J.k0 * rs;
    const unsigned lds0 = (unsigned)(uintptr_t)shm;
    float* wsf = (float*)(shm + LDS_WS) + wid * 64;
    const bf16* ksrc = Kh + (long)lane * rs + wid * 8;
    const bf16* vsrc = Vh + (long)(16 * (wid & 3) + (lane >> 2)) * rs + (wid >> 2) * 32 + (lane & 3) * 8;
    const unsigned kdst = lds0 + LDS_K + wid * 1024, vdst = lds0 + LDS_V + wid * 1024;
#define DMA_K(t, slot) glds16(ksrc + (long)(t) * KVBLK * rs, (unsigned)__builtin_amdgcn_readfirstlane(kdst + (slot)))
#define DMA_V(t, slot) glds16(vsrc + (long)(t) * KVBLK * rs, (unsigned)__builtin_amdgcn_readfirstlane(vdst + (slot)))
    const int vb0 = (int)(lds0 + LDS_V) + ((lane >> 4) & 1) * 32 + (lane & 3) * 8 + (4 * hi + ((lane & 15) >> 2)) * 64;
    bf16x8 kf[8];
    const lds_cptr shm3 = (lds_cptr)shm; const lds_cptr kp0 = shm3 + LDS_K + hi * 1024 + r32 * 16; const lds_cptr vp0 = shm3 + LDS_V + ((lane >> 4) & 1) * 32 + (lane & 3) * 8 + (4 * hi + ((lane & 15) >> 2)) * 64;
    bf16x8 qr[4];
#pragma unroll
    for (int d0 = 0; d0 < 4; ++d0) qr[d0] = *reinterpret_cast<const bf16x8*>(&Qw[(long)r32 * rs + d0 * 16 + hi * 8]);
    unsigned sel = 0xffffffffu;
    if (MOBA) {
        const int ob = J.ob; float gt[16];
        { const float* km = J.kmean + ((r32 < 16) ? r32 : 15) * 64 + hi * 8;
          f32x16 g = f32x16{};
#pragma unroll
          for (int d0 = 0; d0 < 4; ++d0) {
              const f32x4 a = *(const f32x4*)(km + d0 * 16), b = *(const f32x4*)(km + d0 * 16 + 4);
              u32x4 H, L;
              H[0] = cvtpk_s(a[0], a[1]); H[1] = cvtpk_s(a[2], a[3]); H[2] = cvtpk_s(b[0], b[1]); H[3] = cvtpk_s(b[2], b[3]);
              L[0] = cvtpk_s(a[0] - __uint_as_float(H[0] << 16), a[1] - __uint_as_float(H[0] & 0xffff0000u)); L[1] = cvtpk_s(a[2] - __uint_as_float(H[1] << 16), a[3] - __uint_as_float(H[1] & 0xffff0000u));
              L[2] = cvtpk_s(b[0] - __uint_as_float(H[2] << 16), b[1] - __uint_as_float(H[2] & 0xffff0000u)); L[3] = cvtpk_s(b[2] - __uint_as_float(H[3] << 16), b[3] - __uint_as_float(H[3] & 0xffff0000u));
              g = __builtin_amdgcn_mfma_f32_32x32x16_bf16(__builtin_bit_cast(bf16x8, H), qr[d0], g, 0, 0, 0);
              g = __builtin_amdgcn_mfma_f32_32x32x16_bf16(__builtin_bit_cast(bf16x8, L), qr[d0], g, 0, 0, 0);
          }
#pragma unroll
          for (int r = 0; r < 8; ++r) { auto rr = __builtin_amdgcn_permlane32_swap(__float_as_uint(g[r]), __float_as_uint(g[r]), false, false);
              gt[crow(r, 0)] = __uint_as_float(rr[0]); gt[crow(r, 1)] = __uint_as_float(rr[1]); }
        }
        sel = 0u;
#pragma unroll
        for (int k = 0; k < 3; ++k) {
            float best = -INFINITY; int bi = -1;
#pragma unroll
            for (int j = 0; j < 15; ++j) { const bool c = (j < ob) && (((sel >> j) & 1u) == 0u) && (gt[j] > best); best = c ? gt[j] : best; bi = c ? j : bi; }
            if (bi >= 0) sel |= 1u << bi;
        }
        sel |= 1u << ob;
    }
    float mhat = 0.f, l_reg = 0.f; o[0] = f32x16{}; o[1] = f32x16{};
    if (FIXED) { float qq = 0.f;
#pragma unroll
        for (int d0 = 0; d0 < 4; ++d0)
#pragma unroll
            for (int e = 0; e < 8; ++e) { const float v = bf2f((unsigned short)qr[d0][e]); qq += v * v; }
        mhat = __builtin_sqrtf(halves_sum(qq)) * J.kbound; }
    bool selc = MOBA ? ((sel & 1u) != 0u) : true;
    f32x16 negm;
    { const float nv = selc ? -mhat : -INFINITY;
#pragma unroll
      for (int r = 0; r < 16; ++r) negm[r] = nv; }
    asm volatile("" : "+v"(negm));
    const int qrel = wid * QBLK + r32;
    const int D0 = MOBA ? (qrel - 4 * hi) : (J.q0 + qrel - J.k0 - 4 * hi);
    const int toff = MOBA ? (NT - 4) : 0, tmlo = MOBA ? (NT - 4) : 0;
    const unsigned mlim = MOBA ? 0x7fffffffu : 128u;
#define CMASK(P0, P1, t) do { if ((t) >= tmlo) bmask(P0, P1, D0 - 64 * ((t) - toff), mlim); } while (0)
#define SETNEG(j) do { if (MOBA) { selc = ((sel >> (j)) & 1u) != 0u; const float nv_ = selc ? -mhat : -INFINITY; _Pragma("unroll") for (int r = 0; r < 16; ++r) negm[r] = nv_; asm volatile("" : "+v"(negm)); } } while (0)
    bool resc = false;
#define RESC() do { if (resc) { asm volatile("s_waitcnt lgkmcnt(0)" ::: "memory"); \
      _Pragma("unroll") for (int d_ = 0; d_ < 2; ++d_) _Pragma("unroll") for (int r = 0; r < 16; ++r) o[d_][r] *= wsf[crow(r, hi)]; } } while (0)
    f32x16 pA0, pA1, pB0, pB1;
    int sl_prev = 0, sl_cur = 0, sl_next = SLOTB;
#define ROT() do { sl_prev = sl_cur; sl_cur = sl_next; sl_next = (sl_next == (NSLOT - 1) * SLOTB) ? 0 : sl_next + SLOTB; } while (0)
    WAIT_BAR(3);
    kload8(kf, kp0);
    pA0 = __builtin_amdgcn_mfma_f32_32x32x16_bf16(kf[0], qr[0], negm, 0, 0, 0); pA1 = __builtin_amdgcn_mfma_f32_32x32x16_bf16(kf[1], qr[0], negm, 0, 0, 0);
    pA0 = __builtin_amdgcn_mfma_f32_32x32x16_bf16(kf[2], qr[1], pA0, 0, 0, 0);  pA1 = __builtin_amdgcn_mfma_f32_32x32x16_bf16(kf[3], qr[1], pA1, 0, 0, 0);
    pA0 = __builtin_amdgcn_mfma_f32_32x32x16_bf16(kf[4], qr[2], pA0, 0, 0, 0);  pA1 = __builtin_amdgcn_mfma_f32_32x32x16_bf16(kf[5], qr[2], pA1, 0, 0, 0);
    pA0 = __builtin_amdgcn_mfma_f32_32x32x16_bf16(kf[6], qr[3], pA0, 0, 0, 0);  pA1 = __builtin_amdgcn_mfma_f32_32x32x16_bf16(kf[7], qr[3], pA1, 0, 0, 0);
    CMASK(pA0, pA1, 0);
    { const float rm = FIXED ? 0.f : rowmax32(pA0, pA1);
      if (!FIXED && __any(rm > (float)THRL)) { const float dl = __builtin_fmaxf(rm, 0.f); mhat += dl;
#pragma unroll
          for (int r = 0; r < 16; ++r) { pA0[r] -= dl; pA1[r] -= dl; }
          const float nv = selc ? -mhat : -INFINITY;
#pragma unroll
          for (int r = 0; r < 16; ++r) negm[r] = nv;
          asm volatile("" : "+v"(negm)); }
#pragma unroll
      for (int r = 0; r < 16; ++r) { pA0[r] = __builtin_amdgcn_exp2f(pA0[r]); pA1[r] = __builtin_amdgcn_exp2f(pA1[r]); } }
    WAIT_BAR(0);
    DMA_K(3, 0); DMA_V(1, SLOTB);
    ROT();
    kload8(kf, kp0 + sl_cur);
    WAIT_BAR(2);
    s16x4 vlo[8], vhi[8]; u32x4 pw0, pw1, pw2, pw3;
#define PKW(P, B) cvtpk_s(P[B], P[B + 1])
#define PAF(k) __builtin_bit_cast(bf16x8, pw##k)
#define VFR(i) (bf16x8){vlo[i][0], vlo[i][1], vlo[i][2], vlo[i][3], vhi[i][0], vhi[i][1], vhi[i][2], vhi[i][3]}
#define PIN(x) asm volatile("" : "+v"(x))
#define GAPA(MF, A0, A1, A2, A3, W0, W1, PW) do { MF; sacc += A0; sacc += A1; sacc += A2; sacc += A3; PIN(sacc); W0; W1; PIN(PW); SBAR(); } while (0)
#define EX(v) __builtin_amdgcn_exp2f(v)
#define GAPB(MF, X, B) do { MF; X[B] = EX(X[B]); X[B + 1] = EX(X[B + 1]); X[B + 2] = EX(X[B + 2]); X[B + 3] = EX(X[B + 3]); PIN(X); SBAR(); } while (0)
#define VRD(i) do { vlo[i] = vtr(vp_ + (((i) >> 2) * 4096 + ((i) & 3) * 1024)); vhi[i] = vtr(vp_ + (((i) >> 2) * 4096 + ((i) & 3) * 1024 + 512)); } while (0)
#define KRD(G, j) do { if (G) { kload2(kf, kp0 + sl_next, j); SBAR(); } } while (0)
#define STEP(C0, C1, P0, P1, t, GK, GV, GL) do { SBAR(); \
    const lds_cptr vp_ = vp0 + sl_prev; \
    VRD(0); SBAR(); float sacc = (P0[0] + P0[1]); \
    GAPA(C0 = __builtin_amdgcn_mfma_f32_32x32x16_bf16(kf[0], qr[0], negm, 0, 0, 0), P0[2], P0[3], P0[4], P0[5],     pw0[0] = PKW(P0, 0), pw0[1] = PKW(P0, 2), pw0); \
    VRD(4); SBAR(); GAPA(C1 = __builtin_amdgcn_mfma_f32_32x32x16_bf16(kf[1], qr[0], negm, 0, 0, 0), P0[6], P0[7], P0[8], P0[9],     pw0[2] = PKW(P0, 4), pw0[3] = PKW(P0, 6), pw0); \
    VRD(1); SBAR(); GAPA(C0 = __builtin_amdgcn_mfma_f32_32x32x16_bf16(kf[2], qr[1], C0, 0, 0, 0),   P0[10], P0[11], P0[12], P0[13], pw1[0] = PKW(P0, 8), pw1[1] = PKW(P0, 10), pw1); \
    VRD(5); SBAR(); GAPA(C1 = __builtin_amdgcn_mfma_f32_32x32x16_bf16(kf[3], qr[1], C1, 0, 0, 0),   P0[14], P0[15], P1[0], P1[1],   pw1[2] = PKW(P0, 12), pw1[3] = PKW(P0, 14), pw1); \
    VRD(2); SBAR(); GAPA(C0 = __builtin_amdgcn_mfma_f32_32x32x16_bf16(kf[4], qr[2], C0, 0, 0, 0),   P1[2], P1[3], P1[4], P1[5],     pw2[0] = PKW(P1, 0), pw2[1] = PKW(P1, 2), pw2); \
    VRD(6); SBAR(); GAPA(C1 = __builtin_amdgcn_mfma_f32_32x32x16_bf16(kf[5], qr[2], C1, 0, 0, 0),   P1[6], P1[7], P1[8], P1[9],     pw2[2] = PKW(P1, 4), pw2[3] = PKW(P1, 6), pw2); \
    VRD(3); SBAR(); GAPA(C0 = __builtin_amdgcn_mfma_f32_32x32x16_bf16(kf[6], qr[3], C0, 0, 0, 0),   P1[10], P1[11], P1[12], P1[13], pw3[0] = PKW(P1, 8), pw3[1] = PKW(P1, 10), pw3); \
    VRD(7); SBAR(); GAPA(C1 = __builtin_amdgcn_mfma_f32_32x32x16_bf16(kf[7], qr[3], C1, 0, 0, 0),   P1[14], P1[15], 0.f, 0.f,       pw3[2] = PKW(P1, 12), pw3[3] = PKW(P1, 14), pw3); \
    l_reg += sacc; \
    if (GK) { DMA_K((t) + 3, sl_cur); } if (GV) { DMA_V((t) + 1, sl_next); } \
    CMASK(C0, C1, t); \
    if (!FIXED) { float a = MX3(C0[0], C0[1], C1[0]), b = MX3(C0[2], C0[3], C1[1]); a = MX3(a, C1[2], C1[3]); \
      _Pragma("unroll") for (int r = 4; r < 16; r += 4) { a = MX3(a, C0[r], C0[r + 1]); b = MX3(b, C0[r + 2], C0[r + 3]); a = MX3(a, C1[r], C1[r + 1]); b = MX3(b, C1[r + 2], C1[r + 3]); } \
      float rm = __builtin_fmaxf(a, b); { auto rr = __builtin_amdgcn_permlane32_swap(__float_as_uint(rm), __float_as_uint(rm), false, false); rm = __builtin_fmaxf(__uint_as_float(rr[0]), __uint_as_float(rr[1])); } \
      resc = false; \
      if (__builtin_expect(__any(rm > (float)THRL), 0)) { const float dl = __builtin_fmaxf(rm, 0.f); mhat += dl; \
        _Pragma("unroll") for (int r = 0; r < 16; ++r) { C0[r] -= dl; C1[r] -= dl; } \
        { const float nv_ = selc ? -mhat : -INFINITY; _Pragma("unroll") for (int r = 0; r < 16; ++r) negm[r] = nv_; } asm volatile("" : "+v"(negm)); \
        const float f = __builtin_amdgcn_exp2f(-dl); l_reg *= f; if (hi == 0) wsf[r32] = f; resc = true; } } \
    SBAR(); \
    GAPB(o[0] = __builtin_amdgcn_mfma_f32_32x32x16_bf16(PAF(0), VFR(0), o[0], 0, 0, 0), C0, 0); \
    GAPB(o[1] = __builtin_amdgcn_mfma_f32_32x32x16_bf16(PAF(0), VFR(4), o[1], 0, 0, 0), C0, 4); \
    KRD(GL, 0); GAPB(o[0] = __builtin_amdgcn_mfma_f32_32x32x16_bf16(PAF(1), VFR(1), o[0], 0, 0, 0), C0, 8); \
    KRD(GL, 1); GAPB(o[1] = __builtin_amdgcn_mfma_f32_32x32x16_bf16(PAF(1), VFR(5), o[1], 0, 0, 0), C0, 12); \
    KRD(GL, 2); GAPB(o[0] = __builtin_amdgcn_mfma_f32_32x32x16_bf16(PAF(2), VFR(2), o[0], 0, 0, 0), C1, 0); \
    KRD(GL, 3); GAPB(o[1] = __builtin_amdgcn_mfma_f32_32x32x16_bf16(PAF(2), VFR(6), o[1], 0, 0, 0), C1, 4); \
    GAPB(o[0] = __builtin_amdgcn_mfma_f32_32x32x16_bf16(PAF(3), VFR(3), o[0], 0, 0, 0), C1, 8); \
    GAPB(o[1] = __builtin_amdgcn_mfma_f32_32x32x16_bf16(PAF(3), VFR(7), o[1], 0, 0, 0), C1, 12); \
    } while (0)
#define NEWBLK(t) do { if (MOBA && (((t) & 3) == 0)) SETNEG((t) >> 2); } while (0)
    int t = 1;
    if (MOBA) {
        for (; t + 5 < NT; t += 2) {
#undef CMASK
#define CMASK(P0, P1, t) do { } while (0)
            STEP(pB0, pB1, pA0, pA1, t, true, true, true);       WAIT_BAR(2); RESC(); ROT(); NEWBLK(t + 1);
            STEP(pA0, pA1, pB0, pB1, t + 1, true, true, true);   WAIT_BAR(2); RESC(); ROT();
        }
    }
#undef CMASK
#define CMASK(P0, P1, t) do { if ((t) >= tmlo) bmask(P0, P1, D0 - 64 * ((t) - toff), mlim); } while (0)
#define ENDW(tt) do { if ((tt) + 3 < NT) { WAIT_BAR(2); } else if ((tt) + 2 < NT) { WAIT_BAR(1); } else { WAIT_BAR(0); } } while (0)
    for (; t + 1 < NT; t += 2) {
        STEP(pB0, pB1, pA0, pA1, t, (t + 3 < NT), (t + 1 < NT), (t + 1 < NT));       ENDW(t);     RESC(); ROT(); NEWBLK(t + 1);
        STEP(pA0, pA1, pB0, pB1, t + 1, (t + 4 < NT), (t + 2 < NT), (t + 2 < NT));   ENDW(t + 1); RESC(); ROT();
    }
    STEP(pB0, pB1, pA0, pA1, NT - 1, false, false, false); RESC();
    { float sacc = pB0[0] + pB0[1];
#pragma unroll
      for (int r = 2; r < 16; ++r) sacc += pB0[r];
#pragma unroll
      for (int r = 0; r < 16; ++r) sacc += pB1[r];
      l_reg += sacc;
      pw0 = (u32x4){PKW(pB0, 0), PKW(pB0, 2), PKW(pB0, 4), PKW(pB0, 6)}; pw1 = (u32x4){PKW(pB0, 8), PKW(pB0, 10), PKW(pB0, 12), PKW(pB0, 14)};
      pw2 = (u32x4){PKW(pB1, 0), PKW(pB1, 2), PKW(pB1, 4), PKW(pB1, 6)}; pw3 = (u32x4){PKW(pB1, 8), PKW(pB1, 10), PKW(pB1, 12), PKW(pB1, 14)};
      SBAR(); pv(o, vb0 + sl_cur, PAF(0), PAF(1), PAF(2), PAF(3)); }
    l_out = l_reg; m_out = mhat;
    asm volatile("s_waitcnt lgkmcnt(0)\n\ts_barrier" ::: "memory");
#undef DMA_K
#undef DMA_V
#undef CMASK
#undef SETNEG
#undef NEWBLK
#undef RESC
#undef ROT
#undef PKW
#undef PAF
#undef VFR
#undef PIN
#undef GAPA
#undef GAPB
#undef EX
#undef VRD
#undef KRD
#undef STEP
#undef ENDW
}

constexpr int BK_K = 0, BK_V = 6 * SLOTB, BK_Q = 12 * SLOTB, BK_WS = 16 * SLOTB, BK_OST = BK_WS + NW * 256, BK_BYTES = BK_OST + NW * 2048;
__device__ __forceinline__ int ring6(int t, int rot) { const int s_ = t + rot; return s_ >= 6 ? s_ - 6 : s_; }
__device__ __forceinline__ void band_issue_kq(const int tid, const Job& J, char* shm, const bool first, const bool cont, const int rot) {
    const int lane = tid & 63; const int wid = __builtin_amdgcn_readfirstlane(tid >> 6);
    const long rs = J.rs; const unsigned lds0 = (unsigned)(uintptr_t)shm;
    const int prow = 8 * wid + (lane >> 3), pch = (lane & 7) ^ (lane >> 3);
    const bf16* ksrc = J.K + (long)(J.q0 - 128 + prow) * rs + pch * 8;
    const unsigned kdst = lds0 + BK_K + wid * 1024;
#pragma unroll
    for (int t = 0; t < 6; ++t) { if (cont && t < 2) continue; const int ts = (first && t < 2) ? 2 : t; glds16(ksrc + (long)ts * KVBLK * rs, (unsigned)__builtin_amdgcn_readfirstlane(kdst + ring6(t, rot) * SLOTB)); }
    const bf16* qsrc = J.Q + (long)(J.q0 + prow) * rs + pch * 8;
    const unsigned qdst = lds0 + BK_Q + wid * 1024;
#pragma unroll
    for (int g = 0; g < 4; ++g) glds16_nt(qsrc + (long)g * KVBLK * rs, (unsigned)__builtin_amdgcn_readfirstlane(qdst + g * SLOTB));
}
__device__ __forceinline__ void band_issue_v(const int tid, const Job& J, char* shm, const bool first, const bool cont, const int rot) {
    const int lane = tid & 63; const int wid = __builtin_amdgcn_readfirstlane(tid >> 6);
    const long rs = J.rs; const unsigned lds0 = (unsigned)(uintptr_t)shm;
    const bf16* vsrc = J.V + (long)(J.q0 - 128 + 16 * (wid & 3) + (lane >> 2)) * rs + (wid >> 2) * 32 + (lane & 3) * 8;
    const unsigned vdst = lds0 + BK_V + wid * 1024;
#pragma unroll
    for (int t = 0; t < 6; ++t) { if (cont && t < 2) continue; const int ts = (first && t < 2) ? 2 : t; glds16(vsrc + (long)ts * KVBLK * rs, (unsigned)__builtin_amdgcn_readfirstlane(vdst + ring6(t, rot) * SLOTB)); }
}
__device__ __forceinline__ void band_pass1(const int tid, char* shm, const bool first, const bool cont  , const int rot, u32x4 (&pw)[5][2], float& l_out, float& m_out) {
    const int lane = tid & 63, r32 = lane & 31, hi = lane >> 5; const int wid = __builtin_amdgcn_readfirstlane(tid >> 6);
    const lds_cptr shm3 = (lds_cptr)shm;
    int foff[4];
#pragma unroll
    for (int d0 = 0; d0 < 4; ++d0) foff[d0] = r32 * 128 + (((2 * d0 + hi) ^ (r32 & 7)) * 16);
    const lds_cptr kp0 = shm3 + BK_K;
    if (cont) asm volatile("s_waitcnt vmcnt(4)" ::: "memory"); else asm volatile("s_waitcnt vmcnt(6)" ::: "memory");
    asm volatile("s_waitcnt lgkmcnt(0)\n\ts_barrier" ::: "memory");
    bf16x8 qr[4];
    { const lds_cptr qp = shm3 + BK_Q + (wid >> 1) * SLOTB + (wid & 1) * 4096;
#pragma unroll
      for (int d0 = 0; d0 < 4; ++d0) qr[d0] = *(const __attribute__((address_space(3))) bf16x8*)(qp + foff[d0]); }
    f32x16 p[5];
#pragma unroll
    for (int j = 0; j < 5; ++j) {
        const int s = wid + j;
        if (first && s < 4) {
#pragma unroll
            for (int r = 0; r < 16; ++r) p[j][r] = -INFINITY;
        } else {
            const lds_cptr kp = kp0 + ring6(s >> 1, rot) * SLOTB + (s & 1) * 4096;
            bf16x8 kf[4];
#pragma unroll
            for (int d0 = 0; d0 < 4; ++d0) kf[d0] = *(const __attribute__((address_space(3))) bf16x8*)(kp + foff[d0]);
            f32x16 q = __builtin_amdgcn_mfma_f32_32x32x16_bf16(kf[0], qr[0], f32x16{}, 0, 0, 0);
            q = __builtin_amdgcn_mfma_f32_32x32x16_bf16(kf[1], qr[1], q, 0, 0, 0);
            q = __builtin_amdgcn_mfma_f32_32x32x16_bf16(kf[2], qr[2], q, 0, 0, 0);
            p[j] = __builtin_amdgcn_mfma_f32_32x32x16_bf16(kf[3], qr[3], q, 0, 0, 0);
        }
    }
#pragma unroll
    for (int r = 0; r < 16; ++r) { if (crow(r, hi) < r32) p[0][r] = -INFINITY; if (crow(r, hi) > r32) p[4][r] = -INFINITY; }
    float rm;
    { float a = MX3(p[0][0], p[0][1], p[0][2]);
#pragma unroll
      for (int j = 0; j < 5; ++j)
#pragma unroll
          for (int r = (j == 0 ? 3 : 0); r + 1 < 16; r += 2) a = MX3(a, p[j][r], p[j][r + 1]);
      a = __builtin_fmaxf(a, p[0][15]);
      auto rr = __builtin_amdgcn_permlane32_swap(__float_as_uint(a), __float_as_uint(a), false, false); rm = __builtin_fmaxf(__uint_as_float(rr[0]), __uint_as_float(rr[1])); }
    float mhat = 0.f;
    if (__builtin_expect(__any(rm > (float)THRL), 0)) { mhat = __builtin_fmaxf(rm, 0.f);
#pragma unroll
        for (int j = 0; j < 5; ++j)
#pragma unroll
            for (int r = 0; r < 16; ++r) p[j][r] -= mhat; }
    float l_reg = 0.f;
#pragma unroll
    for (int j = 0; j < 5; ++j) {
        float sacc = 0.f;
#pragma unroll
        for (int r = 0; r < 16; ++r) { p[j][r] = __builtin_amdgcn_exp2f(p[j][r]); sacc += p[j][r]; }
        l_reg += sacc;
        pw[j][0] = (u32x4){cvtpk_s(p[j][0], p[j][1]), cvtpk_s(p[j][2], p[j][3]), cvtpk_s(p[j][4], p[j][5]), cvtpk_s(p[j][6], p[j][7])};
        pw[j][1] = (u32x4){cvtpk_s(p[j][8], p[j][9]), cvtpk_s(p[j][10], p[j][11]), cvtpk_s(p[j][12], p[j][13]), cvtpk_s(p[j][14], p[j][15])};
    }
    l_out = l_reg; m_out = mhat;
    asm volatile("s_waitcnt lgkmcnt(0)\n\ts_barrier" ::: "memory");
}
__device__ __forceinline__ void band_pass2(const int tid, char* shm, const bool first, const bool last_unit, const bool cont_next  , const int rot, const u32x4 (&pw)[5][2], f32x16 (&o)[2]) {
    const int lane = tid & 63, hi = lane >> 5; const int wid = __builtin_amdgcn_readfirstlane(tid >> 6);
    const lds_cptr shm3 = (lds_cptr)shm;
    const lds_cptr vp0 = shm3 + BK_V + ((lane >> 4) & 1) * 32 + (lane & 3) * 8 + (4 * hi + ((lane & 15) >> 2)) * 64;
    if (last_unit) asm volatile("s_waitcnt vmcnt(0)" ::: "memory"); else if (cont_next) asm volatile("s_waitcnt vmcnt(8)" ::: "memory"); else asm volatile("s_waitcnt vmcnt(10)" ::: "memory");
    asm volatile("s_waitcnt lgkmcnt(0)\n\ts_barrier" ::: "memory");
    o[0] = f32x16{}; o[1] = f32x16{};
#pragma unroll
    for (int j = 0; j < 5; ++j) {
        const int s = wid + j;
        if (first && s < 4) continue;
        const lds_cptr vp = vp0 + ring6(s >> 1, rot) * SLOTB + (s & 1) * 2048;
#pragma unroll
        for (int d0 = 0; d0 < 2; ++d0) {
            const s16x4 l0 = vtr(vp + d0 * 4096), h0 = vtr(vp + d0 * 4096 + 512), l1 = vtr(vp + d0 * 4096 + 1024), h1 = vtr(vp + d0 * 4096 + 1024 + 512);
            const bf16x8 v0 = (bf16x8){l0[0], l0[1], l0[2], l0[3], h0[0], h0[1], h0[2], h0[3]}, v1 = (bf16x8){l1[0], l1[1], l1[2], l1[3], h1[0], h1[1], h1[2], h1[3]};
            o[d0] = __builtin_amdgcn_mfma_f32_32x32x16_bf16(__builtin_bit_cast(bf16x8, pw[j][0]), v0, o[d0], 0, 0, 0);
            o[d0] = __builtin_amdgcn_mfma_f32_32x32x16_bf16(__builtin_bit_cast(bf16x8, pw[j][1]), v1, o[d0], 0, 0, 0);
        }
    }
    asm volatile("s_waitcnt lgkmcnt(0)\n\ts_barrier" ::: "memory");
}
#undef SBAR
#undef WAIT_BAR
#undef MX3
}

constexpr int NWAVES = 8;
constexpr size_t MiB = 1u << 20;
constexpr size_t WS_CTL = 0, CTL_ZERO_BYTES = 1 * MiB;
constexpr size_t WS_ROPE = 1 * MiB;
constexpr size_t WS_SS = 2 * MiB;
constexpr size_t SS_B_OFF = (size_t)MTOK * 4;
constexpr size_t WS_KMEAN = 4 * MiB;
constexpr size_t WS_STAT = 5 * MiB;
constexpr size_t WS_EDGE = 16 * MiB;
constexpr size_t WS_W = 32 * MiB;
constexpr size_t W_QKVA = 0, W_OA = W_QKVA + (size_t)9216 * 1024, W_UP0 = W_OA + (size_t)1024 * 1024, W_DN0 = W_UP0 + (size_t)NUP * 1024,
                 W_QKVB = W_DN0 + (size_t)1024 * DFF, W_OB = W_QKVB + (size_t)3072 * 1024, W_UP1 = W_OB + (size_t)1024 * 1024, W_DN1 = W_UP1 + (size_t)NUP * 1024,
                 W_END = W_DN1 + (size_t)1024 * DFF;
static_assert(W_END * 2 <= 64 * MiB, "weights fit 64 MiB");
constexpr size_t WS_XN = 96 * MiB;
constexpr size_t WS_Q = 160 * MiB, WS_K = 224 * MiB, WS_V = 288 * MiB, WS_ATT = 352 * MiB;
constexpr size_t WS_HH = 160 * MiB;
constexpr size_t WS_END = 416 * MiB;
static_assert(WS_HH + (size_t)MTOK * DFF * 2 <= WS_ATT, "Hh overlay");

constexpr int RING_BYTES = 131072, XLDS_OFF = RING_BYTES, XLDS_BYTES = XL_END, LDS_BYTES = 163840;
static_assert(attn::LDS_BYTES <= RING_BYTES && attn::BK_BYTES <= LDS_BYTES - 64 && XLDS_OFF + XLDS_BYTES <= LDS_BYTES, "LDS map");

struct Args { const float* in[15]; float* out; unsigned char* ws; int ph_lo, ph_hi; };
static_assert(sizeof(Args) == 15 * 8 + 8 + 8 + 8, "no padding");

__device__ __forceinline__ unsigned f2bf(float f) { unsigned u = __builtin_bit_cast(unsigned, f); return (u + 0x7fffu + ((u >> 16) & 1u)) >> 16; }
__device__ __forceinline__ unsigned pk2(float lo, float hi) { return f2bf(lo) | (f2bf(hi) << 16); }
__device__ __forceinline__ float wave_sum(float v) {
#pragma unroll
    for (int o = 1; o < 64; o <<= 1) v += __shfl_xor(v, o);
    return v;
}
__device__ __forceinline__ int dinv(int d) { return (d < 4) ? d : (d < 8) ? d + 4 : (d < 12) ? d - 4 : d; }
__device__ __forceinline__ int tileperm(int which_is_qk, int h, int d) { const int p = (which_is_qk && d < 16) ? dinv(d) : d; return (h >> 2) * 256 + (p >> 5) * 128 + (h & 3) * 32 + (p & 31); }
template <int KIND> __device__ __forceinline__ int permrow(int n) {
    if (KIND == 1) { const int which = n / 3072, g = (n % 3072) / 1024, h = (n % 1024) / 64, d = n % 64; return g * 3072 + which * 1024 + tileperm(which < 2, h, d); }
    if (KIND == 2) { const int which = n / 1024, h = (n % 1024) / 64, d = n % 64; return which * 1024 + tileperm(which < 2, h, d); }
    if (KIND == 3) { const int isval = n >= DFF, j = n - isval * DFF; return 256 * (j >> 7) + 128 * isval + (j & 127); }
    return n;
}
template <int KIND> __device__ __forceinline__ void transpose_item(const float* W, int K, int N, bf16* WT, LAS float* scr, int item, int lane, const float* gk = nullptr) {
    const int nblk = N / 32, kb = item / nblk, nb = item % nblk, k0 = 64 * kb, n0 = 32 * nb;
    float wv[32];
#pragma unroll
    for (int i = 0; i < 32; ++i) wv[i] = __builtin_nontemporal_load(&W[(size_t)(k0 + 2 * i + (lane >> 5)) * N + n0 + (lane & 31)]);
#pragma unroll
    for (int i = 0; i < 32; ++i) scr[(2 * i + (lane >> 5)) * 33 + (lane & 31)] = wv[i];
    asm volatile("s_waitcnt lgkmcnt(0)" ::: "memory");
    const int c = lane & 7;
    f32x4 ga = (f32x4){1.f, 1.f, 1.f, 1.f}, gb = ga;
    if (gk) { ga = *(const f32x4*)(gk + k0 + 8 * c); gb = *(const f32x4*)(gk + k0 + 8 * c + 4); }
#pragma unroll
    for (int j = 0; j < 4; ++j) { const int n = (lane >> 3) + 8 * j; const LAS float* s = scr + (8 * c) * 33 + n;
        u32x4 o; o.x = pk2(s[0 * 33] * ga[0], s[1 * 33] * ga[1]); o.y = pk2(s[2 * 33] * ga[2], s[3 * 33] * ga[3]); o.z = pk2(s[4 * 33] * gb[0], s[5 * 33] * gb[1]); o.w = pk2(s[6 * 33] * gb[2], s[7 * 33] * gb[3]);
        *(u32x4*)(WT + (size_t)permrow<KIND>(n0 + n) * K + k0 + 8 * c) = o; }
    asm volatile("s_waitcnt lgkmcnt(0)" ::: "memory");
}

template <class T> __device__ __forceinline__ T* uptr(T* p) {
    const unsigned long long v = (unsigned long long)p; const unsigned lo = __builtin_amdgcn_readfirstlane((unsigned)v), hi = __builtin_amdgcn_readfirstlane((unsigned)(v >> 32));
    return (T*)(__attribute__((address_space(1))) T*)(((unsigned long long)hi << 32) | lo); }
struct Frame {
    LAS unsigned char* lds; char* lds_generic;
    int tid, wave, vcu, bx, G;
    unsigned long long karg; float* out; unsigned char* ws;
    __device__ __forceinline__ const float* inp(int k) const {
        typedef unsigned long long __attribute__((address_space(4))) const* kp_t;
        return (const float*)(const __attribute__((address_space(1))) float*)(((kp_t)karg)[k]); }
};
#define FLANE (F.tid & 63)

__device__ __forceinline__ void phase_prologue(Frame& F) {
    LAS float* scr = (LAS float*)(F.lds + F.wave * 16384);
    const int gw = F.vcu * NWAVES + F.wave, NGW = F.G * NWAVES;
    bf16* WB = (bf16*)(F.ws + WS_W);
    constexpr int I_QKVA = 16 * (9216 / 32), I_O = 16 * 32, I_UP = 16 * (NUP / 32), I_DN = (DFF / 64) * 32, I_QKVB = 16 * (3072 / 32);
    constexpr int NITEMS = I_QKVA + I_O + I_UP + I_DN + I_QKVB + I_O + I_UP + I_DN;
    for (int it = gw; it < NITEMS; it += NGW) {
        int r = it;
        if (r < I_QKVA) { transpose_item<1>(F.inp(2), 1024, 9216, WB + W_QKVA, scr, r, FLANE, F.inp(1)); continue; } r -= I_QKVA;
        if (r < I_O) { transpose_item<0>(F.inp(5), 1024, 1024, WB + W_OA, scr, r, FLANE); continue; } r -= I_O;
        if (r < I_UP) { transpose_item<3>(F.inp(11), 1024, NUP, WB + W_UP0, scr, r, FLANE, F.inp(10)); continue; } r -= I_UP;
        if (r < I_DN) { transpose_item<0>(F.inp(14), DFF, 1024, WB + W_DN0, scr, r, FLANE); continue; } r -= I_DN;
        if (r < I_QKVB) { transpose_item<2>(F.inp(6), 1024, 3072, WB + W_QKVB, scr, r, FLANE, F.inp(1) + 1024); continue; } r -= I_QKVB;
        if (r < I_O) { transpose_item<0>(F.inp(9), 1024, 1024, WB + W_OB, scr, r, FLANE); continue; } r -= I_O;
        if (r < I_UP) { transpose_item<3>(F.inp(11) + (size_t)1024 * NUP, 1024, NUP, WB + W_UP1, scr, r, FLANE, F.inp(10) + 1024); continue; } r -= I_UP;
        transpose_item<0>(F.inp(14) + (size_t)DFF * 1024, DFF, 1024, WB + W_DN1, scr, r, FLANE);
    }
    { float* km = (float*)(F.ws + WS_KMEAN); for (int i = (F.vcu * NWAVES + F.wave) * 64 + FLANE; i < BATCH * NHEADS * 16 * 64; i += F.G * NWAVES * 64) km[i] = 0.f; }
    {
        float* cosT = (float*)(F.ws + WS_ROPE); float* sinT = cosT + SEQ * 8;
        const int gt = (F.vcu * NWAVES + F.wave) * 64 + FLANE;
        if (gt < SEQ * 8) { const int pos = gt >> 3, i = gt & 7;
            const float inv = (i == 0) ? 1.0f : (i == 1) ? 1.939227432e-01f : (i == 2) ? 3.760603070e-02f : (i == 3) ? 7.292664610e-03f : (i == 4) ? 1.414213562e-03f : (i == 5) ? 2.742481884e-04f : (i == 6) ? 5.318295734e-05f : 1.031338525e-05f;
            const float ang = (float)pos * inv; cosT[gt] = cosf(ang); sinT[gt] = sinf(ang); }
    }
    {
        const float* x = F.inp(0); bf16* XN = (bf16*)(F.ws + WS_XN); float* SS = (float*)(F.ws + WS_SS);
        for (int m0 = gw * 4; m0 < MTOK; m0 += NGW * 4) {
            f32x4 v[4][4]; float s[4];
#pragma unroll
            for (int r = 0; r < 4; ++r) { const f32x4* xr = (const f32x4*)(x + (size_t)(m0 + r) * DMODEL) + FLANE;
#pragma unroll
                for (int j = 0; j < 4; ++j) v[r][j] = __builtin_nontemporal_load(&xr[64 * j]); }
#pragma unroll
            for (int r = 0; r < 4; ++r) { s[r] = (dot4(v[r][0]) + dot4(v[r][1])) + (dot4(v[r][2]) + dot4(v[r][3])); s[r] = wave_sum(s[r]); }
#pragma unroll
            for (int r = 0; r < 4; ++r) {
                unsigned long long* o8 = (unsigned long long*)(XN + (size_t)(m0 + r) * DMODEL) + FLANE;
#pragma unroll
                for (int j = 0; j < 4; ++j) { const f32x4 y = v[r][j]; o8[64 * j] = (unsigned long long)pk2(y[0], y[1]) | ((unsigned long long)pk2(y[2], y[3]) << 32); }
                if (FLANE == 0) { SS[m0 + r] = s[r]; SS[MTOK + m0 + r] = 0.f; }
            }
        }
    }
}

template <bool KMSUM> __device__ __forceinline__ void phase_gemm_qkv(Frame& F, const bf16* Wt, const float* qg, const float* kg) {
    Wt = uptr(Wt); qg = uptr(qg); kg = uptr(kg);
    pg8::Gemm g{(const bf16*)(F.ws + WS_XN), Wt, MTOK, 3072, 1024}; pg8::StaticOrder S; S.init(MTOK, 3072, F.G, F.bx);
    const float* cosT = (const float*)(F.ws + WS_ROPE);
    EpiQKV<KMSUM> E{(float*)(F.ws + WS_KMEAN), (bf16*)(F.ws + WS_Q), (WS_K - WS_Q) / 2, (const float*)(F.ws + WS_SS), qg, kg, cosT, cosT + SEQ * 8};
    static_assert(WS_V - WS_K == WS_K - WS_Q, "Q|K|V equally spaced");
    pg8::gemm_phase<EpiQKV<KMSUM>, pg8::StaticOrder>(F.tid, F.lds, F.lds + XLDS_OFF, g, S, E);
}
template <bool RES_F32, bool OUT_F32> __device__ __forceinline__ void phase_gemm_res(Frame& F, const bf16* A, const bf16* Wt, int K, const void* resid, void* out, bool has_ss, size_t ssoff) {
    A = uptr(A); Wt = uptr(Wt); resid = (const void*)uptr((const char*)resid); out = (void*)uptr((char*)out); K = __builtin_amdgcn_readfirstlane(K);
    pg8::Gemm g{A, Wt, MTOK, 1024, K}; pg8::StaticOrder S; S.init(MTOK, 1024, F.G, F.bx);
    EpiRes<RES_F32, OUT_F32> E{resid, out, has_ss ? (float*)(F.ws + WS_SS + ssoff) : nullptr};
    pg8::gemm_phase<EpiRes<RES_F32, OUT_F32>, pg8::StaticOrder>(F.tid, F.lds, F.lds + XLDS_OFF, g, S, E);
}
__device__ __forceinline__ void phase_gemm_up(Frame& F, const bf16* Wt, const float* cw, const float* cb) {
    Wt = uptr(Wt); cw = uptr(cw); cb = uptr(cb);
    pg8::Gemm g{(const bf16*)(F.ws + WS_XN), Wt, MTOK, NUP, 1024}; pg8::StaticOrder S; S.init(MTOK, NUP, F.G, F.bx);
    EpiUpConv E{(const float*)(F.ws + WS_SS + SS_B_OFF), cw, cb, (bf16*)(F.ws + WS_HH), (float*)(F.ws + WS_EDGE)};
    pg8::gemm_phase<EpiUpConv, pg8::StaticOrder>(F.tid, F.lds, F.lds + XLDS_OFF, g, S, E);
}
__device__ __forceinline__ void phase_fixup(Frame& F, const float* cw, const float* cb) {
    const float* edge = (const float*)(F.ws + WS_EDGE); bf16* Hh = (bf16*)(F.ws + WS_HH);
    const int gt = (F.vcu * NWAVES + F.wave) * 64 + FLANE, NT = F.G * NWAVES * 64;
    { float* ssa = (float*)(F.ws + WS_SS); for (int i = gt; i < 2 * MTOK; i += NT) ssa[i] = 0.f; }
    constexpr int NJ = DFF / 4;
    for (int it = gt; it < 128 * NJ; it += NT) {
        const int pm = it / NJ, j = (it % NJ) * 4;
        if ((pm & 15) == 0) continue;
        const int pg = 256 * (j >> 7) + (j & 127);
        f32x4 uc[2][2];
#pragma unroll
        for (int bj = 0; bj < 2; ++bj) {
            const int lc = bj * DFF + j, pc = pg + bj * 128;
            const f32x4 w0 = *(const f32x4*)(cw + lc), w1 = *(const f32x4*)(cw + NUP + lc), w2 = *(const f32x4*)(cw + 2 * NUP + lc), bb = *(const f32x4*)(cb + lc);
            const float* ep = edge + (size_t)(pm - 1) * EDGE_ROWS * NUP + pc; const float* ec = edge + (size_t)pm * EDGE_ROWS * NUP + pc;
            const f32x4 u254 = *(const f32x4*)(ep + 2 * (size_t)NUP), u255 = *(const f32x4*)(ep + 3 * (size_t)NUP), u0 = *(const f32x4*)(ec), u1 = *(const f32x4*)(ec + NUP);
            uc[bj][0] = bb + w0 * u254 + w1 * u255 + w2 * u0;
            uc[bj][1] = bb + w0 * u255 + w1 * u0 + w2 * u1;
        }
#pragma unroll
        for (int r = 0; r < 2; ++r) {
            u32x2 w; w.x = pg8::cvt_pk_bf16(silu_mul(uc[0][r][0], uc[1][r][0]), silu_mul(uc[0][r][1], uc[1][r][1]));
            w.y = pg8::cvt_pk_bf16(silu_mul(uc[0][r][2], uc[1][r][2]), silu_mul(uc[0][r][3], uc[1][r][3]));
            *(u32x2*)(Hh + (size_t)(pm * 256 + r) * DFF + j) = w;
        }
    }
}
__device__ __forceinline__ void phase_kmean(Frame& F) {
    const bf16* Kb = (const bf16*)(F.ws + WS_K); float* KM = (float*)(F.ws + WS_KMEAN);
    const int gw = F.vcu * NWAVES + F.wave, NGW = F.G * NWAVES;
    { float* ssb = (float*)(F.ws + WS_SS + SS_B_OFF); for (int i = gw * 64 + FLANE; i < MTOK; i += NGW * 64) ssb[i] = 0.f; }
    for (int task = gw; task < BATCH * NHEADS * 16; task += NGW) {
        const int b = task >> 8, h = (task >> 4) & 15, n = task & 15;
        const int sub = FLANE >> 3, ch = FLANE & 7;
        const bf16* base = Kb + (size_t)(b * SEQ + n * 256 + sub) * DMODEL + h * 64 + ch * 8;
        float a[8];
#pragma unroll
        for (int e = 0; e < 8; ++e) a[e] = 0.f;
#pragma unroll 8
        for (int i = 0; i < 32; ++i) {
            const u32x4 v = *(const u32x4*)(base + (size_t)i * 8 * DMODEL);
#pragma unroll
            for (int e = 0; e < 4; ++e) { a[2 * e] += __uint_as_float(v[e] << 16); a[2 * e + 1] += __uint_as_float(v[e] & 0xffff0000u); }
        }
#pragma unroll
        for (int e = 0; e < 8; ++e) { a[e] += __shfl_xor(a[e], 8); a[e] += __shfl_xor(a[e], 16); a[e] += __shfl_xor(a[e], 32); a[e] *= (1.0f / 256.0f); }
        if (sub == 0) { float* o = KM + (size_t)task * 64 + ch * 8; *(f32x4*)o = (f32x4){a[0], a[1], a[2], a[3]}; *(f32x4*)(o + 4) = (f32x4){a[4], a[5], a[6], a[7]}; }
    }
}
template <int OUT> __device__ __forceinline__ void band_job(Frame& F, int i, int dil, int gidx, attn::Job& J, bool& first) {
    const bf16* Q = (const bf16*)(F.ws + WS_Q); const bf16* K = (const bf16*)(F.ws + WS_K); const bf16* V = (const bf16*)(F.ws + WS_V);
    bf16* num0 = (bf16*)F.out; bf16* num1 = (bf16*)F.out + (size_t)MTOK * DMODEL;
    float* st0 = (float*)(F.ws + WS_STAT); float* st1 = (float*)(F.ws + WS_STAT) + (size_t)MTOK * 32;
    const int u = F.vcu * 8 + i;
    const int nblk = 16 / dil;
    const int bh = u >> 4, b = bh >> 4, h = bh & 15, sub = u & 15, r = sub / nblk, blk = sub % nblk;
    const size_t tok0 = (size_t)b * SEQ + r;
    J.Q = Q + tok0 * DMODEL + h * 64; J.K = K + tok0 * DMODEL + h * 64; J.V = V + tok0 * DMODEL + h * 64;
    J.rs = (long)dil * DMODEL; J.q0 = 256 * blk; J.k0 = J.q0 - 128; J.NT = 6; J.ob = 0; J.kmean = nullptr;
    J.srs = (long)dil * 32;
    J.O = ((OUT == attn::OUT_MERGE) ? (bf16*)(F.ws + WS_ATT) : (gidx == 0 ? num0 : num1)) + tok0 * DMODEL + h * 64;
    J.stat = (OUT == attn::OUT_PART) ? (gidx == 0 ? st0 : st1) + (tok0 * 16 + h) * 2 : nullptr;
    J.num0 = num0 + tok0 * DMODEL + h * 64; J.num1 = num1 + tok0 * DMODEL + h * 64;
    J.stat0 = st0 + (tok0 * 16 + h) * 2; J.stat1 = st1 + (tok0 * 16 + h) * 2;
    first = (blk == 0);
}
template <int OUT> __device__ __forceinline__ void phase_band(Frame& F, int dil, int gidx) {
    if (F.vcu * 8 >= BATCH * NHEADS * 16) return;
    attn::Job J; bool first;
    band_job<OUT>(F, 0, dil, gidx, J, first);
    bool cont = false; int rot = 0;
    { int t_ = F.tid; asm volatile("" : "+v"(t_)); attn::band_issue_kq(t_, J, F.lds_generic, first, false, 0); attn::band_issue_v(t_, J, F.lds_generic, first, false, 0); }
    for (int i = 0; i < 8; ++i) {
        int t_ = F.tid; asm volatile("" : "+v"(t_));
        float l_reg, mhat; attn::f32x16 o[2]; attn::u32x4 pw[5][2];
        attn::band_pass1(t_, F.lds_generic, first, cont, rot, pw, l_reg, mhat);
        attn::Job Jn = J; bool firstn = first;
        bool contn = false; int rotn = 0;
        if (i + 1 < 8) { band_job<OUT>(F, i + 1, dil, gidx, Jn, firstn);
            contn = !firstn;
            rotn = contn ? (rot >= 2 ? rot - 2 : rot + 4) : 0;
            attn::band_issue_kq(t_, Jn, F.lds_generic, firstn, contn, rotn); }
        attn::band_pass2(t_, F.lds_generic, first, i == 7, contn, rot, pw, o);
        if (i + 1 < 8) attn::band_issue_v(t_, Jn, F.lds_generic, firstn, contn, rotn);
        { const int lane = t_ & 63, wid = __builtin_amdgcn_readfirstlane(t_ >> 6);
          attn::unit_epilogue<OUT>(J, (float*)(F.lds_generic + attn::BK_WS) + wid * 64, (unsigned short*)(F.lds_generic + attn::BK_OST) + wid * 1024, wid, lane, l_reg, mhat, o); }
        J = Jn; first = firstn; cont = contn; rot = rotn;
    }
}
__device__ __forceinline__ void moba_job(Frame& F, int i, attn::Job& J) {
    const bf16* Q = (const bf16*)(F.ws + WS_Q); const bf16* K = (const bf16*)(F.ws + WS_K); const bf16* V = (const bf16*)(F.ws + WS_V);
    const int bh = F.vcu >> 1, b = bh >> 4, h = bh & 15;
    const int s = (F.vcu & 1) * 4 + (i >> 1), ob = (i & 1) ? 15 - s : s;
    const size_t tok0 = (size_t)b * SEQ;
    J.Q = Q + tok0 * DMODEL + h * 64; J.K = K + tok0 * DMODEL + h * 64; J.V = V + tok0 * DMODEL + h * 64;
    J.rs = DMODEL; J.q0 = 256 * ob; J.k0 = 0; J.NT = 4 * (ob + 1); J.ob = ob; J.kmean = (const float*)(F.ws + WS_KMEAN) + (size_t)bh * 16 * 64;
    J.O = (bf16*)(F.ws + WS_ATT) + tok0 * DMODEL + h * 64; J.stat = nullptr; J.num0 = J.num1 = nullptr; J.stat0 = J.stat1 = nullptr; J.srs = 32;
}
__device__ __forceinline__ void phase_moba(Frame& F) {
    if ((F.vcu >> 1) >= BATCH * NHEADS) return;
    float gq = __builtin_fabsf(F.inp(7)[FLANE]), gk = __builtin_fabsf(F.inp(8)[FLANE]);
#pragma unroll
    for (int o_ = 1; o_ < 64; o_ <<= 1) { gq = __builtin_fmaxf(gq, __shfl_xor(gq, o_)); gk = __builtin_fmaxf(gk, __shfl_xor(gk, o_)); }
    const float kbound = 8.0f * 1.02f * gk;
    const bool fixed_ok = (QSCALE * 8.0f * 1.02f * gq * kbound) <= 60.0f;
    attn::Job J; moba_job(F, 0, J); J.kbound = kbound;
    { int t_ = F.tid; asm volatile("" : "+v"(t_)); attn::ring_issue(t_, J, F.lds_generic); }
    for (int i = 0; i < 8; ++i) {
        int t_ = F.tid; asm volatile("" : "+v"(t_));
        float l_reg, mhat; attn::f32x16 o[2];
        if (fixed_ok) attn::attn_unit<true, true>(t_, J, F.lds_generic, l_reg, mhat, o); else attn::attn_unit<true, false>(t_, J, F.lds_generic, l_reg, mhat, o);
        attn::Job Jn = J;
        if (i + 1 < 8) { moba_job(F, i + 1, Jn); attn::ring_issue(t_, Jn, F.lds_generic); }
        { const int lane = t_ & 63, wid = __builtin_amdgcn_readfirstlane(t_ >> 6);
          attn::unit_epilogue<attn::OUT_FINAL>(J, (float*)(F.lds_generic + attn::LDS_WS) + wid * 64, (unsigned short*)(F.lds_generic + attn::LDS_OST) + wid * 1024, wid, lane, l_reg, mhat, o); }
        J = Jn;
    }
}

#define XB_TMO      128
#define XB_XCNT(j)  (256  + 64 * (j))
#define XB_XSUB(j)  (1280 + 64 * (j))
#define XB_XGEN(j)  (2304 + 64 * (j))
#define XB_TOP      3328
#define XB_TOPGEN   3392
#define XCD_BAR_WORDS 3456
#define XB_SPIN_CAP (1u << 18)

__device__ __forceinline__ unsigned xb_ld(unsigned* p)              { return __hip_atomic_load(p, __ATOMIC_RELAXED, __HIP_MEMORY_SCOPE_AGENT); }
__device__ __forceinline__ unsigned xb_add(unsigned* p, unsigned v) { return __hip_atomic_fetch_add(p, v, __ATOMIC_RELAXED, __HIP_MEMORY_SCOPE_AGENT); }
__device__ __forceinline__ unsigned xb_xcc_id() { return (unsigned)__builtin_amdgcn_s_getreg((3 << 11) | 20) & 0xFu; }
#define XB_SPIN(cond, bar) do { unsigned _sp = 0; while (cond) { __builtin_amdgcn_s_sleep(1); \
    if ((++_sp & 255u) == 0u) { if (xb_ld(&(bar)[XB_TMO])) break; if (_sp > XB_SPIN_CAP) { atomicAdd(&(bar)[XB_TMO], 1u); break; } } } } while (0)

struct XcdBarrier {
    unsigned* bar; unsigned x;
    volatile LAS unsigned* st;
};

__device__ __forceinline__ XcdBarrier xcd_barrier_post(unsigned* bar, volatile LAS unsigned* st, int tid) {
    XcdBarrier b; b.bar = bar; b.x = xb_xcc_id(); b.st = st;
    if (tid == 0) (void)xb_add(&bar[XB_XCNT(b.x)], 1u);
    return b;
}
__device__ __forceinline__ void xcd_barrier_complete(unsigned* bar, unsigned x, unsigned& nloc, unsigned& nx) {
    const unsigned G = gridDim.x * gridDim.y * gridDim.z;
    unsigned sum, cnt, mine, sp = 0u;
    for (;;) {
        sum = 0u; cnt = 0u; mine = 0u;
#pragma unroll
        for (unsigned j = 0; j < 16; ++j) { const unsigned c = xb_ld(&bar[XB_XCNT(j)]); sum += c; cnt += (c > 0u) ? 1u : 0u; mine = (j == x) ? c : mine; }
        if (sum == G) break;
        __builtin_amdgcn_s_sleep(1);
        if ((++sp & 255u) == 0u) { if (xb_ld(&bar[XB_TMO])) break; if (sp > XB_SPIN_CAP) { atomicAdd(&bar[XB_TMO], 1u); break; } }
    }
    nloc = mine > 0u ? mine : 1u; nx = cnt > 0u ? cnt : 1u;
}

__device__ __forceinline__ void xcd_barrier(const XcdBarrier& b, int tid) {
    asm volatile("s_waitcnt vmcnt(0)" ::: "memory");
    __syncthreads();
    if (tid == 0) {
        unsigned* bar = b.bar;
        __builtin_amdgcn_s_waitcnt(0);
        unsigned nloc = b.st[0], nx = b.st[1];
        if (nloc == 0u) { xcd_barrier_complete(bar, b.x, nloc, nx); b.st[0] = nloc; b.st[1] = nx; }
        const unsigned old = xb_add(&bar[XB_XSUB(b.x)], 1u);
        const unsigned gen = old / nloc;
        if (old + 1u == (gen + 1u) * nloc) {
            __builtin_amdgcn_fence(__ATOMIC_RELEASE, "agent");
            asm volatile("s_waitcnt vmcnt(0)" ::: "memory");
            const unsigned og = xb_add(&bar[XB_TOP], 1u);
            const unsigned tg = og / nx;
            if (og + 1u == (tg + 1u) * nx) xb_add(&bar[XB_TOPGEN], 1u);
            else XB_SPIN(xb_ld(&bar[XB_TOPGEN]) == tg, bar);
            __builtin_amdgcn_fence(__ATOMIC_ACQUIRE, "agent");
            xb_add(&bar[XB_XGEN(b.x)], 1u);
            asm volatile("s_waitcnt vmcnt(0)" ::: "memory");
        } else {
            XB_SPIN(xb_ld(&bar[XB_XGEN(b.x)]) == gen, bar);
            __builtin_amdgcn_fence(__ATOMIC_ACQUIRE, "agent");
            asm volatile("s_waitcnt vmcnt(0)" ::: "memory");
        }
    }
    __syncthreads();
}

constexpr int N_PHASES = 18;
constexpr int CW_BAR = 4096;
constexpr int BARST_OFF = XLDS_OFF + XLDS_BYTES;
static_assert(BARST_OFF + 64 <= LDS_BYTES && (CW_BAR + XCD_BAR_WORDS) * 4 <= (int)CTL_ZERO_BYTES, "barrier state placement");
__device__ __forceinline__ void frame_setup(Frame& F, int wave0, unsigned char* lds) {
    { int t_ = wave0 * 64 + fresh_lane(); asm volatile("" : "+v"(t_)); F.tid = t_; }
    { int b_ = blockIdx.x, g_ = gridDim.x; asm volatile("" : "+s"(b_), "+s"(g_)); F.bx = b_; F.G = g_; }
    F.wave = __builtin_amdgcn_readfirstlane(F.tid >> 6);
    F.vcu = (F.G % 8 == 0) ? (F.bx % 8) * (F.G / 8) + F.bx / 8 : F.bx;
    { unsigned long long k_ = (unsigned long long)__builtin_amdgcn_kernarg_segment_ptr(); asm volatile("" : "+s"(k_)); F.karg = k_; F.out = (float*)F.inp(15); F.ws = (unsigned char*)F.inp(16); }
    F.lds = (LAS unsigned char*)lds; F.lds_generic = (char*)lds;
}
template <int PH> __device__ __forceinline__ void run_phase(Frame& F) {
    const bf16* WB = (const bf16*)(F.ws + WS_W);
    const bf16* ATT = (const bf16*)(F.ws + WS_ATT); const bf16* HH = (const bf16*)(F.ws + WS_HH);
    constexpr int L = (PH >= 11) ? 1 : 0;
    if constexpr (PH == 0) phase_prologue(F);
    else if constexpr (PH == 1 || PH == 3 || PH == 5) { constexpr int g = PH >> 1; phase_gemm_qkv<false>(F, WB + W_QKVA + (size_t)g * 3072 * 1024, F.inp(3) + 64 * g, F.inp(4) + 64 * g); }
    else if constexpr (PH == 11) phase_gemm_qkv<true>(F, WB + W_QKVB, F.inp(7), F.inp(8));
    else if constexpr (PH == 2) phase_band<attn::OUT_PART>(F, 1, 0);
    else if constexpr (PH == 4) phase_band<attn::OUT_PART>(F, 4, 1);
    else if constexpr (PH == 6) phase_band<attn::OUT_MERGE>(F, 16, 2);
    else if constexpr (PH == 7) phase_gemm_res<false, false>(F, ATT, WB + W_OA, 1024, F.ws + WS_XN, F.ws + WS_XN, true, SS_B_OFF);
    else if constexpr (PH == 10) phase_gemm_res<false, false>(F, HH, WB + W_DN0, DFF, F.ws + WS_XN, F.ws + WS_XN, true, 0);
    else if constexpr (PH == 14) phase_gemm_res<false, false>(F, ATT, WB + W_OB, 1024, F.ws + WS_XN, F.ws + WS_XN, true, SS_B_OFF);
    else if constexpr (PH == 17) phase_gemm_res<false, true>(F, HH, WB + W_DN1, DFF, F.ws + WS_XN, F.out, false, 0);
    else if constexpr (PH == 8 || PH == 15) phase_gemm_up(F, WB + (L ? W_UP1 : W_UP0), F.inp(12) + (size_t)L * 3 * NUP, F.inp(13) + (size_t)L * NUP);
    else if constexpr (PH == 9 || PH == 16) phase_fixup(F, F.inp(12) + (size_t)L * 3 * NUP, F.inp(13) + (size_t)L * NUP);
    else if constexpr (PH == 13) phase_moba(F);
}
template <unsigned PHASE_MASK> __global__ void __launch_bounds__(NWAVES * 64, 2) fwd_kernel(const Args args) {
    extern __shared__ __attribute__((aligned(16))) unsigned char lds[];
    const int lo = args.ph_lo, hi = args.ph_hi;
    const int wave0 = __builtin_amdgcn_readfirstlane(threadIdx.x >> 6);
    constexpr bool FUSED = (PHASE_MASK & (PHASE_MASK - 1u)) != 0u;
    volatile LAS unsigned* bst = (volatile LAS unsigned*)((LAS unsigned char*)lds + BARST_OFF);
    XcdBarrier xb; xb.bar = nullptr; xb.x = 0; xb.st = bst;
    if constexpr (FUSED) {
        if (threadIdx.x < 16) bst[threadIdx.x] = 0u;
        __syncthreads();
        xb = xcd_barrier_post((unsigned*)(args.ws + WS_CTL) + CW_BAR, bst, (int)threadIdx.x);
    }
#define PHASE_FENCE() asm volatile("; phase boundary" ::: "v8", "v9", "v10", "v11", "v12", "v13", "v14", "v15", "v16", "v17", "v18", "v19", "v20", "v21", "v22", "v23", "v24", "v25", "v26", "v27", "v28", "v29", "v30", "v31", "v32", "v33", "v34", "v35", "v36", "v37", "v38", "v39", "v40", "v41", "v42", "v43", "v44", "v45", "v46", "v47", "v48", "v49", "v50", "v51", "v52", "v53", "v54", "v55", "v56", "v57", "v58", "v59", "v60", "v61", "v62", "v63", "v64", "v65", "v66", "v67", "v68", "v69", "v70", "v71", "v72", "v73", "v74", "v75", "v76", "v77", "v78", "v79", "v80", "v81", "v82", "v83", "v84", "v85", "v86", "v87", "v88", "v89", "v90", "v91", "v92", "v93", "v94", "v95", "v96", "v97", "v98", "v99", "v100", "v101", "v102", "v103", "v104", "v105", "v106", "v107", "v108", "v109", "v110", "v111", "v112", "v113", "v114", "v115", "v116", "v117", "v118", "v119", "v120", "v121", "v122", "v123", "v124", "v125", "v126", "v127", "v128", "v129", "v130", "v131", "v132", "v133", "v134", "v135", "v136", "v137", "v138", "v139", "v140", "v141", "v142", "v143", "v144", "v145", "v146", "v147", "v148", "v149", "v150", "v151", "v152", "v153", "v154", "v155", "v156", "v157", "v158", "v159", "v160", "v161", "v162", "v163", "v164", "v165", "v166", "v167", "v168", "v169", "v170", "v171", "v172", "v173", "v174", "v175", "v176", "v177", "v178", "v179", "v180", "v181", "v182", "v183", "v184", "v185", "v186", "v187", "v188", "v189", "v190", "v191", "v192", "v193", "v194", "v195", "v196", "v197", "v198", "v199", "v200", "v201", "v202", "v203", "v204", "v205", "v206", "v207", "v208", "v209", "v210", "v211", "v212", "v213", "v214", "v215", "v216", "v217", "v218", "v219", "v220", "v221", "v222", "v223", "v224", "v225", "v226", "v227", "v228", "v229", "v230", "v231", "v232", "v233", "v234", "v235", "v236", "v237", "v238", "v239", "v240", "v241", "v242", "v243", "v244", "v245", "v246", "v247", "v248", "v249", "v250", "v251", "v252", "v253", "v254", "v255", "s36", "s37", "s38", "s39", "s40", "s41", "s42", "s43", "s44", "s45", "s46", "s47", "s48", "s49", "s50", "s51", "s52", "s53", "s54", "s55", "s56", "s57", "s58", "s59", "s60", "s61", "s62", "s63", "s64", "s65", "s66", "s67", "s68", "s69", "s70", "s71", "s72", "s73", "s74", "s75", "s76", "s77", "s78", "s79", "s80", "s81", "s82", "s83", "s84", "s85", "s86", "s87", "s88", "s89", "s90", "s91", "s92", "s93", "s94", "s95", "s96", "s97", "s98", "s99", "s100", "s101", "memory")
#define TID_NOW() (wave0 * 64 + fresh_lane())
#ifndef PROBE_DUP
#define PROBE_DUP 0u
#endif
#ifndef MK_CG_FIRST
#define MK_CG_FIRST 0
#endif
#define PHASE(k) if constexpr (((PHASE_MASK >> (k)) & 1u) != 0u) { PHASE_FENCE(); if (lo <= (k) && (k) < hi) { { Frame F; frame_setup(F, wave0, lds); run_phase<(k)>(F); } \
        if constexpr (((PROBE_DUP >> (k)) & 1u) != 0u) { Frame F; frame_setup(F, wave0, lds); run_phase<(k)>(F); } \
        if constexpr (FUSED && (k) + 1 < N_PHASES) { if ((k) + 1 < hi) { if (MK_CG_FIRST && (k) == 0) cg::this_grid().sync(); else xcd_barrier(xb, TID_NOW()); } } } }
    PHASE(0) PHASE(1) PHASE(2) PHASE(3) PHASE(4) PHASE(5) PHASE(6) PHASE(7) PHASE(8) PHASE(9) PHASE(10) PHASE(11) PHASE(13) PHASE(14) PHASE(15) PHASE(16) PHASE(17)
#undef TID_NOW
#undef PHASE
}

constexpr unsigned PM_ALL = 0x3ffffu;
typedef void (*kern_t)(const Args);
#ifndef MK_SPLIT
#define MK_SPLIT 0
#endif
#if MK_SPLIT
static kern_t kernel_of_phase(int ph) {
    switch (ph) {
#define KP(k) case k: return fwd_kernel<(1u << k)>;
    KP(0) KP(1) KP(2) KP(3) KP(4) KP(5) KP(6) KP(7) KP(8) KP(9) KP(10) KP(11) KP(12) KP(13) KP(14) KP(15) KP(16)
#undef KP
    default: return fwd_kernel<(1u << 17)>;
    }
}
#endif
extern "C" void kernel_launch(void* const* d_in, const int* in_sizes, int n_in, void* d_out, int out_size, void* d_ws, size_t ws_size, hipStream_t stream) {
    static int grid = 0;
    if (grid == 0) {
        if (n_in != 15 || out_size != MTOK * DMODEL || ws_size < WS_END) { fprintf(stderr, "kernel_launch: unexpected shapes (n_in %d, out %d, ws %zu)\n", n_in, out_size, ws_size); grid = -1; return; }
        int dev = 0, cus = 0;
        if (hipGetDevice(&dev) != hipSuccess || hipDeviceGetAttribute(&cus, hipDeviceAttributeMultiprocessorCount, dev) != hipSuccess) { grid = -1; return; }
#if MK_SPLIT
        for (int ph = 0; ph < N_PHASES; ++ph)
            if (hipFuncSetAttribute((const void*)kernel_of_phase(ph), hipFuncAttributeMaxDynamicSharedMemorySize, LDS_BYTES) != hipSuccess) { fprintf(stderr, "kernel_launch: hipFuncSetAttribute failed\n"); grid = -1; return; }
#else
        if (hipFuncSetAttribute((const void*)fwd_kernel<PM_ALL>, hipFuncAttributeMaxDynamicSharedMemorySize, LDS_BYTES) != hipSuccess) { fprintf(stderr, "kernel_launch: hipFuncSetAttribute failed\n"); grid = -1; return; }
        int per_cu = 0;
        if (hipOccupancyMaxActiveBlocksPerMultiprocessor(&per_cu, (const void*)fwd_kernel<PM_ALL>, NWAVES * 64, LDS_BYTES) != hipSuccess || per_cu < 1) fprintf(stderr, "kernel_launch: occupancy query says %d blocks/CU\n", per_cu);
        (void)hipGetLastError();
#endif
        grid = cus;
    }
    if (grid < 0) return;
    Args a{};
    for (int i = 0; i < 15; ++i) a.in[i] = (const float*)d_in[i];
    a.out = (float*)d_out; a.ws = (unsigned char*)d_ws;
#if MK_SPLIT
    for (int ph = 0; ph < N_PHASES; ++ph) { a.ph_lo = ph; a.ph_hi = ph + 1; hipLaunchKernelGGL(kernel_of_phase(ph), dim3(grid), dim3(NWAVES * 64), LDS_BYTES, stream, a); }
#else
    a.ph_lo = 0; a.ph_hi = N_PHASES;
    if (hipMemsetAsync((char*)d_ws + WS_CTL, 0, 65536, stream) != hipSuccess) { fprintf(stderr, "kernel_launch: memset failed\n"); return; }
    void* kargs[] = {&a};
    hipError_t e = hipLaunchCooperativeKernel((const void*)fwd_kernel<PM_ALL>, dim3(grid), dim3(NWAVES * 64), kargs, LDS_BYTES, stream);
    if (e != hipSuccess) fprintf(stderr, "cooperative launch failed: %s (grid %d)\n", hipGetErrorString(e), grid);
#endif
}
```

```cpp
#include <hip/hip_runtime.h>
#include <hip/hip_bf16.h>
#include <hip/hip_cooperative_groups.h>
#include <cstdio>
#include <cstdint>
#include <cmath>
namespace cg = cooperative_groups;

__device__ __forceinline__ int fresh_lane() { unsigned z = 0u; asm volatile("" : "+v"(z)); return (int)__builtin_amdgcn_mbcnt_hi(~0u, __builtin_amdgcn_mbcnt_lo(~0u, z)); }
#ifndef PROBE_K2
#define PROBE_K2 0
#endif
namespace pg8 {
#define PG8_LAS __attribute__((address_space(3)))
typedef unsigned short bf16_t;
typedef short bf16x8 __attribute__((ext_vector_type(8)));
typedef float f32x4 __attribute__((ext_vector_type(4)));
typedef unsigned u32x4 __attribute__((ext_vector_type(4)));
typedef unsigned u32x2 __attribute__((ext_vector_type(2)));
constexpr int BM = 256, BK = 64, HALF = 128, HTB = HALF * BK * 2  , STAGE_BYTES = 8 * HTB, NXCD = 8, WGM = 4;

__host__ __device__ __forceinline__ int lds_byte(int r, int c) { const int st = (r >> 4) * 2 + (c >> 5), rr = r & 15, cc = c & 31, ob = rr * 64 + cc * 2; return st * 1024 + (ob ^ (((ob >> 9) & 1) << 5)); }
__host__ __device__ __forceinline__ void stage_rc(int b, int& R, int& C) { const int st = b / 1024, sb = b % 1024, swz = sb ^ (((sb >> 9) & 1) << 5); R = (st >> 1) * 16 + swz / 64; C = (st & 1) * 32 + (swz % 64) / 2; }
__host__ __device__ __forceinline__ int perm32(int rho) { const int n = rho >> 4, i = rho & 15; return 8 * (i >> 2) + 4 * n + (i & 3); }

struct Unit { int pm, pn; };
struct Gemm { const bf16_t* A; const bf16_t* Bt; int M, N, K; };

struct StaticOrder {
    int nM, nN, nwg, G, c;
    __device__ __forceinline__ void init(int M, int N, int G_, int c_) { nM = M / BM; nN = N / BM; nwg = nM * nN; G = G_; c = c_; }
    __device__ __forceinline__ bool next(int i, Unit& u) const {
        const long L = (long)i * G + c; if (L >= nwg) return false;
        int wgid = (int)L; { const int q = nwg / NXCD, r = nwg % NXCD, xcd = wgid % NXCD, off = wgid / NXCD; wgid = (xcd < r ? xcd * (q + 1) : r * (q + 1) + (xcd - r) * q) + off; }
        const int nig = WGM * nN, gid = wgid / nig, fm = gid * WGM, gsz = (nM - fm) < WGM ? (nM - fm) : WGM;
        u.pm = fm + ((wgid % nig) % gsz); u.pn = (wgid % nig) / gsz; return true;
    }
};

__device__ __forceinline__ unsigned cvt_pk_bf16(float lo, float hi) { unsigned r; asm volatile("v_cvt_pk_bf16_f32 %0, %1, %2" : "=v"(r) : "v"(lo), "v"(hi)); return r; }

template <class Epi, class Sched>
__device__ __forceinline__ void gemm_phase(const int tid, PG8_LAS unsigned char* lds, PG8_LAS unsigned char* xlds, const Gemm g, const Sched& S, const Epi& E) {
    const int wid = __builtin_amdgcn_readfirstlane(tid >> 6), lane = tid & 63, wr = wid >> 2, wc = wid & 3, fr = lane & 15, fq = lane >> 4;
    const int K = g.K, nt = K / BK;
    unsigned voffA, voffB;
    { int R, C; stage_rc(tid * 16, R, C); const int Rb = ((R & ~31) + perm32(R & 31));
      const int Ra = Epi::AROWPERM ? ((R & ~63) + 4 * (R & 15) + ((R >> 4) & 3)) : R;
      voffA = (unsigned)(Ra * K + C) * 2u; voffB = (unsigned)(Rb * K + C) * 2u; }
    const unsigned qstep = 64u * (unsigned)K * 2u;
    const unsigned kstep = (unsigned)(BK * 2);
    const unsigned hstep = (unsigned)HALF * (unsigned)K * 2u;
    const unsigned tstep = 2u * hstep;
    const char* const gA = (const char*)g.A; const char* const gB = (const char*)g.Bt;
    const unsigned ldsw = (unsigned)wid * 1024u;
    const int aoff = lds_byte(wr * 64 + fr, fq * 8), boff = lds_byte(wc * 32 + fr, fq * 8);
    unsigned ldsA_ = (unsigned)(uintptr_t)lds + (unsigned)aoff, ldsB_ = (unsigned)(uintptr_t)lds + 4u * HTB + (unsigned)boff; asm volatile("" : "+v"(ldsA_), "+v"(ldsB_));
    const PG8_LAS unsigned char* const ldsA = (const PG8_LAS unsigned char*)(uintptr_t)ldsA_; const PG8_LAS unsigned char* const ldsB = (const PG8_LAS unsigned char*)(uintptr_t)ldsB_;
#define PG8_SA(b, h) (((b) * 2 + (h)) * HTB)
#define PG8_SB(b, h) ((4 + (b) * 2 + (h)) * HTB)
#define PG8_STAGE(bufoff, gptr, goff, voff) do { _Pragma("unroll") for (int _i = 0; _i < 2; ++_i) \
        __builtin_amdgcn_global_load_lds((const unsigned*)((gptr) + (unsigned)((goff) + _i * qstep + (voff))), (PG8_LAS unsigned*)(lds + (bufoff) + ldsw + _i * 8192), 16, 0, 0); } while (0)
#define PG8_LDA(dst, b, h) do { _Pragma("unroll") for (int m = 0; m < 4; ++m) _Pragma("unroll") for (int k = 0; k < 2; ++k) dst[m][k] = *(const PG8_LAS bf16x8*)(ldsA + (PG8_SA(b, h) + m * 2048 + k * 1024)); } while (0)
#define PG8_LDB(dst, b, h) do { _Pragma("unroll") for (int n = 0; n < 2; ++n) _Pragma("unroll") for (int k = 0; k < 2; ++k) dst[n][k] = *(const PG8_LAS bf16x8*)(ldsB + (PG8_SB(b, h) - 4 * HTB + n * 2048 + k * 1024)); } while (0)
#define PG8_MMA(ai, bj, At, Bt) do { __builtin_amdgcn_s_setprio(1); _Pragma("unroll") for (int m = 0; m < 4; ++m) _Pragma("unroll") for (int n = 0; n < 2; ++n) _Pragma("unroll") for (int k = 0; k < 2; ++k) \
        acc[ai][bj][m][n] = __builtin_amdgcn_mfma_f32_16x16x32_bf16(Bt[n][k], At[m][k], acc[ai][bj][m][n], 0, 0, 0); __builtin_amdgcn_s_setprio(0); } while (0)
#define PG8_WAIT_V(n) asm volatile("s_waitcnt vmcnt(" #n ")" ::: "memory")
#define PG8_WAIT_L(n) asm volatile("s_waitcnt lgkmcnt(" #n ")" ::: "memory")
#define PG8_BAR __builtin_amdgcn_s_barrier()
#define PG8_SCHED __builtin_amdgcn_sched_barrier(0)
    Unit cur, nxt; int ui = 0;
    if (!S.next(0, cur)) return;
    f32x4 acc[2][2][4][2];
#pragma unroll
    for (int a = 0; a < 2; ++a)
#pragma unroll
        for (int b = 0; b < 2; ++b)
#pragma unroll
            for (int m = 0; m < 4; ++m)
#pragma unroll
                for (int n = 0; n < 2; ++n) acc[a][b][m][n] = (f32x4){0.f, 0.f, 0.f, 0.f};
    bf16x8 At[4][2], B0[2][2], B1[2][2];
    unsigned cA = (unsigned)cur.pm * tstep, cB = (unsigned)cur.pn * tstep;
    PG8_STAGE(PG8_SB(0, 0), gB, cB, voffB); PG8_STAGE(PG8_SB(0, 1), gB, cB + hstep, voffB); PG8_STAGE(PG8_SA(0, 0), gA, cA, voffA); PG8_STAGE(PG8_SA(0, 1), gA, cA + hstep, voffA);
    if (wr == 1) PG8_BAR;
    PG8_WAIT_V(2); PG8_BAR;
    PG8_STAGE(PG8_SB(1, 0), gB, cB + kstep, voffB); PG8_STAGE(PG8_SA(1, 0), gA, cA + kstep, voffA); PG8_STAGE(PG8_SB(1, 1), gB, cB + hstep + kstep, voffB);
    PG8_WAIT_V(0); PG8_BAR;
    for (;;) {
        PG8_BAR; { const int ln_ = fresh_lane(); E.prefetch(cur, xlds, wid, ln_); }
        const bool has_next = S.next(ui + 1, nxt);
        const unsigned nA = has_next ? (unsigned)nxt.pm * tstep : cA, nB = has_next ? (unsigned)nxt.pn * tstep : cB;
#if PROBE_K2
        for (int rep = 0; rep < 2; ++rep)
#endif
        for (int t = 0; t < nt; t += 2) {
            const bool last = (t == nt - 2);
            const unsigned a1 = cA + (unsigned)(t + 1) * kstep;
#if PROBE_K2
            const unsigned a2 = last ? (rep == 0 ? cA : nA) : cA + (unsigned)(t + 2) * kstep, b2 = last ? (rep == 0 ? cB : nB) : cB + (unsigned)(t + 2) * kstep;
#else
            const unsigned a2 = last ? nA : cA + (unsigned)(t + 2) * kstep, b2 = last ? nB : cB + (unsigned)(t + 2) * kstep;
#endif
            const unsigned a3 = a2 + kstep, b3 = b2 + kstep;
            const bool relax = (t == 0);
            PG8_LDB(B0, 0, 0); PG8_LDB(B1, 0, 1); PG8_SCHED; PG8_LDA(At, 0, 0); PG8_STAGE(PG8_SA(1, 1), gA, a1 + hstep, voffA);
            if (!relax) PG8_WAIT_V(8); PG8_WAIT_L(0); PG8_BAR; PG8_MMA(0, 0, At, B0); PG8_MMA(0, 1, At, B1); PG8_BAR; PG8_SCHED;
            PG8_LDA(At, 0, 1); PG8_STAGE(PG8_SB(0, 0), gB, b2, voffB); PG8_STAGE(PG8_SB(0, 1), gB, b2 + hstep, voffB); PG8_STAGE(PG8_SA(0, 0), gA, a2, voffA);
            if (!relax) PG8_WAIT_V(8); PG8_WAIT_L(0); PG8_BAR; PG8_MMA(1, 0, At, B0); PG8_MMA(1, 1, At, B1); PG8_BAR; PG8_SCHED;
            PG8_LDB(B0, 1, 0); PG8_LDB(B1, 1, 1); PG8_SCHED; PG8_LDA(At, 1, 0); PG8_STAGE(PG8_SA(0, 1), gA, a2 + hstep, voffA);
            PG8_WAIT_V(8); PG8_WAIT_L(0); PG8_BAR; PG8_MMA(0, 0, At, B0); PG8_MMA(0, 1, At, B1); PG8_BAR; PG8_SCHED;
            PG8_LDA(At, 1, 1); PG8_STAGE(PG8_SB(1, 0), gB, b3, voffB); PG8_STAGE(PG8_SB(1, 1), gB, b3 + hstep, voffB); PG8_STAGE(PG8_SA(1, 0), gA, a3, voffA);
            PG8_WAIT_V(8); PG8_WAIT_L(0); PG8_BAR; PG8_MMA(1, 0, At, B0); PG8_MMA(1, 1, At, B1); PG8_BAR; PG8_SCHED;
        }
#if PROBE_K2
#pragma unroll
        for (int a = 0; a < 2; ++a)
#pragma unroll
            for (int b = 0; b < 2; ++b)
#pragma unroll
                for (int m = 0; m < 4; ++m)
#pragma unroll
                    for (int n = 0; n < 2; ++n) acc[a][b][m][n] = acc[a][b][m][n] * 0.5f;
#endif
        if (wr == 0) PG8_BAR;
        PG8_WAIT_V(0);
        { const int ln_ = fresh_lane(); const int fr_ = ln_ & 15, fq_ = ln_ >> 4; E(acc, cur, wr, wc, fr_, fq_, xlds); if constexpr (Epi::PROBE2) { { const int l2_ = fresh_lane(); E(acc, cur, wr, wc, l2_ & 15, l2_ >> 4, xlds); } } }
        if (!has_next) break;
#pragma unroll
        for (int a = 0; a < 2; ++a)
#pragma unroll
            for (int b = 0; b < 2; ++b)
#pragma unroll
                for (int m = 0; m < 4; ++m)
#pragma unroll
                    for (int n = 0; n < 2; ++n) acc[a][b][m][n] = (f32x4){0.f, 0.f, 0.f, 0.f};
        cur = nxt; cA = nA; cB = nB; ++ui;
        if (wr == 1) PG8_BAR;
    }
    PG8_WAIT_V(0);
    PG8_BAR;
#undef PG8_SA
#undef PG8_SB
#undef PG8_STAGE
#undef PG8_LDA
#undef PG8_LDB
#undef PG8_MMA
#undef PG8_WAIT_V
#undef PG8_WAIT_L
#undef PG8_BAR
#undef PG8_SCHED
}
}

constexpr int BATCH = 8, SEQ = 4096, DMODEL = 1024, NHEADS = 16, HDIM = 64, DFF = 2816, NUP = 2 * DFF;
constexpr int MTOK = BATCH * SEQ;
constexpr float RMS_EPS = 1e-6f;
constexpr float QSCALE = 0.125f * 1.4426950408889634f;
constexpr int XL_EX = 0, XL_SS = 8192, XL_GAIN = XL_SS + 1024, XL_COS = XL_GAIN + 256, XL_SIN = XL_COS + 8192, XL_CW = XL_COS, XL_END = XL_SIN + 8192;

typedef unsigned short bf16;
typedef float f32x4 __attribute__((ext_vector_type(4)));
typedef float f32x2 __attribute__((ext_vector_type(2)));
typedef unsigned u32x4 __attribute__((ext_vector_type(4)));
typedef unsigned u32x2 __attribute__((ext_vector_type(2)));
#define LAS __attribute__((address_space(3)))

__device__ __forceinline__ float shx(float v, int m) { return __shfl_xor(v, m); }
__device__ __forceinline__ float xsum16(float v) { auto r = __builtin_amdgcn_permlane16_swap(__float_as_uint(v), __float_as_uint(v), false, false); return __uint_as_float(r[0]) + __uint_as_float(r[1]); }
__device__ __forceinline__ float xsum32(float v) { auto r = __builtin_amdgcn_permlane32_swap(__float_as_uint(v), __float_as_uint(v), false, false); return __uint_as_float(r[0]) + __uint_as_float(r[1]); }
__device__ __forceinline__ float fqsum(float v) { return xsum32(xsum16(v)); }
__device__ __forceinline__ float rsq(float v) { return __builtin_amdgcn_rsqf(v); }
__device__ __forceinline__ float bf2f(unsigned short b) { return __uint_as_float(((unsigned)b) << 16); }
__device__ __forceinline__ float sum4(f32x4 v) { return (v[0] + v[1]) + (v[2] + v[3]); }
__device__ __forceinline__ float dot4(f32x4 v) { return (v[0] * v[0] + v[1] * v[1]) + (v[2] * v[2] + v[3] * v[3]); }

__device__ __forceinline__ void dma1k(const void* src, LAS unsigned char* dst, unsigned voff) {
    __builtin_amdgcn_global_load_lds((const unsigned*)((const char*)src + voff), (LAS unsigned*)dst, 16, 0, 0); }
__device__ __forceinline__ float lds_rstd(LAS unsigned char* xlds, int r) { return rsq(((LAS float*)(xlds + XL_SS))[r] * (1.0f / DMODEL) + RMS_EPS); }
#ifndef PROBE_EPI2
#define PROBE_EPI2 0
#endif
template <int CTRL> __device__ __forceinline__ float dpp_ror(float v) { return __builtin_bit_cast(float, __builtin_amdgcn_update_dpp(0, __builtin_bit_cast(int, v), CTRL, 0xf, 0xf, false)); }
template <bool KMSUM> struct EpiQKV {
    static constexpr bool PROBE2 = (PROBE_EPI2 & 1) != 0, AROWPERM = false;
    float* kmsum;
    bf16 *Q; size_t qkv_stride; const float* ss; const float *qg, *kg; const float *cosT, *sinT;
    __device__ __forceinline__ void prefetch(const pg8::Unit& u, LAS unsigned char* xlds, int wid, int lane) const {
        const int which = u.pn >> 2; const unsigned l16 = (unsigned)lane * 16u;
        if (wid == 0) dma1k(ss + u.pm * 256, xlds + XL_SS, l16);
        if (which < 2) {
            const int pos0 = (u.pm * 256) & (SEQ - 1);
            dma1k(cosT + pos0 * 8 + wid * 256, xlds + XL_COS + wid * 1024, l16);
            dma1k(sinT + pos0 * 8 + wid * 256, xlds + XL_SIN + wid * 1024, l16);
            if (wid == 1 && lane < 16) dma1k((which == 0) ? qg : kg, xlds + XL_GAIN, l16);
        }
    }
    __device__ __forceinline__ void operator()(const f32x4 (&acc)[2][2][4][2], const pg8::Unit& u, int wr, int wc, int fr, int fq, LAS unsigned char* xlds) const {
        const int which = u.pn >> 2, head = (u.pn & 3) * 4 + wc;
        bf16* dst = Q + (size_t)which * qkv_stride;
        f32x4 g[2][2];
        if (which < 2) {
            const LAS float* gn = (const LAS float*)(xlds + XL_GAIN);
            const int b0 = (fq < 2) ? 4 * fq : 8 * fq, b1 = (fq < 2) ? 8 + 4 * fq : 8 * fq + 4;
            g[0][0] = *(const LAS f32x4*)(gn + b0); g[0][1] = *(const LAS f32x4*)(gn + b1);
            g[1][0] = *(const LAS f32x4*)(gn + 32 + 8 * fq); g[1][1] = *(const LAS f32x4*)(gn + 32 + 8 * fq + 4);
        }
        const float post = (which == 0) ? QSCALE : 1.0f;
        const bool ropeq = (which < 2) && (fq < 2);
        f32x4 ks[2][2];
        if (KMSUM) {
#pragma unroll
            for (int bj = 0; bj < 2; ++bj)
#pragma unroll
                for (int n = 0; n < 2; ++n) ks[bj][n] = (f32x4){0.f, 0.f, 0.f, 0.f};
        }
#pragma unroll
        for (int ai = 0; ai < 2; ++ai) {
#pragma unroll
            for (int m = 0; m < 4; ++m) {
                const int row = u.pm * 256 + ai * 128 + wr * 64 + m * 16 + fr;
                f32x4 cs = (f32x4){1.f, 1.f, 1.f, 1.f}, sn = (f32x4){0.f, 0.f, 0.f, 0.f};
                if (ropeq) { const int r = ai * 128 + wr * 64 + m * 16 + fr; cs = *(const LAS f32x4*)(xlds + XL_COS + r * 32 + 16 * fq); sn = *(const LAS f32x4*)(xlds + XL_SIN + r * 32 + 16 * fq); }
                const float rstd = lds_rstd(xlds, ai * 128 + wr * 64 + m * 16 + fr);
                f32x4 v[2][2];
                if (which < 2) {
                    const float q = fqsum((dot4(acc[ai][0][m][0]) + dot4(acc[ai][0][m][1])) + (dot4(acc[ai][1][m][0]) + dot4(acc[ai][1][m][1])));
                    const float sc = post * rstd * rsq(q * (rstd * rstd) * (1.0f / HDIM) + RMS_EPS);
#pragma unroll
                    for (int bj = 0; bj < 2; ++bj)
#pragma unroll
                        for (int n = 0; n < 2; ++n) v[bj][n] = acc[ai][bj][m][n] * (g[bj][n] * sc);
                    const f32x4 x1 = v[0][0], x2 = v[0][1];
                    v[0][0] = (x1 * cs - x2 * sn); v[0][1] = (x2 * cs + x1 * sn);
                    if (KMSUM && which == 1) {
#pragma unroll
                        for (int bj = 0; bj < 2; ++bj)
#pragma unroll
                            for (int n = 0; n < 2; ++n) ks[bj][n] += v[bj][n];
                    }
                } else {
#pragma unroll
                    for (int bj = 0; bj < 2; ++bj)
#pragma unroll
                        for (int n = 0; n < 2; ++n) v[bj][n] = acc[ai][bj][m][n] * rstd;
                }
                bf16* rowp = dst + (size_t)row * DMODEL + head * 64 + 8 * fq;
#pragma unroll
                for (int bj = 0; bj < 2; ++bj) {
                    u32x4 w; w.x = pg8::cvt_pk_bf16(v[bj][0][0], v[bj][0][1]); w.y = pg8::cvt_pk_bf16(v[bj][0][2], v[bj][0][3]);
                    w.z = pg8::cvt_pk_bf16(v[bj][1][0], v[bj][1][1]); w.w = pg8::cvt_pk_bf16(v[bj][1][2], v[bj][1][3]);
                    *(u32x4*)(rowp + bj * 32) = w;
                }
            }
            asm volatile("" ::: "memory");
        }
        if (KMSUM && which == 1) {
#pragma unroll
            for (int bj = 0; bj < 2; ++bj)
#pragma unroll
                for (int n = 0; n < 2; ++n)
#pragma unroll
                    for (int e = 0; e < 4; ++e) {
                        float x = ks[bj][n][e];
                        x += dpp_ror<0x128>(x); x += dpp_ror<0x124>(x); x += dpp_ror<0x122>(x); x += dpp_ror<0x121>(x);
                        ks[bj][n][e] = x;
                    }
            if (fr == 0) {
                float* kp = kmsum + ((size_t)((u.pm >> 4) * NHEADS + head) * 16 + (u.pm & 15)) * 64 + 8 * fq;
#pragma unroll
                for (int bj = 0; bj < 2; ++bj)
#pragma unroll
                    for (int n = 0; n < 2; ++n)
#pragma unroll
                        for (int e = 0; e < 4; ++e) atomicAdd(kp + bj * 32 + 4 * n + e, ks[bj][n][e]);
            }
        }
    }
};

__device__ __forceinline__ f32x4 bf_lo2(unsigned a, unsigned b) { return (f32x4){__uint_as_float(a << 16), __uint_as_float(a & 0xffff0000u), __uint_as_float(b << 16), __uint_as_float(b & 0xffff0000u)}; }
template <bool RES_F32, bool OUT_F32> struct EpiRes {
    static constexpr bool PROBE2 = false, AROWPERM = false;
    const void* resid; void* out; float* ss;
    __device__ __forceinline__ void prefetch(const pg8::Unit&, LAS unsigned char*, int, int) const {}
    __device__ __forceinline__ void operator()(const f32x4 (&acc)[2][2][4][2], const pg8::Unit& u, int wr, int wc, int fr, int fq, LAS unsigned char*) const {
        const int col0 = u.pn * 256 + wc * 32 + 8 * fq;
        if constexpr (!RES_F32) {
            u32x4 rb[2][4][2];
#pragma unroll
            for (int ai = 0; ai < 2; ++ai)
#pragma unroll
                for (int m = 0; m < 4; ++m) {
                    const size_t off = (size_t)(u.pm * 256 + ai * 128 + wr * 64 + m * 16 + fr) * DMODEL + col0;
#pragma unroll
                    for (int bj = 0; bj < 2; ++bj) rb[ai][m][bj] = __builtin_nontemporal_load((const u32x4*)((const bf16*)resid + off + bj * 128));
                }
            asm volatile("" ::: "memory");
#pragma unroll
            for (int ai = 0; ai < 2; ++ai)
#pragma unroll
                for (int m = 0; m < 4; ++m) {
                    const int row = u.pm * 256 + ai * 128 + wr * 64 + m * 16 + fr;
                    const size_t off = (size_t)row * DMODEL + col0;
                    float q = 0.f;
#pragma unroll
                    for (int bj = 0; bj < 2; ++bj) {
                        const f32x4 x0 = bf_lo2(rb[ai][m][bj].x, rb[ai][m][bj].y) + acc[ai][bj][m][0], x1 = bf_lo2(rb[ai][m][bj].z, rb[ai][m][bj].w) + acc[ai][bj][m][1];
                        q += dot4(x0) + dot4(x1);
                        if (OUT_F32) { *(f32x4*)((float*)out + off + bj * 128) = x0; *(f32x4*)((float*)out + off + bj * 128 + 4) = x1; }
                        else { u32x4 w; w.x = pg8::cvt_pk_bf16(x0[0], x0[1]); w.y = pg8::cvt_pk_bf16(x0[2], x0[3]); w.z = pg8::cvt_pk_bf16(x1[0], x1[1]); w.w = pg8::cvt_pk_bf16(x1[2], x1[3]);
                            *(u32x4*)((bf16*)out + off + bj * 128) = w; }
                    }
                    if (ss) { q = fqsum(q); if (fq == 0) atomicAdd(ss + row, q); }
                }
        } else {
#pragma unroll
            for (int ai = 0; ai < 2; ++ai)
#pragma unroll
                for (int mp = 0; mp < 4; mp += 2) {
                    f32x4 rr[2][2][2];
#pragma unroll
                    for (int mm = 0; mm < 2; ++mm) {
                        const size_t off = (size_t)(u.pm * 256 + ai * 128 + wr * 64 + (mp + mm) * 16 + fr) * DMODEL + col0;
#pragma unroll
                        for (int bj = 0; bj < 2; ++bj) { rr[mm][bj][0] = *(const f32x4*)((const float*)resid + off + bj * 128); rr[mm][bj][1] = *(const f32x4*)((const float*)resid + off + bj * 128 + 4); }
                    }
#pragma unroll
                    for (int mm = 0; mm < 2; ++mm) {
                        const int m = mp + mm;
                        const int row = u.pm * 256 + ai * 128 + wr * 64 + m * 16 + fr;
                        const size_t off = (size_t)row * DMODEL + col0;
                        float q = 0.f;
#pragma unroll
                        for (int bj = 0; bj < 2; ++bj) {
                            const f32x4 x0 = rr[mm][bj][0] + acc[ai][bj][m][0], x1 = rr[mm][bj][1] + acc[ai][bj][m][1];
                            q += dot4(x0) + dot4(x1);
                            if (OUT_F32) { *(f32x4*)((float*)out + off + bj * 128) = x0; *(f32x4*)((float*)out + off + bj * 128 + 4) = x1; }
                            else { u32x4 w; w.x = pg8::cvt_pk_bf16(x0[0], x0[1]); w.y = pg8::cvt_pk_bf16(x0[2], x0[3]); w.z = pg8::cvt_pk_bf16(x1[0], x1[1]); w.w = pg8::cvt_pk_bf16(x1[2], x1[3]);
                                *(u32x4*)((bf16*)out + off + bj * 128) = w; }
                        }
                        if (ss) { q = fqsum(q); if (fq == 0) atomicAdd(ss + row, q); }
                    }
                    asm volatile("" ::: "memory");
                }
        }
    }
};

__device__ __forceinline__ void shr1_into(f32x4& d, const f32x4 s) {
    float d0 = d[0], d1 = d[1], d2 = d[2], d3 = d[3];
    asm volatile("s_nop 1\n\tv_mov_b32_dpp %0, %4 row_shr:1 row_mask:0xf bank_mask:0xf\n\tv_mov_b32_dpp %1, %5 row_shr:1 row_mask:0xf bank_mask:0xf\n\t"
                 "v_mov_b32_dpp %2, %6 row_shr:1 row_mask:0xf bank_mask:0xf\n\tv_mov_b32_dpp %3, %7 row_shr:1 row_mask:0xf bank_mask:0xf"
                 : "+v"(d0), "+v"(d1), "+v"(d2), "+v"(d3) : "v"(s[0]), "v"(s[1]), "v"(s[2]), "v"(s[3]));
    d = (f32x4){d0, d1, d2, d3};
}
__device__ __forceinline__ f32x4 ror1(f32x4 v) { return (f32x4){dpp_ror<0x121>(v[0]), dpp_ror<0x121>(v[1]), dpp_ror<0x121>(v[2]), dpp_ror<0x121>(v[3])}; }
__device__ __forceinline__ f32x4 ror2(f32x4 v) { return (f32x4){dpp_ror<0x122>(v[0]), dpp_ror<0x122>(v[1]), dpp_ror<0x122>(v[2]), dpp_ror<0x122>(v[3])}; }
__device__ __forceinline__ float silu_mul(float gte, float val) { const float e = __builtin_amdgcn_exp2f(gte * -1.4426950408889634f); return gte * __builtin_amdgcn_rcpf(1.0f + e) * val; }
constexpr int EDGE_ROWS = 4;
struct EpiUpConv {
    static constexpr bool PROBE2 = (PROBE_EPI2 & 2) != 0, AROWPERM = true;
    const float* ss; const float* cw; const float* cb; bf16* Hh; float* edge;
    __device__ __forceinline__ void prefetch(const pg8::Unit& u, LAS unsigned char* xlds, int wid, int lane) const {
        const unsigned l16 = (unsigned)lane * 16u;
        if (wid == 0) dma1k(ss + u.pm * 256, xlds + XL_SS, l16);
        if (wid >= 1 && wid <= 4) {
            const float* src = ((wid == 4) ? cb : cw + (size_t)(wid - 1) * NUP) + u.pn * 128;
            dma1k(src, xlds + XL_CW + (wid - 1) * 1024, l16 + ((lane < 32) ? 0u : (unsigned)(DFF - 128) * 4u));
        }
    }
    __device__ __forceinline__ void operator()(const f32x4 (&acc)[2][2][4][2], const pg8::Unit& u, int wr, int wc, int fr, int fq, LAS unsigned char* xlds) const {
        float rs[2][4];
#pragma unroll
        for (int ai = 0; ai < 2; ++ai)
#pragma unroll
            for (int m = 0; m < 4; ++m) rs[ai][m] = lds_rstd(xlds, ai * 128 + wr * 64 + 4 * fr + m);
        LAS f32x4* EX = (LAS f32x4*)(xlds + XL_EX);
        if (fr == 15) {
#pragma unroll
            for (int ai = 0; ai < 2; ++ai)
#pragma unroll
                for (int mm = 0; mm < 2; ++mm)
#pragma unroll
                    for (int bj = 0; bj < 2; ++bj)
#pragma unroll
                        for (int n = 0; n < 2; ++n) EX[((((ai * 2 + wr) * 4 + wc) * 2 + mm) * 4 + fq) * 4 + bj * 2 + n] = acc[ai][bj][2 + mm][n] * rs[ai][2 + mm];
        }
        {
            const int pcol = u.pn * 256 + wc * 32 + 8 * fq;
            float* eb = edge + (size_t)u.pm * EDGE_ROWS * NUP + pcol;
            if (wr == 0 && fr == 0) {
#pragma unroll
                for (int mm = 0; mm < 2; ++mm)
#pragma unroll
                    for (int bj = 0; bj < 2; ++bj)
#pragma unroll
                        for (int n = 0; n < 2; ++n) *(f32x4*)(eb + (size_t)mm * NUP + bj * 128 + 4 * n) = acc[0][bj][mm][n] * rs[0][mm];
            }
            if (wr == 1 && fr == 15) {
#pragma unroll
                for (int mm = 0; mm < 2; ++mm)
#pragma unroll
                    for (int bj = 0; bj < 2; ++bj)
#pragma unroll
                        for (int n = 0; n < 2; ++n) *(f32x4*)(eb + (size_t)(2 + mm) * NUP + bj * 128 + 4 * n) = acc[1][bj][2 + mm][n] * rs[1][2 + mm];
            }
        }
        asm volatile("s_waitcnt lgkmcnt(0)" ::: "memory"); __builtin_amdgcn_s_barrier(); asm volatile("" ::: "memory");
        const bool seq_start = (u.pm & 15) == 0;
        const int jg0 = u.pn * 128 + wc * 32 + 8 * fq;
        u32x2 hold[2][4];
#pragma unroll
        for (int n = 0; n < 2; ++n) {
            f32x4 w0[2], w1[2], w2[2], bb[2];
#pragma unroll
            for (int bj = 0; bj < 2; ++bj) {
                const int pc = (bj * 128 + wc * 32 + 8 * fq + 4 * n) * 4;
                w0[bj] = *(const LAS f32x4*)(xlds + XL_CW + pc); w1[bj] = *(const LAS f32x4*)(xlds + XL_CW + 1024 + pc); w2[bj] = *(const LAS f32x4*)(xlds + XL_CW + 2048 + pc); bb[bj] = *(const LAS f32x4*)(xlds + XL_CW + 3072 + pc);
            }
#pragma unroll
            for (int ai = 0; ai < 2; ++ai) {
                f32x4 uc[2][4];
#pragma unroll
                for (int bj = 0; bj < 2; ++bj) {
                    f32x4 h62, h63;
                    if (ai == 0 && wr == 0) { h62 = (f32x4){0.f, 0.f, 0.f, 0.f}; h63 = h62; }
                    else { const int sa = (wr == 1) ? ai : ai - 1, sw = (wr == 1) ? 0 : 1;
                        h62 = EX[((((sa * 2 + sw) * 4 + wc) * 2 + 0) * 4 + fq) * 4 + bj * 2 + n]; h63 = EX[((((sa * 2 + sw) * 4 + wc) * 2 + 1) * 4 + fq) * 4 + bj * 2 + n]; }
                    f32x4 c[4];
#pragma unroll
                    for (int m = 0; m < 4; ++m) c[m] = acc[ai][bj][m][n] * rs[ai][m];
                    f32x4 x1 = h63, x2 = h62;
                    shr1_into(x1, c[3]); shr1_into(x2, c[2]);
                    uc[bj][0] = bb[bj] + w0[bj] * x2 + w1[bj] * x1 + w2[bj] * c[0];
                    uc[bj][1] = bb[bj] + w0[bj] * x1 + w1[bj] * c[0] + w2[bj] * c[1];
                    uc[bj][2] = bb[bj] + w0[bj] * c[0] + w1[bj] * c[1] + w2[bj] * c[2];
                    uc[bj][3] = bb[bj] + w0[bj] * c[1] + w1[bj] * c[2] + w2[bj] * c[3];
                }
#pragma unroll
                for (int m = 0; m < 4; ++m) {
                    const unsigned lo = pg8::cvt_pk_bf16(silu_mul(uc[0][m][0], uc[1][m][0]), silu_mul(uc[0][m][1], uc[1][m][1]));
                    const unsigned hi = pg8::cvt_pk_bf16(silu_mul(uc[0][m][2], uc[1][m][2]), silu_mul(uc[0][m][3], uc[1][m][3]));
                    if (n == 0) { hold[ai][m] = (u32x2){lo, hi}; }
                    else {
                        const int row = u.pm * 256 + ai * 128 + wr * 64 + 4 * fr + m;
                        const bool skip = (!seq_start) && ai == 0 && wr == 0 && m < 2 && fr == 0;
                        if (!skip) { u32x4 w; w.x = hold[ai][m].x; w.y = hold[ai][m].y; w.z = lo; w.w = hi; *(u32x4*)(Hh + (size_t)row * DFF + jg0) = w; }
                    }
                }
                asm volatile("" ::: "memory");
            }
        }
    }
};

namespace attn {
using bf16x8 = __attribute__((ext_vector_type(8))) short;
using s16x4 = __attribute__((ext_vector_type(4))) short;
using f32x16 = __attribute__((ext_vector_type(16))) float;
using u32x4 = ::u32x4;
constexpr int DM = 1024, NW = 8, QBLK = 32, QB = 256, KVBLK = 64;
constexpr int NSLOT = 3, SLOTB = 8192;
constexpr int LDS_K = 0, LDS_V = NSLOT * SLOTB, LDS_WS = 2 * NSLOT * SLOTB, LDS_OST = LDS_WS + NW * 64 * 4, LDS_BYTES = LDS_OST + NW * 4096;
constexpr int THRL = 8;
enum { OUT_FINAL = 0, OUT_PART = 1, OUT_MERGE = 2 };
struct Job {
    const bf16* Q; const bf16* K; const bf16* V;
    bf16* O;
    long rs;
    int q0, k0, NT;
    int ob;
    const float* kmean;
    float kbound;
    float* stat;
    const bf16* num0; const bf16* num1; const float* stat0; const float* stat1;
    long srs;
};
__device__ __forceinline__ int crow(int r, int hi) { return (r & 3) + 8 * (r >> 2) + 4 * hi; }
#define SBAR() __builtin_amdgcn_sched_barrier(0)
__device__ __forceinline__ void glds16_nt(const void* gsrc, unsigned lds_dst) { unsigned keep;
    asm volatile("s_mov_b32 %0, m0\n\ts_mov_b32 m0, %2\n\ts_nop 0\n\tglobal_load_lds_dwordx4 %1, off nt\n\ts_mov_b32 m0, %0" : "=&s"(keep) : "v"(gsrc), "s"(lds_dst) : "memory"); }
__device__ __forceinline__ void glds16(const void* gsrc, unsigned lds_dst) { unsigned keep;
    asm volatile("s_mov_b32 %0, m0\n\ts_mov_b32 m0, %2\n\ts_nop 0\n\tglobal_load_lds_dwordx4 %1, off\n\ts_mov_b32 m0, %0" : "=&s"(keep) : "v"(gsrc), "s"(lds_dst) : "memory"); }
typedef float f32x2_t __attribute__((ext_vector_type(2))); typedef __bf16 bf16x2_t __attribute__((ext_vector_type(2)));
__device__ __forceinline__ unsigned cvtpk_s(float lo, float hi) { f32x2_t v = {lo, hi}; bf16x2_t b = __builtin_convertvector(v, bf16x2_t); return __builtin_bit_cast(unsigned, b); }
#define WAIT_BAR(N) asm volatile("s_waitcnt vmcnt(" #N ") lgkmcnt(0)\n\ts_barrier" ::: "memory")
typedef __attribute__((address_space(3))) const char* lds_cptr;
typedef short v4i16_t __attribute__((ext_vector_type(4)));
__device__ __forceinline__ void kload8(bf16x8* kf, lds_cptr kp) {
    kf[0] = *(const __attribute__((address_space(3))) bf16x8*)(kp);        kf[1] = *(const __attribute__((address_space(3))) bf16x8*)(kp + 512);
    kf[2] = *(const __attribute__((address_space(3))) bf16x8*)(kp + 2048); kf[3] = *(const __attribute__((address_space(3))) bf16x8*)(kp + 2560);
    kf[4] = *(const __attribute__((address_space(3))) bf16x8*)(kp + 4096); kf[5] = *(const __attribute__((address_space(3))) bf16x8*)(kp + 4608);
    kf[6] = *(const __attribute__((address_space(3))) bf16x8*)(kp + 6144); kf[7] = *(const __attribute__((address_space(3))) bf16x8*)(kp + 6656);
}
__device__ __forceinline__ void kload2(bf16x8* kf, lds_cptr kp, int j) { kf[2 * j] = *(const __attribute__((address_space(3))) bf16x8*)(kp + j * 2048); kf[2 * j + 1] = *(const __attribute__((address_space(3))) bf16x8*)(kp + j * 2048 + 512); }
__device__ __forceinline__ s16x4 vtr(lds_cptr p) { return __builtin_bit_cast(s16x4, __builtin_amdgcn_ds_read_tr16_b64_v4i16((__attribute__((address_space(3))) v4i16_t*)p)); }
#define MX3(a, b, c) __builtin_fmaxf(__builtin_fmaxf((a), (b)), (c))
__device__ __forceinline__ float rowmax32(const f32x16& p0, const f32x16& p1) {
    float a = MX3(p0[0], p0[1], p1[0]), b = MX3(p0[2], p0[3], p1[1]); a = MX3(a, p1[2], p1[3]);
#pragma unroll
    for (int r = 4; r < 16; r += 4) { a = MX3(a, p0[r], p0[r + 1]); b = MX3(b, p0[r + 2], p0[r + 3]); a = MX3(a, p1[r], p1[r + 1]); b = MX3(b, p1[r + 2], p1[r + 3]); }
    float m = __builtin_fmaxf(a, b); auto rr = __builtin_amdgcn_permlane32_swap(__float_as_uint(m), __float_as_uint(m), false, false);
    return __builtin_fmaxf(__uint_as_float(rr[0]), __uint_as_float(rr[1]));
}
__device__ __forceinline__ float halves_sum(float v) { auto rr = __builtin_amdgcn_permlane32_swap(__float_as_uint(v), __float_as_uint(v), false, false); return __uint_as_float(rr[0]) + __uint_as_float(rr[1]); }
__device__ __forceinline__ void bmask(f32x16& p0, f32x16& p1, int Dt, unsigned lim) {
#pragma unroll
    for (int r = 0; r < 16; ++r) { const int x = Dt - ((r & 3) + 8 * (r >> 2)); if ((unsigned)x > lim) p0[r] = -INFINITY; if ((unsigned)(x - 32) > lim) p1[r] = -INFINITY; }
}
__device__ __forceinline__ void pv(f32x16* o, int vb, bf16x8 pa0, bf16x8 pa1, bf16x8 pa2, bf16x8 pa3) {
#pragma unroll
    for (int d0 = 0; d0 < 2; ++d0) { s16x4 lo[4], hi[4];
#pragma unroll
        for (int ks = 0; ks < 4; ++ks) {
            asm volatile("ds_read_b64_tr_b16 %0,%1 offset:%c2" : "=&v"(lo[ks]) : "v"(vb), "i"(d0 * 4096 + ks * 1024) : "memory");
            asm volatile("ds_read_b64_tr_b16 %0,%1 offset:%c2" : "=&v"(hi[ks]) : "v"(vb), "i"(d0 * 4096 + ks * 1024 + 512) : "memory"); }
        asm volatile("s_waitcnt lgkmcnt(0)" ::: "memory"); SBAR();
#define PK(k) (bf16x8){lo[k][0], lo[k][1], lo[k][2], lo[k][3], hi[k][0], hi[k][1], hi[k][2], hi[k][3]}
        o[d0] = __builtin_amdgcn_mfma_f32_32x32x16_bf16(pa0, PK(0), o[d0], 0, 0, 0);
        o[d0] = __builtin_amdgcn_mfma_f32_32x32x16_bf16(pa1, PK(1), o[d0], 0, 0, 0);
        o[d0] = __builtin_amdgcn_mfma_f32_32x32x16_bf16(pa2, PK(2), o[d0], 0, 0, 0);
        o[d0] = __builtin_amdgcn_mfma_f32_32x32x16_bf16(pa3, PK(3), o[d0], 0, 0, 0);
#undef PK
    }
}

template <int OUT> __device__ __forceinline__ void unit_epilogue(const Job& J, float* wsf, unsigned short* stg  , int wid, int lane, float l_reg, float mhat, const f32x16 (&o)[2]) {
    const int r32 = lane & 31, hi = lane >> 5; const long rs = J.rs;
    l_reg = halves_sum(l_reg);
    if (hi == 0) { wsf[32 + r32] = l_reg; wsf[r32] = mhat; }
    asm volatile("s_waitcnt lgkmcnt(0)" ::: "memory");
    const long orow0 = (long)(J.q0 + wid * QBLK);
    if (OUT == OUT_PART) { if (hi == 0) { float* sp = J.stat + (orow0 + r32) * J.srs; *(f32x2*)sp = (f32x2){l_reg, mhat}; } }
#pragma unroll
    for (int hf = 0; hf < 2; ++hf) {
#pragma unroll
        for (int rr = 0; rr < 8; ++rr) { const int r = 8 * hf + rr; const int orow = crow(rr, hi);
            const float sc = (OUT == OUT_FINAL) ? __builtin_amdgcn_rcpf(wsf[32 + crow(r, hi)]) : 1.0f;
#pragma unroll
            for (int d0 = 0; d0 < 2; ++d0) stg[orow * 64 + d0 * 32 + r32] = (unsigned short)(cvtpk_s(o[d0][r] * sc, 0.f) & 0xffffu); }
        asm volatile("s_waitcnt lgkmcnt(0)" ::: "memory");
#pragma unroll
        for (int i = 0; i < 2; ++i) {
            const int srow = i * 8 + (lane >> 3), row = 16 * hf + srow, ch = lane & 7;
            const u32x4 v = *(const u32x4*)(stg + srow * 64 + ch * 8);
            const long go = (orow0 + row) * rs + ch * 8;
            if (OUT == OUT_MERGE) {
                const float l2 = wsf[32 + row], m2 = wsf[row];
                const f32x2 s0 = *(const f32x2*)(J.stat0 + (orow0 + row) * J.srs), s1 = *(const f32x2*)(J.stat1 + (orow0 + row) * J.srs);
                const u32x4 n0 = *(const u32x4*)(J.num0 + go), n1 = *(const u32x4*)(J.num1 + go);
                const float mx = MX3(s0.y, s1.y, m2);
                const float w0 = __builtin_amdgcn_exp2f(s0.y - mx), w1 = __builtin_amdgcn_exp2f(s1.y - mx), w2 = __builtin_amdgcn_exp2f(m2 - mx);
                const float inv = 1.0f / (w0 * s0.x + w1 * s1.x + w2 * l2);
                const float a0 = w0 * inv, a1 = w1 * inv, a2 = w2 * inv;
                u32x4 w;
#pragma unroll
                for (int e = 0; e < 4; ++e) {
                    const float lo = a0 * __uint_as_float(n0[e] << 16) + a1 * __uint_as_float(n1[e] << 16) + a2 * __uint_as_float(v[e] << 16);
                    const float hh = a0 * __uint_as_float(n0[e] & 0xffff0000u) + a1 * __uint_as_float(n1[e] & 0xffff0000u) + a2 * __uint_as_float(v[e] & 0xffff0000u);
                    w[e] = cvtpk_s(lo, hh);
                }
                *(u32x4*)(J.O + go) = w;
            } else {
                *(u32x4*)(J.O + go) = v;
            }
        }
        asm volatile("s_waitcnt lgkmcnt(0)" ::: "memory");
    }
}

__device__ __forceinline__ void ring_issue(const int tid, const Job& J, char* shm) {
    const int lane = tid & 63; const int wid = __builtin_amdgcn_readfirstlane(tid >> 6);
    const long rs = J.rs;
    const bf16* Kh = J.K + (long)J.k0 * rs; const bf16* Vh = J.V + (long)J.k0 * rs;
    const unsigned lds0 = (unsigned)(uintptr_t)shm;
    const bf16* ksrc = Kh + (long)lane * rs + wid * 8;
    const bf16* vsrc = Vh + (long)(16 * (wid & 3) + (lane >> 2)) * rs + (wid >> 2) * 32 + (lane & 3) * 8;
    const unsigned kdst = lds0 + LDS_K + wid * 1024, vdst = lds0 + LDS_V + wid * 1024;
    glds16(ksrc, (unsigned)__builtin_amdgcn_readfirstlane(kdst)); glds16(vsrc, (unsigned)__builtin_amdgcn_readfirstlane(vdst));
    glds16(ksrc + (long)KVBLK * rs, (unsigned)__builtin_amdgcn_readfirstlane(kdst + SLOTB)); glds16(ksrc + (long)2 * KVBLK * rs, (unsigned)__builtin_amdgcn_readfirstlane(kdst + 2 * SLOTB));
}
template <bool MOBA, bool FIXED = false> __device__ __forceinline__ void attn_unit(const int tid, const Job& J, char* shm, float& l_out, float& m_out, f32x16 (&o)[2]) {
    const int lane = tid & 63, r32 = lane & 31, hi = lane >> 5; const int wid = __builtin_amdgcn_readfirstlane(tid >> 6);
    const long rs = J.rs; const int NT = J.NT;
    const bf16* Qw = J.Q + (long)(J.q0 + wid * QBLK) * rs;
    const bf16* Kh = J.K + (long)J.k0 * rs; const bf16* Vh = J.V + (long)J.k0 * rs;
    const unsigned lds0 = (unsigned)(uintptr_t)shm;
    float* wsf = (float*)(shm + LDS_WS) + wid * 64;
    const bf16* ksrc = Kh + (long)lane * rs + wid * 8;
    const bf16* vsrc = Vh + (long)(16 * (wid & 3) + (lane >> 2)) * rs + (wid >> 2) * 32 + (lane & 3) * 8;
    const unsigned kdst = lds0 + LDS_K + wid * 1024, vdst = lds0 + LDS_V + wid * 1024;
#define DMA_K(t, slot) glds16(ksrc + (long)(t) * KVBLK * rs, (unsigned)__builtin_amdgcn_readfirstlane(kdst + (slot)))
#define DMA_V(t, slot) glds16(vsrc + (long)(t) * KVBLK * rs, (unsigned)__builtin_amdgcn_readfirstlane(vdst + (slot)))
    const int vb0 = (int)(lds0 + LDS_V) + ((lane >> 4) & 1) * 32 + (lane & 3) * 8 + (4 * hi + ((lane & 15) >> 2)) * 64;
    bf16x8 kf[8];
    const lds_cptr shm3 = (lds_cptr)shm; const lds_cptr kp0 = shm3 + LDS_K + hi * 1024 + r32 * 16; const lds_cptr vp0 = shm3 + LDS_V + ((lane >> 4) & 1) * 32 + (lane & 3) * 8 + (4 * hi + ((lane & 15) >> 2)) * 64;
    bf16x8 qr[4];
#pragma unroll
    for (int d0 = 0; d0 < 4; ++d0) qr[d0] = *reinterpret_cast<const bf16x8*>(&Qw[(long)r32 * rs + d0 * 16 + hi * 8]);
    unsigned sel = 0xffffffffu;
    if (MOBA) {
        const int ob = J.ob; float gt[16];
        { const float* km = J.kmean + ((r32 < 16) ? r32 : 15) * 64 + hi * 8;
          f32x16 g = f32x16{};
#pragma unroll
          for (int d0 = 0; d0 < 4; ++d0) {
              const f32x4 a = *(const f32x4*)(km + d0 * 16), b = *(const f32x4*)(km + d0 * 16 + 4);
              u32x4 H, L;
              H[0] = cvtpk_s(a[0], a[1]); H[1] = cvtpk_s(a[2], a[3]); H[2] = cvtpk_s(b[0], b[1]); H[3] = cvtpk_s(b[2], b[3]);
              L[0] = cvtpk_s(a[0] - __uint_as_float(H[0] << 16), a[1] - __uint_as_float(H[0] & 0xffff0000u)); L[1] = cvtpk_s(a[2] - __uint_as_float(H[1] << 16), a[3] - __uint_as_float(H[1] & 0xffff0000u));
              L[2] = cvtpk_s(b[0] - __uint_as_float(H[2] << 16), b[1] - __uint_as_float(H[2] & 0xffff0000u)); L[3] = cvtpk_s(b[2] - __uint_as_float(H[3] << 16), b[3] - __uint_as_float(H[3] & 0xffff0000u));
              g = __builtin_amdgcn_mfma_f32_32x32x16_bf16(__builtin_bit_cast(bf16x8, H), qr[d0], g, 0, 0, 0);
              g = __builtin_amdgcn_mfma_f32_32x32x16_bf16(__builtin_bit_cast(bf16x8, L), qr[d0], g, 0, 0, 0);
          }
#pragma unroll
          for (int r = 0; r < 8; ++r) { auto rr = __builtin_amdgcn_permlane32_swap(__float_as_uint(g[r]), __float_as_uint(g[r]), false, false);
              gt[crow(r, 0)] = __uint_as_float(rr[0]); gt[crow(r, 1)] = __uint_as_float(rr[1]); }
        }
        sel = 0u;
#pragma unroll
        for (int k = 0; k < 3; ++k) {
            float best = -INFINITY; int bi = -1;
#pragma unroll
            for (int j = 0; j < 15; ++j) { const bool c = (j < ob) && (((sel >> j) & 1u) == 0u) && (gt[j] > best); best = c ? gt[j] : best; bi = c ? j : bi; }
            if (bi >= 0) sel |= 1u << bi;
        }
        sel |= 1u << ob;
    }
    float mhat = 0.f, l_reg = 0.f; o[0] = f32x16{}; o[1] = f32x16{};
    if (FIXED) { float qq = 0.f;
#pragma unroll
        for (int d0 = 0; d0 < 4; ++d0)
#pragma unroll
            for (int e = 0; e < 8; ++e) { const float v = bf2f((unsigned short)qr[d0][e]); qq += v * v; }
        mhat = __builtin_sqrtf(halves_sum(qq)) * J.kbound; }
    bool selc = MOBA ? ((sel & 1u) != 0u) : true;
    f32x16 negm;
    { const float nv = selc ? -mhat : -INFINITY;
#pragma unroll
      for (int r = 0; r < 16; ++r) negm[r] = nv; }
    asm volatile("" : "+v"(negm));
    const int qrel = wid * QBLK + r32;
    const int D0 = MOBA ? (qrel - 4 * hi) : (J.q0 + qrel - J.k0 - 4 * hi);
    const int toff = MOBA ? (NT - 4) : 0, tmlo = MOBA ? (NT - 4) : 0;
    const unsigned mlim = MOBA ? 0x7fffffffu : 128u;
#define CMASK(P0, P1, t) do { if ((t) >= tmlo) bmask(P0, P1, D0 - 64 * ((t) - toff), mlim); } while (0)
#define SETNEG(j) do { if (MOBA) { selc = ((sel >> (j)) & 1u) != 0u; const float nv_ = selc ? -mhat : -INFINITY; _Pragma("unroll") for (int r = 0; r < 16; ++r) negm[r] = nv_; asm volatile("" : "+v"(negm)); } } while (0)
    bool resc = false;
#define RESC() do { if (resc) { asm volatile("s_waitcnt lgkmcnt(0)" ::: "memory"); \
      _Pragma("unroll") for (int d_ = 0; d_ < 2; ++d_) _Pragma("unroll") for (int r = 0; r < 16; ++r) o[d_][r] *= wsf[crow(r, hi)]; } } while (0)
    f32x16 pA0, pA1, pB0, pB1;
    int sl_prev = 0, sl_cur = 0, sl_next = SLOTB;
#define ROT() do { sl_prev = sl_cur; sl_cur = sl_next; sl_next = (sl_next == (NSLOT - 1) * SLOTB) ? 0 : sl_next + SLOTB; } while (0)
    WAIT_BAR(3);
    kload8(kf, kp0);
    pA0 = __builtin_amdgcn_mfma_f32_32x32x16_bf16(kf[0], qr[0], negm, 0, 0, 0); pA1 = __builtin_amdgcn_mfma_f32_32x32x16_bf16(kf[1], qr[0], negm, 0, 0, 0);
    pA0 = __builtin_amdgcn_mfma_f32_32x32x16_bf16(kf[2], qr[1], pA0, 0, 0, 0);  pA1 = __builtin_amdgcn_mfma_f32_32x32x16_bf16(kf[3], qr[1], pA1, 0, 0, 0);
    pA0 = __builtin_amdgcn_mfma_f32_32x32x16_bf16(kf[4], qr[2], pA0, 0, 0, 0);  pA1 = __builtin_amdgcn_mfma_f32_32x32x16_bf16(kf[5], qr[2], pA1, 0, 0, 0);
    pA0 = __builtin_amdgcn_mfma_f32_32x32x16_bf16(kf[6], qr[3], pA0, 0, 0, 0);  pA1 = __builtin_amdgcn_mfma_f32_32x32x16_bf16(kf[7], qr[3], pA1, 0, 0, 0);
    CMASK(pA0, pA1, 0);
    { const float rm = FIXED ? 0.f : rowmax32(pA0, pA1);
      if (!FIXED && __any(rm > (float)THRL)) { const float dl = __builtin_fmaxf(rm, 0.f); mhat += dl;
#pragma unroll
          for (int r = 0; r < 16; ++r) { pA0[r] -= dl; pA1[r] -= dl; }
          const float nv = selc ? -mhat : -INFINITY;
#pragma unroll
          for (int r = 0; r < 16; ++r) negm[r] = nv;
          asm volatile("" : "+v"(negm)); }
#pragma unroll
      for (int r = 0; r < 16; ++r) { pA0[r] = __builtin_amdgcn_exp2f(pA0[r]); pA1[r] = __builtin_amdgcn_exp2f(pA1[r]); } }
    WAIT_BAR(0);
    DMA_K(3, 0); DMA_V(1, SLOTB);
    ROT();
    kload8(kf, kp0 + sl_cur);
    WAIT_BAR(2);
    s16x4 vlo[8], vhi[8]; u32x4 pw0, pw1, pw2, pw3;
#define PKW(P, B) cvtpk_s(P[B], P[B + 1])
#define PAF(k) __builtin_bit_cast(bf16x8, pw##k)
#define VFR(i) (bf16x8){vlo[i][0], vlo[i][1], vlo[i][2], vlo[i][3], vhi[i][0], vhi[i][1], vhi[i][2], vhi[i][3]}
#define PIN(x) asm volatile("" : "+v"(x))
#define GAPA(MF, A0, A1, A2, A3, W0, W1, PW) do { MF; sacc += A0; sacc += A1; sacc += A2; sacc += A3; PIN(sacc); W0; W1; PIN(PW); SBAR(); } while (0)
#define EX(v) __builtin_amdgcn_exp2f(v)
#define GAPB(MF, X, B) do { MF; X[B] = EX(X[B]); X[B + 1] = EX(X[B + 1]); X[B + 2] = EX(X[B + 2]); X[B + 3] = EX(X[B + 3]); PIN(X); SBAR(); } while (0)
#define VRD(i) do { vlo[i] = vtr(vp_ + (((i) >> 2) * 4096 + ((i) & 3) * 1024)); vhi[i] = vtr(vp_ + (((i) >> 2) * 4096 + ((i) & 3) * 1024 + 512)); } while (0)
#define KRD(G, j) do { if (G) { kload2(kf, kp0 + sl_next, j); SBAR(); } } while (0)
#define STEP(C0, C1, P0, P1, t, GK, GV, GL) do { SBAR(); \
    const lds_cptr vp_ = vp0 + sl_prev; \
    VRD(0); SBAR(); float sacc = (P0[0] + P0[1]); \
    GAPA(C0 = __builtin_amdgcn_mfma_f32_32x32x16_bf16(kf[0], qr[0], negm, 0, 0, 0), P0[2], P0[3], P0[4], P0[5],     pw0[0] = PKW(P0, 0), pw0[1] = PKW(P0, 2), pw0); \
    VRD(4); SBAR(); GAPA(C1 = __builtin_amdgcn_mfma_f32_32x32x16_bf16(kf[1], qr[0], negm, 0, 0, 0), P0[6], P0[7], P0[8], P0[9],     pw0[2] = PKW(P0, 4), pw0[3] = PKW(P0, 6), pw0); \
    VRD(1); SBAR(); GAPA(C0 = __builtin_amdgcn_mfma_f32_32x32x16_bf16(kf[2], qr[1], C0, 0, 0, 0),   P0[10], P0[11], P0[12], P0[13], pw1[0] = PKW(P0, 8), pw1[1] = PKW(P0, 10), pw1); \
    VRD(5); SBAR(); GAPA(C1 = __builtin_amdgcn_mfma_f32_32x32x16_bf16(kf[3], qr[1], C1, 0, 0, 0),   P0[14], P0[15], P1[0], P1[1],   pw1[2] = PKW(P0, 12), pw1[3] = PKW(P0, 14), pw1); \
    VRD(2); SBAR(); GAPA(C0 = __builtin_amdgcn_mfma_f32_32x32x16_bf16(kf[4], qr[2], C0, 0, 0, 0),   P1[2], P1[3], P1[4], P1[5],     pw2[0] = PKW(P1, 0), pw2[1] = PKW(P1, 2), pw2); \
    VRD(6); SBAR(); GAPA(C1 = __builtin_amdgcn_mfma_f32_32x32x16_bf16(kf[5], qr[2], C1, 0, 0, 0),   P1[6], P1[7], P1[8], P1[9],     pw2[2] = PKW(P1, 4), pw2[3] = PKW(P1, 6), pw2); \
    VRD(3); SBAR(); GAPA(C0 = __builtin_amdgcn_mfma_f32_32x32x16_bf16(kf[6], qr[3], C0, 0, 0, 0),   P1[10], P1[11], P1[12], P1[13], pw3[0] = PKW(P1, 8), pw3[1] = PKW(P1, 10), pw3); \
    VRD(7); SBAR(); GAPA(C1 = __builtin_amdgcn_mfma_f32_32x32x16_bf16(kf[7], qr[3], C1, 0, 0, 0),   P1[14], P1[15], 0.f, 0.f,       pw3[2] = PKW(P1, 12), pw3[3] = PKW(P1, 14), pw3); \
    l_reg += sacc; \
    if (GK) { DMA_K((t) + 3, sl_cur); } if (GV) { DMA_V((t) + 1, sl_next); } \
    CMASK(C0, C1, t); \
    if (!FIXED) { float a = MX3(C0[0], C0[1], C1[0]), b = MX3(C0[2], C0[3], C1[1]); a = MX3(a, C1[2], C1[3]); \
      _Pragma("unroll") for (int r = 4; r < 16; r += 4) { a = MX3(a, C0[r], C0[r + 1]); b = MX3(b, C0[r + 2], C0[r + 3]); a = MX3(a, C1[r], C1[r + 1]); b = MX3(b, C1[r + 2], C1[r + 3]); } \
      float rm = __builtin_fmaxf(a, b); { auto rr = __builtin_amdgcn_permlane32_swap(__float_as_uint(rm), __float_as_uint(rm), false, false); rm = __builtin_fmaxf(__uint_as_float(rr[0]), __uint_as_float(rr[1])); } \
      resc = false; \
      if (__builtin_expect(__any(rm > (float)THRL), 0)) { const float dl = __builtin_fmaxf(rm, 0.f); mhat += dl; \
        _Pragma("unroll") for (int r = 0; r < 16; ++r) { C0[r] -= dl; C1[r] -= dl; } \
        { const float nv_ = selc ? -mhat : -INFINITY; _Pragma("unroll") for (int r = 0; r < 16; ++r) negm[r] = nv_; } asm volatile("" : "+v"(negm)); \
        const float f = __builtin_amdgcn_exp2f(-dl); l_reg *= f; if (hi == 0) wsf[r32] = f; resc = true; } } \
    SBAR(); \
    GAPB(o[0] = __builtin_amdgcn_mfma_f32_32x32x16_bf16(PAF(0), VFR(0), o[0], 0, 0, 0), C0, 0); \
    GAPB(o[1] = __builtin_amdgcn_mfma_f32_32x32x16_bf16(PAF(0), VFR(4), o[1], 0, 0, 0), C0, 4); \
    KRD(GL, 0); GAPB(o[0] = __builtin_amdgcn_mfma_f32_32x32x16_bf16(PAF(1), VFR(1), o[0], 0, 0, 0), C0, 8); \
    KRD(GL, 1); GAPB(o[1] = __builtin_amdgcn_mfma_f32_32x32x16_bf16(PAF(1), VFR(5), o[1], 0, 0, 0), C0, 12); \
    KRD(GL, 2); GAPB(o[0] = __builtin_amdgcn_mfma_f32_32x32x16_bf16(PAF(2), VFR(2), o[0], 0, 0, 0), C1, 0); \
    KRD(GL, 3); GAPB(o[1] = __builtin_amdgcn_mfma_f32_32x32x16_bf16(PAF(2), VFR(6), o[1], 0, 0, 0), C1, 4); \
    GAPB(o[0] = __builtin_amdgcn_mfma_f32_32x32x16_bf16(PAF(3), VFR(3), o[0], 0, 0, 0), C1, 8); \
    GAPB(o[1] = __builtin_amdgcn_mfma_f32_32x32x16_bf16(PAF(3), VFR(7), o[1], 0, 0, 0), C1, 12); \
    } while (0)
#define NEWBLK(t) do { if (MOBA && (((t) & 3) == 0)) SETNEG((t) >> 2); } while (0)
    int t = 1;
    if (MOBA) {
        for (; t + 5 < NT; t += 2) {
#undef CMASK
#define CMASK(P0, P1, t) do { } while (0)
            STEP(pB0, pB1, pA0, pA1, t, true, true, true);       WAIT_BAR(2); RESC(); ROT(); NEWBLK(t + 1);
            STEP(pA0, pA1, pB0, pB1, t + 1, true, true, true);   WAIT_BAR(2); RESC(); ROT();
        }
    }
#undef CMASK
#define CMASK(P0, P1, t) do { if ((t) >= tmlo) bmask(P0, P1, D0 - 64 * ((t) - toff), mlim); } while (0)
#define ENDW(tt) do { if ((tt) + 3 < NT) { WAIT_BAR(2); } else if ((tt) + 2 < NT) { WAIT_BAR(1); } else { WAIT_BAR(0); } } while (0)
    for (; t + 1 < NT; t += 2) {
        STEP(pB0, pB1, pA0, pA1, t, (t + 3 < NT), (t + 1 < NT), (t + 1 < NT));       ENDW(t);     RESC(); ROT(); NEWBLK(t + 1);
        STEP(pA0, pA1, pB0, pB1, t + 1, (t + 4 < NT), (t + 2 < NT), (t + 2 < NT));   ENDW(t + 1); RESC(); ROT();
    }
    STEP(pB0, pB1, pA0, pA1, NT - 1, false, false, false); RESC();
    { float sacc = pB0[0] + pB0[1];
#pragma unroll
      for (int r = 2; r < 16; ++r) sacc += pB0[r];
#pragma unroll
      for (int r = 0; r < 16; ++r) sacc += pB1[r];
      l_reg += sacc;
      pw0 = (u32x4){PKW(pB0, 0), PKW(pB0, 2), PKW(pB0, 4), PKW(pB0, 6)}; pw1 = (u32x4){PKW(pB0, 8), PKW(pB0, 10), PKW(pB0, 12), PKW(pB0, 14)};
      pw2 = (u32x4){PKW(pB1, 0), PKW(pB1, 2), PKW(pB1, 4), PKW(pB1, 6)}; pw3 = (u32x4){PKW(pB1, 8), PKW(pB1, 10), PKW(pB1, 12), PKW(pB1, 14)};
      SBAR(); pv(o, vb0 + sl_cur, PAF(0), PAF(1), PAF(2), PAF(3)); }
    l_out = l_reg; m_out = mhat;
    asm volatile("s_waitcnt lgkmcnt(0)\n\ts_barrier" ::: "memory");
#undef DMA_K
#undef DMA_V
#undef CMASK
#undef SETNEG
#undef NEWBLK
#undef RESC
#undef ROT
#undef PKW
#undef PAF
#undef VFR
#undef PIN
#undef GAPA
#undef GAPB
#undef EX
#undef VRD
#undef KRD
#undef STEP
#undef ENDW
}

constexpr int BK_K = 0, BK_V = 6 * SLOTB, BK_Q = 12 * SLOTB, BK_WS = 16 * SLOTB, BK_OST = BK_WS + NW * 256, BK_BYTES = BK_OST + NW * 2048;
__device__ __forceinline__ int ring6(int t, int rot) { const int s_ = t + rot; return s_ >= 6 ? s_ - 6 : s_; }
__device__ __forceinline__ void band_issue_kq(const int tid, const Job& J, char* shm, const bool first, const bool cont, const int rot) {
    const int lane = tid & 63; const int wid = __builtin_amdgcn_readfirstlane(tid >> 6);
    const long rs = J.rs; const unsigned lds0 = (unsigned)(uintptr_t)shm;
    const int prow = 8 * wid + (lane >> 3), pch = (lane & 7) ^ (lane >> 3);
    const bf16* ksrc = J.K + (long)(J.q0 - 128 + prow) * rs + pch * 8;
    const unsigned kdst = lds0 + BK_K + wid * 1024;
#pragma unroll
    for (int t = 0; t < 6; ++t) { if (cont && t < 2) continue; const int ts = (first && t < 2) ? 2 : t; glds16(ksrc + (long)ts * KVBLK * rs, (unsigned)__builtin_amdgcn_readfirstlane(kdst + ring6(t, rot) * SLOTB)); }
    const bf16* qsrc = J.Q + (long)(J.q0 + prow) * rs + pch * 8;
    const unsigned qdst = lds0 + BK_Q + wid * 1024;
#pragma unroll
    for (int g = 0; g < 4; ++g) glds16_nt(qsrc + (long)g * KVBLK * rs, (unsigned)__builtin_amdgcn_readfirstlane(qdst + g * SLOTB));
}
__device__ __forceinline__ void band_issue_v(const int tid, const Job& J, char* shm, const bool first, const bool cont, const int rot) {
    const int lane = tid & 63; const int wid = __builtin_amdgcn_readfirstlane(tid >> 6);
    const long rs = J.rs; const unsigned lds0 = (unsigned)(uintptr_t)shm;
    const bf16* vsrc = J.V + (long)(J.q0 - 128 + 16 * (wid & 3) + (lane >> 2)) * rs + (wid >> 2) * 32 + (lane & 3) * 8;
    const unsigned vdst = lds0 + BK_V + wid * 1024;
#pragma unroll
    for (int t = 0; t < 6; ++t) { if (cont && t < 2) continue; const int ts = (first && t < 2) ? 2 : t; glds16(vsrc + (long)ts * KVBLK * rs, (unsigned)__builtin_amdgcn_readfirstlane(vdst + ring6(t, rot) * SLOTB)); }
}
__device__ __forceinline__ void band_pass1(const int tid, char* shm, const bool first, const bool cont  , const int rot, u32x4 (&pw)[5][2], float& l_out, float& m_out) {
    const int lane = tid & 63, r32 = lane & 31, hi = lane >> 5; const int wid = __builtin_amdgcn_readfirstlane(tid >> 6);
    const lds_cptr shm3 = (lds_cptr)shm;
    int foff[4];
#pragma unroll
    for (int d0 = 0; d0 < 4; ++d0) foff[d0] = r32 * 128 + (((2 * d0 + hi) ^ (r32 & 7)) * 16);
    const lds_cptr kp0 = shm3 + BK_K;
    if (cont) asm volatile("s_waitcnt vmcnt(4)" ::: "memory"); else asm volatile("s_waitcnt vmcnt(6)" ::: "memory");
    asm volatile("s_waitcnt lgkmcnt(0)\n\ts_barrier" ::: "memory");
    bf16x8 qr[4];
    { const lds_cptr qp = shm3 + BK_Q + (wid >> 1) * SLOTB + (wid & 1) * 4096;
#pragma unroll
      for (int d0 = 0; d0 < 4; ++d0) qr[d0] = *(const __attribute__((address_space(3))) bf16x8*)(qp + foff[d0]); }
    f32x16 p[5];
#pragma unroll
    for (int j = 0; j < 5; ++j) {
        const int s = wid + j;
        if (first && s < 4) {
#pragma unroll
            for (int r = 0; r < 16; ++r) p[j][r] = -INFINITY;
        } else {
            const lds_cptr kp = kp0 + ring6(s >> 1, rot) * SLOTB + (s & 1) * 4096;
            bf16x8 kf[4];
#pragma unroll
            for (int d0 = 0; d0 < 4; ++d0) kf[d0] = *(const __attribute__((address_space(3))) bf16x8*)(kp + foff[d0]);
            f32x16 q = __builtin_amdgcn_mfma_f32_32x32x16_bf16(kf[0], qr[0], f32x16{}, 0, 0, 0);
            q = __builtin_amdgcn_mfma_f32_32x32x16_bf16(kf[1], qr[1], q, 0, 0, 0);
            q = __builtin_amdgcn_mfma_f32_32x32x16_bf16(kf[2], qr[2], q, 0, 0, 0);
            p[j] = __builtin_amdgcn_mfma_f32_32x32x16_bf16(kf[3], qr[3], q, 0, 0, 0);
        }
    }
#pragma unroll
    for (int r = 0; r < 16; ++r) { if (crow(r, hi) < r32) p[0][r] = -INFINITY; if (crow(r, hi) > r32) p[4][r] = -INFINITY; }
    float rm;
    { float a = MX3(p[0][0], p[0][1], p[0][2]);
#pragma unroll
      for (int j = 0; j < 5; ++j)
#pragma unroll
          for (int r = (j == 0 ? 3 : 0); r + 1 < 16; r += 2) a = MX3(a, p[j][r], p[j][r + 1]);
      a = __builtin_fmaxf(a, p[0][15]);
      auto rr = __builtin_amdgcn_permlane32_swap(__float_as_uint(a), __float_as_uint(a), false, false); rm = __builtin_fmaxf(__uint_as_float(rr[0]), __uint_as_float(rr[1])); }
    float mhat = 0.f;
    if (__builtin_expect(__any(rm > (float)THRL), 0)) { mhat = __builtin_fmaxf(rm, 0.f);
#pragma unroll
        for (int j = 0; j < 5; ++j)
#pragma unroll
            for (int r = 0; r < 16; ++r) p[j][r] -= mhat; }
    float l_reg = 0.f;
#pragma unroll
    for (int j = 0; j < 5; ++j) {
        float sacc = 0.f;
#pragma unroll
        for (int r = 0; r < 16; ++r) { p[j][r] = __builtin_amdgcn_exp2f(p[j][r]); sacc += p[j][r]; }
        l_reg += sacc;
        pw[j][0] = (u32x4){cvtpk_s(p[j][0], p[j][1]), cvtpk_s(p[j][2], p[j][3]), cvtpk_s(p[j][4], p[j][5]), cvtpk_s(p[j][6], p[j][7])};
        pw[j][1] = (u32x4){cvtpk_s(p[j][8], p[j][9]), cvtpk_s(p[j][10], p[j][11]), cvtpk_s(p[j][12], p[j][13]), cvtpk_s(p[j][14], p[j][15])};
    }
    l_out = l_reg; m_out = mhat;
    asm volatile("s_waitcnt lgkmcnt(0)\n\ts_barrier" ::: "memory");
}
__device__ __forceinline__ void band_pass2(const int tid, char* shm, const bool first, const bool last_unit, const bool cont_next  , const int rot, const u32x4 (&pw)[5][2], f32x16 (&o)[2]) {
    const int lane = tid & 63, hi = lane >> 5; const int wid = __builtin_amdgcn_readfirstlane(tid >> 6);
    const lds_cptr shm3 = (lds_cptr)shm;
    const lds_cptr vp0 = shm3 + BK_V + ((lane >> 4) & 1) * 32 + (lane & 3) * 8 + (4 * hi + ((lane & 15) >> 2)) * 64;
    if (last_unit) asm volatile("s_waitcnt vmcnt(0)" ::: "memory"); else if (cont_next) asm volatile("s_waitcnt vmcnt(8)" ::: "memory"); else asm volatile("s_waitcnt vmcnt(10)" ::: "memory");
    asm volatile("s_waitcnt lgkmcnt(0)\n\ts_barrier" ::: "memory");
    o[0] = f32x16{}; o[1] = f32x16{};
#pragma unroll
    for (int j = 0; j < 5; ++j) {
        const int s = wid + j;
        if (first && s < 4) continue;
        const lds_cptr vp = vp0 + ring6(s >> 1, rot) * SLOTB + (s & 1) * 2048;
#pragma unroll
        for (int d0 = 0; d0 < 2; ++d0) {
            const s16x4 l0 = vtr(vp + d0 * 4096), h0 = vtr(vp + d0 * 4096 + 512), l1 = vtr(vp + d0 * 4096 + 1024), h1 = vtr(vp + d0 * 4096 + 1024 + 512);
            const bf16x8 v0 = (bf16x8){l0[0], l0[1], l0[2], l0[3], h0[0], h0[1], h0[2], h0[3]}, v1 = (bf16x8){l1[0], l1[1], l1[2], l1[3], h1[0], h1[1], h1[2], h1[3]};
            o[d0] = __builtin_amdgcn_mfma_f32_32x32x16_bf16(__builtin_bit_cast(bf16x8, pw[j][0]), v0, o[d0], 0, 0, 0);
            o[d0] = __builtin_amdgcn_mfma_f32_32x32x16_bf16(__builtin_bit_cast(bf16x8, pw[j][1]), v1, o[d0], 0, 0, 0);
        }
    }
    asm volatile("s_waitcnt lgkmcnt(0)\n\ts_barrier" ::: "memory");
}
#undef SBAR
#undef WAIT_BAR
#undef MX3
}

constexpr int NWAVES = 8;
constexpr size_t MiB = 1u << 20;
constexpr size_t WS_CTL = 0, CTL_ZERO_BYTES = 1 * MiB;
constexpr size_t WS_ROPE = 1 * MiB;
constexpr size_t WS_SS = 2 * MiB;
constexpr size_t SS_B_OFF = (size_t)MTOK * 4;
constexpr size_t WS_KMEAN = 4 * MiB;
constexpr size_t WS_STAT = 5 * MiB;
constexpr size_t WS_EDGE = 16 * MiB;
constexpr size_t WS_W = 32 * MiB;
constexpr size_t W_QKVA = 0, W_OA = W_QKVA + (size_t)9216 * 1024, W_UP0 = W_OA + (size_t)1024 * 1024, W_DN0 = W_UP0 + (size_t)NUP * 1024,
                 W_QKVB = W_DN0 + (size_t)1024 * DFF, W_OB = W_QKVB + (size_t)3072 * 1024, W_UP1 = W_OB + (size_t)1024 * 1024, W_DN1 = W_UP1 + (size_t)NUP * 1024,
                 W_END = W_DN1 + (size_t)1024 * DFF;
static_assert(W_END * 2 <= 64 * MiB, "weights fit 64 MiB");
constexpr size_t WS_XN = 96 * MiB;
constexpr size_t WS_Q = 160 * MiB, WS_K = 224 * MiB, WS_V = 288 * MiB, WS_ATT = 352 * MiB;
constexpr size_t WS_HH = 160 * MiB;
constexpr size_t WS_END = 416 * MiB;
static_assert(WS_HH + (size_t)MTOK * DFF * 2 <= WS_ATT, "Hh overlay");

constexpr int RING_BYTES = 131072, XLDS_OFF = RING_BYTES, XLDS_BYTES = XL_END, LDS_BYTES = 163840;
static_assert(attn::LDS_BYTES <= RING_BYTES && attn::BK_BYTES <= LDS_BYTES - 64 && XLDS_OFF + XLDS_BYTES <= LDS_BYTES, "LDS map");

struct Args { const float* in[15]; float* out; unsigned char* ws; int ph_lo, ph_hi; };
static_assert(sizeof(Args) == 15 * 8 + 8 + 8 + 8, "no padding");

__device__ __forceinline__ unsigned f2bf(float f) { unsigned u = __builtin_bit_cast(unsigned, f); return (u + 0x7fffu + ((u >> 16) & 1u)) >> 16; }
__device__ __forceinline__ unsigned pk2(float lo, float hi) { return f2bf(lo) | (f2bf(hi) << 16); }
__device__ __forceinline__ float wave_sum(float v) {
#pragma unroll
    for (int o = 1; o < 64; o <<= 1) v += __shfl_xor(v, o);
    return v;
}
__device__ __forceinline__ int dinv(int d) { return (d < 4) ? d : (d < 8) ? d + 4 : (d < 12) ? d - 4 : d; }
__device__ __forceinline__ int tileperm(int which_is_qk, int h, int d) { const int p = (which_is_qk && d < 16) ? dinv(d) : d; return (h >> 2) * 256 + (p >> 5) * 128 + (h & 3) * 32 + (p & 31); }
template <int KIND> __device__ __forceinline__ int permrow(int n) {
    if (KIND == 1) { const int which = n / 3072, g = (n % 3072) / 1024, h = (n % 1024) / 64, d = n % 64; return g * 3072 + which * 1024 + tileperm(which < 2, h, d); }
    if (KIND == 2) { const int which = n / 1024, h = (n % 1024) / 64, d = n % 64; return which * 1024 + tileperm(which < 2, h, d); }
    if (KIND == 3) { const int isval = n >= DFF, j = n - isval * DFF; return 256 * (j >> 7) + 128 * isval + (j & 127); }
    return n;
}
template <int KIND> __device__ __forceinline__ void transpose_item(const float* W, int K, int N, bf16* WT, LAS float* scr, int item, int lane, const float* gk = nullptr) {
    const int nblk = N / 32, kb = item / nblk, nb = item % nblk, k0 = 64 * kb, n0 = 32 * nb;
    float wv[32];
#pragma unroll
    for (int i = 0; i < 32; ++i) wv[i] = __builtin_nontemporal_load(&W[(size_t)(k0 + 2 * i + (lane >> 5)) * N + n0 + (lane & 31)]);
#pragma unroll
    for (int i = 0; i < 32; ++i) scr[(2 * i + (lane >> 5)) * 33 + (lane & 31)] = wv[i];
    asm volatile("s_waitcnt lgkmcnt(0)" ::: "memory");
    const int c = lane & 7;
    f32x4 ga = (f32x4){1.f, 1.f, 1.f, 1.f}, gb = ga;
    if (gk) { ga = *(const f32x4*)(gk + k0 + 8 * c); gb = *(const f32x4*)(gk + k0 + 8 * c + 4); }
#pragma unroll
    for (int j = 0; j < 4; ++j) { const int n = (lane >> 3) + 8 * j; const LAS float* s = scr + (8 * c) * 33 + n;
        u32x4 o; o.x = pk2(s[0 * 33] * ga[0], s[1 * 33] * ga[1]); o.y = pk2(s[2 * 33] * ga[2], s[3 * 33] * ga[3]); o.z = pk2(s[4 * 33] * gb[0], s[5 * 33] * gb[1]); o.w = pk2(s[6 * 33] * gb[2], s[7 * 33] * gb[3]);
        *(u32x4*)(WT + (size_t)permrow<KIND>(n0 + n) * K + k0 + 8 * c) = o; }
    asm volatile("s_waitcnt lgkmcnt(0)" ::: "memory");
}

struct TI { const float* W; bf16* WT; const float* gk; int K, N, kind, k0, n0, hasg; };
__device__ __forceinline__ int permrow_rt(int kind, int n) { return kind == 1 ? permrow<1>(n) : kind == 2 ? permrow<2>(n) : kind == 3 ? permrow<3>(n) : n; }
__device__ __forceinline__ void ti_load(const TI& t, int lane, float (&wv)[32], f32x4& ga, f32x4& gb) {
    const float* p = t.W + (size_t)(t.k0 + (lane >> 5)) * t.N + t.n0 + (lane & 31);
#pragma unroll
    for (int i = 0; i < 32; ++i) wv[i] = __builtin_nontemporal_load(&p[(size_t)(2 * i) * t.N]);
    const int c = lane & 7;
    const float* gp = t.gk + (t.hasg ? t.k0 : 0) + 8 * c;
    ga = *(const f32x4*)gp; gb = *(const f32x4*)(gp + 4);
}
__device__ __forceinline__ void ti_finish(const TI& t, LAS float* scr, int lane, const float (&wv)[32], f32x4 ga, f32x4 gb) {
#pragma unroll
    for (int i = 0; i < 32; ++i) scr[(2 * i + (lane >> 5)) * 33 + (lane & 31)] = wv[i];
    asm volatile("s_waitcnt lgkmcnt(0)" ::: "memory");
    const int c = lane & 7;
    if (!t.hasg) { ga = (f32x4){1.f, 1.f, 1.f, 1.f}; gb = ga; }
#pragma unroll
    for (int j = 0; j < 4; ++j) { const int n = (lane >> 3) + 8 * j; const LAS float* s = scr + (8 * c) * 33 + n;
        u32x4 o; o.x = pk2(s[0 * 33] * ga[0], s[1 * 33] * ga[1]); o.y = pk2(s[2 * 33] * ga[2], s[3 * 33] * ga[3]); o.z = pk2(s[4 * 33] * gb[0], s[5 * 33] * gb[1]); o.w = pk2(s[6 * 33] * gb[2], s[7 * 33] * gb[3]);
        *(u32x4*)(t.WT + (size_t)permrow_rt(t.kind, t.n0 + n) * t.K + t.k0 + 8 * c) = o; }
    asm volatile("s_waitcnt lgkmcnt(0)" ::: "memory");
}
template <class T> __device__ __forceinline__ T* uptr(T* p) {
    const unsigned long long v = (unsigned long long)p; const unsigned lo = __builtin_amdgcn_readfirstlane((unsigned)v), hi = __builtin_amdgcn_readfirstlane((unsigned)(v >> 32));
    return (T*)(__attribute__((address_space(1))) T*)(((unsigned long long)hi << 32) | lo); }
struct Frame {
    LAS unsigned char* lds; char* lds_generic;
    int tid, wave, vcu, bx, G;
    unsigned long long karg; float* out; unsigned char* ws;
    __device__ __forceinline__ const float* inp(int k) const {
        typedef unsigned long long __attribute__((address_space(4))) const* kp_t;
        return (const float*)(const __attribute__((address_space(1))) float*)(((kp_t)karg)[k]); }
};
#define FLANE (F.tid & 63)

__device__ __forceinline__ void phase_prologue(Frame& F) {
    LAS float* scr = (LAS float*)(F.lds + F.wave * 16384);
    const int gw = F.vcu * NWAVES + F.wave, NGW = F.G * NWAVES;
    bf16* WB = (bf16*)(F.ws + WS_W);
    constexpr int I_QKVA = 16 * (9216 / 32), I_O = 16 * 32, I_UP = 16 * (NUP / 32), I_DN = (DFF / 64) * 32, I_QKVB = 16 * (3072 / 32);
    constexpr int NITEMS = I_QKVA + I_O + I_UP + I_DN + I_QKVB + I_O + I_UP + I_DN;
    auto decode = [&](int it, TI& t) {
        int r = it; const float* g0 = F.inp(1);
        if (r < I_QKVA) { t = TI{F.inp(2), WB + W_QKVA, g0, 1024, 9216, 1, 64 * (r / (9216 / 32)), 32 * (r % (9216 / 32)), 1}; return; } r -= I_QKVA;
        if (r < I_O) { t = TI{F.inp(5), WB + W_OA, g0, 1024, 1024, 0, 64 * (r / 32), 32 * (r % 32), 0}; return; } r -= I_O;
        if (r < I_UP) { t = TI{F.inp(11), WB + W_UP0, F.inp(10), 1024, NUP, 3, 64 * (r / (NUP / 32)), 32 * (r % (NUP / 32)), 1}; return; } r -= I_UP;
        if (r < I_DN) { t = TI{F.inp(14), WB + W_DN0, g0, DFF, 1024, 0, 64 * (r / 32), 32 * (r % 32), 0}; return; } r -= I_DN;
        if (r < I_QKVB) { t = TI{F.inp(6), WB + W_QKVB, g0 + 1024, 1024, 3072, 2, 64 * (r / (3072 / 32)), 32 * (r % (3072 / 32)), 1}; return; } r -= I_QKVB;
        if (r < I_O) { t = TI{F.inp(9), WB + W_OB, g0, 1024, 1024, 0, 64 * (r / 32), 32 * (r % 32), 0}; return; } r -= I_O;
        if (r < I_UP) { t = TI{F.inp(11) + (size_t)1024 * NUP, WB + W_UP1, F.inp(10) + 1024, 1024, NUP, 3, 64 * (r / (NUP / 32)), 32 * (r % (NUP / 32)), 1}; return; } r -= I_UP;
        t = TI{F.inp(14) + (size_t)DFF * 1024, WB + W_DN1, g0, DFF, 1024, 0, 64 * (r / 32), 32 * (r % 32), 0};
    };
    if (gw < NITEMS) {
        const int lane = FLANE;
        TI ta, tb; float wa[32], wb[32]; f32x4 gaa, gab, gba, gbb;
        int it = gw; decode(it, ta); ti_load(ta, lane, wa, gaa, gab);
        for (;;) {
            int nx = it + NGW; const bool hb = nx < NITEMS;
            decode(hb ? nx : it, tb); ti_load(tb, lane, wb, gba, gbb);
            ti_finish(ta, scr, lane, wa, gaa, gab);
            if (!hb) break;
            it = nx; nx = it + NGW; const bool ha = nx < NITEMS;
            decode(ha ? nx : it, ta); ti_load(ta, lane, wa, gaa, gab);
            ti_finish(tb, scr, lane, wb, gba, gbb);
            if (!ha) break;
            it = nx;
        }
    }
    { float* km = (float*)(F.ws + WS_KMEAN); for (int i = (F.vcu * NWAVES + F.wave) * 64 + FLANE; i < BATCH * NHEADS * 16 * 64; i += F.G * NWAVES * 64) km[i] = 0.f; }
    {
        float* cosT = (float*)(F.ws + WS_ROPE); float* sinT = cosT + SEQ * 8;
        const int gt = (F.vcu * NWAVES + F.wave) * 64 + FLANE;
        if (gt < SEQ * 8) { const int pos = gt >> 3, i = gt & 7;
            const float inv = (i == 0) ? 1.0f : (i == 1) ? 1.939227432e-01f : (i == 2) ? 3.760603070e-02f : (i == 3) ? 7.292664610e-03f : (i == 4) ? 1.414213562e-03f : (i == 5) ? 2.742481884e-04f : (i == 6) ? 5.318295734e-05f : 1.031338525e-05f;
            const float ang = (float)pos * inv; cosT[gt] = cosf(ang); sinT[gt] = sinf(ang); }
    }
    {
        const float* x = F.inp(0); bf16* XN = (bf16*)(F.ws + WS_XN); float* SS = (float*)(F.ws + WS_SS);
        for (int m0 = gw * 4; m0 < MTOK; m0 += NGW * 4) {
            f32x4 v[4][4]; float s[4];
#pragma unroll
            for (int r = 0; r < 4; ++r) { const f32x4* xr = (const f32x4*)(x + (size_t)(m0 + r) * DMODEL) + FLANE;
#pragma unroll
                for (int j = 0; j < 4; ++j) v[r][j] = __builtin_nontemporal_load(&xr[64 * j]); }
#pragma unroll
            for (int r = 0; r < 4; ++r) { s[r] = (dot4(v[r][0]) + dot4(v[r][1])) + (dot4(v[r][2]) + dot4(v[r][3])); s[r] = wave_sum(s[r]); }
#pragma unroll
            for (int r = 0; r < 4; ++r) {
                unsigned long long* o8 = (unsigned long long*)(XN + (size_t)(m0 + r) * DMODEL) + FLANE;
#pragma unroll
                for (int j = 0; j < 4; ++j) { const f32x4 y = v[r][j]; o8[64 * j] = (unsigned long long)pk2(y[0], y[1]) | ((unsigned long long)pk2(y[2], y[3]) << 32); }
                if (FLANE == 0) { SS[m0 + r] = s[r]; SS[MTOK + m0 + r] = 0.f; }
            }
        }
    }
}

template <bool KMSUM> __device__ __forceinline__ void phase_gemm_qkv(Frame& F, const bf16* Wt, const float* qg, const float* kg) {
    Wt = uptr(Wt); qg = uptr(qg); kg = uptr(kg);
    pg8::Gemm g{(const bf16*)(F.ws + WS_XN), Wt, MTOK, 3072, 1024}; pg8::StaticOrder S; S.init(MTOK, 3072, F.G, F.bx);
    const float* cosT = (const float*)(F.ws + WS_ROPE);
    EpiQKV<KMSUM> E{(float*)(F.ws + WS_KMEAN), (bf16*)(F.ws + WS_Q), (WS_K - WS_Q) / 2, (const float*)(F.ws + WS_SS), qg, kg, cosT, cosT + SEQ * 8};
    static_assert(WS_V - WS_K == WS_K - WS_Q, "Q|K|V equally spaced");
    pg8::gemm_phase<EpiQKV<KMSUM>, pg8::StaticOrder>(F.tid, F.lds, F.lds + XLDS_OFF, g, S, E);
}
template <bool RES_F32, bool OUT_F32> __device__ __forceinline__ void phase_gemm_res(Frame& F, const bf16* A, const bf16* Wt, int K, const void* resid, void* out, bool has_ss, size_t ssoff) {
    A = uptr(A); Wt = uptr(Wt); resid = (const void*)uptr((const char*)resid); out = (void*)uptr((char*)out); K = __builtin_amdgcn_readfirstlane(K);
    pg8::Gemm g{A, Wt, MTOK, 1024, K}; pg8::StaticOrder S; S.init(MTOK, 1024, F.G, F.bx);
    EpiRes<RES_F32, OUT_F32> E{resid, out, has_ss ? (float*)(F.ws + WS_SS + ssoff) : nullptr};
    pg8::gemm_phase<EpiRes<RES_F32, OUT_F32>, pg8::StaticOrder>(F.tid, F.lds, F.lds + XLDS_OFF, g, S, E);
}
__device__ __forceinline__ void phase_gemm_up(Frame& F, const bf16* Wt, const float* cw, const float* cb) {
    Wt = uptr(Wt); cw = uptr(cw); cb = uptr(cb);
    pg8::Gemm g{(const bf16*)(F.ws + WS_XN), Wt, MTOK, NUP, 1024}; pg8::StaticOrder S; S.init(MTOK, NUP, F.G, F.bx);
    EpiUpConv E{(const float*)(F.ws + WS_SS + SS_B_OFF), cw, cb, (bf16*)(F.ws + WS_HH), (float*)(F.ws + WS_EDGE)};
    pg8::gemm_phase<EpiUpConv, pg8::StaticOrder>(F.tid, F.lds, F.lds + XLDS_OFF, g, S, E);
}
__device__ __forceinline__ void phase_fixup(Frame& F, const float* cw, const float* cb) {
    const float* edge = (const float*)(F.ws + WS_EDGE); bf16* Hh = (bf16*)(F.ws + WS_HH);
    const int gt = (F.vcu * NWAVES + F.wave) * 64 + FLANE, NT = F.G * NWAVES * 64;
    { float* ssa = (float*)(F.ws + WS_SS); for (int i = gt; i < 2 * MTOK; i += NT) ssa[i] = 0.f; }
    constexpr int NJ = DFF / 4;
    for (int it = gt; it < 128 * NJ; it += NT) {
        const int pm = it / NJ, j = (it % NJ) * 4;
        if ((pm & 15) == 0) continue;
        const int pg = 256 * (j >> 7) + (j & 127);
        f32x4 uc[2][2];
#pragma unroll
        for (int bj = 0; bj < 2; ++bj) {
            const int lc = bj * DFF + j, pc = pg + bj * 128;
            const f32x4 w0 = *(const f32x4*)(cw + lc), w1 = *(const f32x4*)(cw + NUP + lc), w2 = *(const f32x4*)(cw + 2 * NUP + lc), bb = *(const f32x4*)(cb + lc);
            const float* ep = edge + (size_t)(pm - 1) * EDGE_ROWS * NUP + pc; const float* ec = edge + (size_t)pm * EDGE_ROWS * NUP + pc;
            const f32x4 u254 = *(const f32x4*)(ep + 2 * (size_t)NUP), u255 = *(const f32x4*)(ep + 3 * (size_t)NUP), u0 = *(const f32x4*)(ec), u1 = *(const f32x4*)(ec + NUP);
            uc[bj][0] = bb + w0 * u254 + w1 * u255 + w2 * u0;
            uc[bj][1] = bb + w0 * u255 + w1 * u0 + w2 * u1;
        }
#pragma unroll
        for (int r = 0; r < 2; ++r) {
            u32x2 w; w.x = pg8::cvt_pk_bf16(silu_mul(uc[0][r][0], uc[1][r][0]), silu_mul(uc[0][r][1], uc[1][r][1]));
            w.y = pg8::cvt_pk_bf16(silu_mul(uc[0][r][2], uc[1][r][2]), silu_mul(uc[0][r][3], uc[1][r][3]));
            *(u32x2*)(Hh + (size_t)(pm * 256 + r) * DFF + j) = w;
        }
    }
}
__device__ __forceinline__ void phase_kmean(Frame& F) {
    const bf16* Kb = (const bf16*)(F.ws + WS_K); float* KM = (float*)(F.ws + WS_KMEAN);
    const int gw = F.vcu * NWAVES + F.wave, NGW = F.G * NWAVES;
    { float* ssb = (float*)(F.ws + WS_SS + SS_B_OFF); for (int i = gw * 64 + FLANE; i < MTOK; i += NGW * 64) ssb[i] = 0.f; }
    for (int task = gw; task < BATCH * NHEADS * 16; task += NGW) {
        const int b = task >> 8, h = (task >> 4) & 15, n = task & 15;
        const int sub = FLANE >> 3, ch = FLANE & 7;
        const bf16* base = Kb + (size_t)(b * SEQ + n * 256 + sub) * DMODEL + h * 64 + ch * 8;
        float a[8];
#pragma unroll
        for (int e = 0; e < 8; ++e) a[e] = 0.f;
#pragma unroll 8
        for (int i = 0; i < 32; ++i) {
            const u32x4 v = *(const u32x4*)(base + (size_t)i * 8 * DMODEL);
#pragma unroll
            for (int e = 0; e < 4; ++e) { a[2 * e] += __uint_as_float(v[e] << 16); a[2 * e + 1] += __uint_as_float(v[e] & 0xffff0000u); }
        }
#pragma unroll
        for (int e = 0; e < 8; ++e) { a[e] += __shfl_xor(a[e], 8); a[e] += __shfl_xor(a[e], 16); a[e] += __shfl_xor(a[e], 32); a[e] *= (1.0f / 256.0f); }
        if (sub == 0) { float* o = KM + (size_t)task * 64 + ch * 8; *(f32x4*)o = (f32x4){a[0], a[1], a[2], a[3]}; *(f32x4*)(o + 4) = (f32x4){a[4], a[5], a[6], a[7]}; }
    }
}
template <int OUT> __device__ __forceinline__ void band_job(Frame& F, int i, int dil, int gidx, attn::Job& J, bool& first) {
    const bf16* Q = (const bf16*)(F.ws + WS_Q); const bf16* K = (const bf16*)(F.ws + WS_K); const bf16* V = (const bf16*)(F.ws + WS_V);
    bf16* num0 = (bf16*)F.out; bf16* num1 = (bf16*)F.out + (size_t)MTOK * DMODEL;
    float* st0 = (float*)(F.ws + WS_STAT); float* st1 = (float*)(F.ws + WS_STAT) + (size_t)MTOK * 32;
    const int u = F.vcu * 8 + i;
    const int nblk = 16 / dil;
    const int bh = u >> 4, b = bh >> 4, h = bh & 15, sub = u & 15, r = sub / nblk, blk = sub % nblk;
    const size_t tok0 = (size_t)b * SEQ + r;
    J.Q = Q + tok0 * DMODEL + h * 64; J.K = K + tok0 * DMODEL + h * 64; J.V = V + tok0 * DMODEL + h * 64;
    J.rs = (long)dil * DMODEL; J.q0 = 256 * blk; J.k0 = J.q0 - 128; J.NT = 6; J.ob = 0; J.kmean = nullptr;
    J.srs = (long)dil * 32;
    J.O = ((OUT == attn::OUT_MERGE) ? (bf16*)(F.ws + WS_ATT) : (gidx == 0 ? num0 : num1)) + tok0 * DMODEL + h * 64;
    J.stat = (OUT == attn::OUT_PART) ? (gidx == 0 ? st0 : st1) + (tok0 * 16 + h) * 2 : nullptr;
    J.num0 = num0 + tok0 * DMODEL + h * 64; J.num1 = num1 + tok0 * DMODEL + h * 64;
    J.stat0 = st0 + (tok0 * 16 + h) * 2; J.stat1 = st1 + (tok0 * 16 + h) * 2;
    first = (blk == 0);
}
template <int OUT> __device__ __forceinline__ void phase_band(Frame& F, int dil, int gidx) {
    if (F.vcu * 8 >= BATCH * NHEADS * 16) return;
    attn::Job J; bool first;
    band_job<OUT>(F, 0, dil, gidx, J, first);
    bool cont = false; int rot = 0;
    { int t_ = F.tid; asm volatile("" : "+v"(t_)); attn::band_issue_kq(t_, J, F.lds_generic, first, false, 0); attn::band_issue_v(t_, J, F.lds_generic, first, false, 0); }
    for (int i = 0; i < 8; ++i) {
        int t_ = F.tid; asm volatile("" : "+v"(t_));
        float l_reg, mhat; attn::f32x16 o[2]; attn::u32x4 pw[5][2];
        attn::band_pass1(t_, F.lds_generic, first, cont, rot, pw, l_reg, mhat);
        attn::Job Jn = J; bool firstn = first;
        bool contn = false; int rotn = 0;
        if (i + 1 < 8) { band_job<OUT>(F, i + 1, dil, gidx, Jn, firstn);
            contn = !firstn;
            rotn = contn ? (rot >= 2 ? rot - 2 : rot + 4) : 0;
            attn::band_issue_kq(t_, Jn, F.lds_generic, firstn, contn, rotn); }
        attn::band_pass2(t_, F.lds_generic, first, i == 7, contn, rot, pw, o);
        if (i + 1 < 8) attn::band_issue_v(t_, Jn, F.lds_generic, firstn, contn, rotn);
        { const int lane = t_ & 63, wid = __builtin_amdgcn_readfirstlane(t_ >> 6);
          attn::unit_epilogue<OUT>(J, (float*)(F.lds_generic + attn::BK_WS) + wid * 64, (unsigned short*)(F.lds_generic + attn::BK_OST) + wid * 1024, wid, lane, l_reg, mhat, o); }
        J = Jn; first = firstn; cont = contn; rot = rotn;
    }
}
__device__ __forceinline__ void moba_job(Frame& F, int i, attn::Job& J) {
    const bf16* Q = (const bf16*)(F.ws + WS_Q); const bf16* K = (const bf16*)(F.ws + WS_K); const bf16* V = (const bf16*)(F.ws + WS_V);
    const int bh = F.vcu >> 1, b = bh >> 4, h = bh & 15;
    const int s = (F.vcu & 1) * 4 + (i >> 1), ob = (i & 1) ? 15 - s : s;
    const size_t tok0 = (size_t)b * SEQ;
    J.Q = Q + tok0 * DMODEL + h * 64; J.K = K + tok0 * DMODEL + h * 64; J.V = V + tok0 * DMODEL + h * 64;
    J.rs = DMODEL; J.q0 = 256 * ob; J.k0 = 0; J.NT = 4 * (ob + 1); J.ob = ob; J.kmean = (const float*)(F.ws + WS_KMEAN) + (size_t)bh * 16 * 64;
    J.O = (bf16*)(F.ws + WS_ATT) + tok0 * DMODEL + h * 64; J.stat = nullptr; J.num0 = J.num1 = nullptr; J.stat0 = J.stat1 = nullptr; J.srs = 32;
}
__device__ __forceinline__ void phase_moba(Frame& F) {
    if ((F.vcu >> 1) >= BATCH * NHEADS) return;
    float gq = __builtin_fabsf(F.inp(7)[FLANE]), gk = __builtin_fabsf(F.inp(8)[FLANE]);
#pragma unroll
    for (int o_ = 1; o_ < 64; o_ <<= 1) { gq = __builtin_fmaxf(gq, __shfl_xor(gq, o_)); gk = __builtin_fmaxf(gk, __shfl_xor(gk, o_)); }
    const float kbound = 8.0f * 1.02f * gk;
    const bool fixed_ok = (QSCALE * 8.0f * 1.02f * gq * kbound) <= 60.0f;
    attn::Job J; moba_job(F, 0, J); J.kbound = kbound;
    { int t_ = F.tid; asm volatile("" : "+v"(t_)); attn::ring_issue(t_, J, F.lds_generic); }
    for (int i = 0; i < 8; ++i) {
        int t_ = F.tid; asm volatile("" : "+v"(t_));
        float l_reg, mhat; attn::f32x16 o[2];
        if (fixed_ok) attn::attn_unit<true, true>(t_, J, F.lds_generic, l_reg, mhat, o); else attn::attn_unit<true, false>(t_, J, F.lds_generic, l_reg, mhat, o);
        attn::Job Jn = J;
        if (i + 1 < 8) { moba_job(F, i + 1, Jn); attn::ring_issue(t_, Jn, F.lds_generic); }
        { const int lane = t_ & 63, wid = __builtin_amdgcn_readfirstlane(t_ >> 6);
          attn::unit_epilogue<attn::OUT_FINAL>(J, (float*)(F.lds_generic + attn::LDS_WS) + wid * 64, (unsigned short*)(F.lds_generic + attn::LDS_OST) + wid * 1024, wid, lane, l_reg, mhat, o); }
        J = Jn;
    }
}

#define XB_TMO      128
#define XB_XCNT(j)  (256  + 64 * (j))
#define XB_XSUB(j)  (1280 + 64 * (j))
#define XB_XGEN(j)  (2304 + 64 * (j))
#define XB_TOP      3328
#define XB_TOPGEN   3392
#define XCD_BAR_WORDS 3456
#define XB_SPIN_CAP (1u << 18)

__device__ __forceinline__ unsigned xb_ld(unsigned* p)              { return __hip_atomic_load(p, __ATOMIC_RELAXED, __HIP_MEMORY_SCOPE_AGENT); }
__device__ __forceinline__ unsigned xb_add(unsigned* p, unsigned v) { return __hip_atomic_fetch_add(p, v, __ATOMIC_RELAXED, __HIP_MEMORY_SCOPE_AGENT); }
__device__ __forceinline__ unsigned xb_xcc_id() { return (unsigned)__builtin_amdgcn_s_getreg((3 << 11) | 20) & 0xFu; }
#define XB_SPIN(cond, bar) do { unsigned _sp = 0; while (cond) { __builtin_amdgcn_s_sleep(1); \
    if ((++_sp & 255u) == 0u) { if (xb_ld(&(bar)[XB_TMO])) break; if (_sp > XB_SPIN_CAP) { atomicAdd(&(bar)[XB_TMO], 1u); break; } } } } while (0)

struct XcdBarrier {
    unsigned* bar; unsigned x;
    volatile LAS unsigned* st;
};

__device__ __forceinline__ XcdBarrier xcd_barrier_post(unsigned* bar, volatile LAS unsigned* st, int tid) {
    XcdBarrier b; b.bar = bar; b.x = xb_xcc_id(); b.st = st;
    if (tid == 0) (void)xb_add(&bar[XB_XCNT(b.x)], 1u);
    return b;
}
__device__ __forceinline__ void xcd_barrier_complete(unsigned* bar, unsigned x, unsigned& nloc, unsigned& nx) {
    const unsigned G = gridDim.x * gridDim.y * gridDim.z;
    unsigned sum, cnt, mine, sp = 0u;
    for (;;) {
        sum = 0u; cnt = 0u; mine = 0u;
#pragma unroll
        for (unsigned j = 0; j < 16; ++j) { const unsigned c = xb_ld(&bar[XB_XCNT(j)]); sum += c; cnt += (c > 0u) ? 1u : 0u; mine = (j == x) ? c : mine; }
        if (sum == G) break;
        __builtin_amdgcn_s_sleep(1);
        if ((++sp & 255u) == 0u) { if (xb_ld(&bar[XB_TMO])) break; if (sp > XB_SPIN_CAP) { atomicAdd(&bar[XB_TMO], 1u); break; } }
    }
    nloc = mine > 0u ? mine : 1u; nx = cnt > 0u ? cnt : 1u;
}

__device__ __forceinline__ void xcd_barrier(const XcdBarrier& b, int tid) {
    asm volatile("s_waitcnt vmcnt(0)" ::: "memory");
    __syncthreads();
    if (tid == 0) {
        unsigned* bar = b.bar;
        __builtin_amdgcn_s_waitcnt(0);
        unsigned nloc = b.st[0], nx = b.st[1];
        if (nloc == 0u) { xcd_barrier_complete(bar, b.x, nloc, nx); b.st[0] = nloc; b.st[1] = nx; }
        const unsigned old = xb_add(&bar[XB_XSUB(b.x)], 1u);
        const unsigned gen = old / nloc;
        if (old + 1u == (gen + 1u) * nloc) {
            __builtin_amdgcn_fence(__ATOMIC_RELEASE, "agent");
            asm volatile("s_waitcnt vmcnt(0)" ::: "memory");
            const unsigned og = xb_add(&bar[XB_TOP], 1u);
            const unsigned tg = og / nx;
            if (og + 1u == (tg + 1u) * nx) xb_add(&bar[XB_TOPGEN], 1u);
            else XB_SPIN(xb_ld(&bar[XB_TOPGEN]) == tg, bar);
            __builtin_amdgcn_fence(__ATOMIC_ACQUIRE, "agent");
            xb_add(&bar[XB_XGEN(b.x)], 1u);
            asm volatile("s_waitcnt vmcnt(0)" ::: "memory");
        } else {
            XB_SPIN(xb_ld(&bar[XB_XGEN(b.x)]) == gen, bar);
            __builtin_amdgcn_fence(__ATOMIC_ACQUIRE, "agent");
            asm volatile("s_waitcnt vmcnt(0)" ::: "memory");
        }
    }
    __syncthreads();
}

constexpr int N_PHASES = 18;
constexpr int CW_BAR = 4096;
constexpr int BARST_OFF = XLDS_OFF + XLDS_BYTES;
static_assert(BARST_OFF + 64 <= LDS_BYTES && (CW_BAR + XCD_BAR_WORDS) * 4 <= (int)CTL_ZERO_BYTES, "barrier state placement");
__device__ __forceinline__ void frame_setup(Frame& F, int wave0, unsigned char* lds) {
    { int t_ = wave0 * 64 + fresh_lane(); asm volatile("" : "+v"(t_)); F.tid = t_; }
    { int b_ = blockIdx.x, g_ = gridDim.x; asm volatile("" : "+s"(b_), "+s"(g_)); F.bx = b_; F.G = g_; }
    F.wave = __builtin_amdgcn_readfirstlane(F.tid >> 6);
    F.vcu = (F.G % 8 == 0) ? (F.bx % 8) * (F.G / 8) + F.bx / 8 : F.bx;
    { unsigned long long k_ = (unsigned long long)__builtin_amdgcn_kernarg_segment_ptr(); asm volatile("" : "+s"(k_)); F.karg = k_; F.out = (float*)F.inp(15); F.ws = (unsigned char*)F.inp(16); }
    F.lds = (LAS unsigned char*)lds; F.lds_generic = (char*)lds;
}
template <int PH> __device__ __forceinline__ void run_phase(Frame& F) {
    const bf16* WB = (const bf16*)(F.ws + WS_W);
    const bf16* ATT = (const bf16*)(F.ws + WS_ATT); const bf16* HH = (const bf16*)(F.ws + WS_HH);
    constexpr int L = (PH >= 11) ? 1 : 0;
    if constexpr (PH == 0) phase_prologue(F);
    else if constexpr (PH == 1 || PH == 3 || PH == 5) { constexpr int g = PH >> 1; phase_gemm_qkv<false>(F, WB + W_QKVA + (size_t)g * 3072 * 1024, F.inp(3) + 64 * g, F.inp(4) + 64 * g); }
    else if constexpr (PH == 11) phase_gemm_qkv<true>(F, WB + W_QKVB, F.inp(7), F.inp(8));
    else if constexpr (PH == 2) phase_band<attn::OUT_PART>(F, 1, 0);
    else if constexpr (PH == 4) phase_band<attn::OUT_PART>(F, 4, 1);
    else if constexpr (PH == 6) phase_band<attn::OUT_MERGE>(F, 16, 2);
    else if constexpr (PH == 7) phase_gemm_res<false, false>(F, ATT, WB + W_OA, 1024, F.ws + WS_XN, F.ws + WS_XN, true, SS_B_OFF);
    else if constexpr (PH == 10) phase_gemm_res<false, false>(F, HH, WB + W_DN0, DFF, F.ws + WS_XN, F.ws + WS_XN, true, 0);
    else if constexpr (PH == 14) phase_gemm_res<false, false>(F, ATT, WB + W_OB, 1024, F.ws + WS_XN, F.ws + WS_XN, true, SS_B_OFF);
    else if constexpr (PH == 17) phase_gemm_res<false, true>(F, HH, WB + W_DN1, DFF, F.ws + WS_XN, F.out, false, 0);
    else if constexpr (PH == 8 || PH == 15) phase_gemm_up(F, WB + (L ? W_UP1 : W_UP0), F.inp(12) + (size_t)L * 3 * NUP, F.inp(13) + (size_t)L * NUP);
    else if constexpr (PH == 9 || PH == 16) phase_fixup(F, F.inp(12) + (size_t)L * 3 * NUP, F.inp(13) + (size_t)L * NUP);
    else if constexpr (PH == 13) phase_moba(F);
}
template <unsigned PHASE_MASK> __global__ void __launch_bounds__(NWAVES * 64, 2) fwd_kernel(const Args args) {
    extern __shared__ __attribute__((aligned(16))) unsigned char lds[];
    const int lo = args.ph_lo, hi = args.ph_hi;
    const int wave0 = __builtin_amdgcn_readfirstlane(threadIdx.x >> 6);
    constexpr bool FUSED = (PHASE_MASK & (PHASE_MASK - 1u)) != 0u;
    volatile LAS unsigned* bst = (volatile LAS unsigned*)((LAS unsigned char*)lds + BARST_OFF);
    XcdBarrier xb; xb.bar = nullptr; xb.x = 0; xb.st = bst;
    if constexpr (FUSED) {
        if (threadIdx.x < 16) bst[threadIdx.x] = 0u;
        __syncthreads();
        xb = xcd_barrier_post((unsigned*)(args.ws + WS_CTL) + CW_BAR, bst, (int)threadIdx.x);
    }
#define PHASE_FENCE() asm volatile("; phase boundary" ::: "v8", "v9", "v10", "v11", "v12", "v13", "v14", "v15", "v16", "v17", "v18", "v19", "v20", "v21", "v22", "v23", "v24", "v25", "v26", "v27", "v28", "v29", "v30", "v31", "v32", "v33", "v34", "v35", "v36", "v37", "v38", "v39", "v40", "v41", "v42", "v43", "v44", "v45", "v46", "v47", "v48", "v49", "v50", "v51", "v52", "v53", "v54", "v55", "v56", "v57", "v58", "v59", "v60", "v61", "v62", "v63", "v64", "v65", "v66", "v67", "v68", "v69", "v70", "v71", "v72", "v73", "v74", "v75", "v76", "v77", "v78", "v79", "v80", "v81", "v82", "v83", "v84", "v85", "v86", "v87", "v88", "v89", "v90", "v91", "v92", "v93", "v94", "v95", "v96", "v97", "v98", "v99", "v100", "v101", "v102", "v103", "v104", "v105", "v106", "v107", "v108", "v109", "v110", "v111", "v112", "v113", "v114", "v115", "v116", "v117", "v118", "v119", "v120", "v121", "v122", "v123", "v124", "v125", "v126", "v127", "v128", "v129", "v130", "v131", "v132", "v133", "v134", "v135", "v136", "v137", "v138", "v139", "v140", "v141", "v142", "v143", "v144", "v145", "v146", "v147", "v148", "v149", "v150", "v151", "v152", "v153", "v154", "v155", "v156", "v157", "v158", "v159", "v160", "v161", "v162", "v163", "v164", "v165", "v166", "v167", "v168", "v169", "v170", "v171", "v172", "v173", "v174", "v175", "v176", "v177", "v178", "v179", "v180", "v181", "v182", "v183", "v184", "v185", "v186", "v187", "v188", "v189", "v190", "v191", "v192", "v193", "v194", "v195", "v196", "v197", "v198", "v199", "v200", "v201", "v202", "v203", "v204", "v205", "v206", "v207", "v208", "v209", "v210", "v211", "v212", "v213", "v214", "v215", "v216", "v217", "v218", "v219", "v220", "v221", "v222", "v223", "v224", "v225", "v226", "v227", "v228", "v229", "v230", "v231", "v232", "v233", "v234", "v235", "v236", "v237", "v238", "v239", "v240", "v241", "v242", "v243", "v244", "v245", "v246", "v247", "v248", "v249", "v250", "v251", "v252", "v253", "v254", "v255", "s36", "s37", "s38", "s39", "s40", "s41", "s42", "s43", "s44", "s45", "s46", "s47", "s48", "s49", "s50", "s51", "s52", "s53", "s54", "s55", "s56", "s57", "s58", "s59", "s60", "s61", "s62", "s63", "s64", "s65", "s66", "s67", "s68", "s69", "s70", "s71", "s72", "s73", "s74", "s75", "s76", "s77", "s78", "s79", "s80", "s81", "s82", "s83", "s84", "s85", "s86", "s87", "s88", "s89", "s90", "s91", "s92", "s93", "s94", "s95", "s96", "s97", "s98", "s99", "s100", "s101", "memory")
#define TID_NOW() (wave0 * 64 + fresh_lane())
#ifndef PROBE_DUP
#define PROBE_DUP 0u
#endif
#ifndef MK_CG_FIRST
#define MK_CG_FIRST 0
#endif
#define PHASE(k) if constexpr (((PHASE_MASK >> (k)) & 1u) != 0u) { PHASE_FENCE(); if (lo <= (k) && (k) < hi) { { Frame F; frame_setup(F, wave0, lds); run_phase<(k)>(F); } \
        if constexpr (((PROBE_DUP >> (k)) & 1u) != 0u) { Frame F; frame_setup(F, wave0, lds); run_phase<(k)>(F); } \
        if constexpr (FUSED && (k) + 1 < N_PHASES) { if ((k) + 1 < hi) { if (MK_CG_FIRST && (k) == 0) cg::this_grid().sync(); else xcd_barrier(xb, TID_NOW()); } } } }
    PHASE(0) PHASE(1) PHASE(2) PHASE(3) PHASE(4) PHASE(5) PHASE(6) PHASE(7) PHASE(8) PHASE(9) PHASE(10) PHASE(11) PHASE(13) PHASE(14) PHASE(15) PHASE(16) PHASE(17)
#undef TID_NOW
#undef PHASE
}

constexpr unsigned PM_ALL = 0x3ffffu;
typedef void (*kern_t)(const Args);
#ifndef MK_SPLIT
#define MK_SPLIT 0
#endif
#if MK_SPLIT
static kern_t kernel_of_phase(int ph) {
    switch (ph) {
#define KP(k) case k: return fwd_kernel<(1u << k)>;
    KP(0) KP(1) KP(2) KP(3) KP(4) KP(5) KP(6) KP(7) KP(8) KP(9) KP(10) KP(11) KP(12) KP(13) KP(14) KP(15) KP(16)
#undef KP
    default: return fwd_kernel<(1u << 17)>;
    }
}
#endif
extern "C" void kernel_launch(void* const* d_in, const int* in_sizes, int n_in, void* d_out, int out_size, void* d_ws, size_t ws_size, hipStream_t stream) {
    static int grid = 0;
    if (grid == 0) {
        if (n_in != 15 || out_size != MTOK * DMODEL || ws_size < WS_END) { fprintf(stderr, "kernel_launch: unexpected shapes (n_in %d, out %d, ws %zu)\n", n_in, out_size, ws_size); grid = -1; return; }
        int dev = 0, cus = 0;
        if (hipGetDevice(&dev) != hipSuccess || hipDeviceGetAttribute(&cus, hipDeviceAttributeMultiprocessorCount, dev) != hipSuccess) { grid = -1; return; }
#if MK_SPLIT
        for (int ph = 0; ph < N_PHASES; ++ph)
            if (hipFuncSetAttribute((const void*)kernel_of_phase(ph), hipFuncAttributeMaxDynamicSharedMemorySize, LDS_BYTES) != hipSuccess) { fprintf(stderr, "kernel_launch: hipFuncSetAttribute failed\n"); grid = -1; return; }
#else
        if (hipFuncSetAttribute((const void*)fwd_kernel<PM_ALL>, hipFuncAttributeMaxDynamicSharedMemorySize, LDS_BYTES) != hipSuccess) { fprintf(stderr, "kernel_launch: hipFuncSetAttribute failed\n"); grid = -1; return; }
        int per_cu = 0;
        if (hipOccupancyMaxActiveBlocksPerMultiprocessor(&per_cu, (const void*)fwd_kernel<PM_ALL>, NWAVES * 64, LDS_BYTES) != hipSuccess || per_cu < 1) fprintf(stderr, "kernel_launch: occupancy query says %d blocks/CU\n", per_cu);
        (void)hipGetLastError();
#endif
        grid = cus;
    }
    if (grid < 0) return;
    Args a{};
    for (int i = 0; i < 15; ++i) a.in[i] = (const float*)d_in[i];
    a.out = (float*)d_out; a.ws = (unsigned char*)d_ws;
#if MK_SPLIT
    for (int ph = 0; ph < N_PHASES; ++ph) { a.ph_lo = ph; a.ph_hi = ph + 1; hipLaunchKernelGGL(kernel_of_phase(ph), dim3(grid), dim3(NWAVES * 64), LDS_BYTES, stream, a); }
#else
    a.ph_lo = 0; a.ph_hi = N_PHASES;
    if (hipMemsetAsync((char*)d_ws + WS_CTL, 0, 65536, stream) != hipSuccess) { fprintf(stderr, "kernel_launch: memset failed\n"); return; }
    void* kargs[] = {&a};
    hipError_t e = hipLaunchCooperativeKernel((const void*)fwd_kernel<PM_ALL>, dim3(grid), dim3(NWAVES * 64), kargs, LDS_BYTES, stream);
    if (e != hipSuccess) fprintf(stderr, "cooperative launch failed: %s (grid %d)\n", hipGetErrorString(e), grid);
#endif
}
```

```cpp
#include <hip/hip_runtime.h>
#include <hip/hip_bf16.h>
#include <hip/hip_cooperative_groups.h>
#include <cstdio>
#include <cstdint>
#include <cmath>
namespace cg = cooperative_groups;

__device__ __forceinline__ int fresh_lane() { unsigned z = 0u; asm volatile("" : "+v"(z)); return (int)__builtin_amdgcn_mbcnt_hi(~0u, __builtin_amdgcn_mbcnt_lo(~0u, z)); }
#ifndef PROBE_K2
#define PROBE_K2 0
#endif
namespace pg8 {
#define PG8_LAS __attribute__((address_space(3)))
typedef unsigned short bf16_t;
typedef short bf16x8 __attribute__((ext_vector_type(8)));
typedef float f32x4 __attribute__((ext_vector_type(4)));
typedef unsigned u32x4 __attribute__((ext_vector_type(4)));
typedef unsigned u32x2 __attribute__((ext_vector_type(2)));
constexpr int BM = 256, BK = 64, HALF = 128, HTB = HALF * BK * 2  , STAGE_BYTES = 8 * HTB, NXCD = 8, WGM = 4;

__host__ __device__ __forceinline__ int lds_byte(int r, int c) { const int st = (r >> 4) * 2 + (c >> 5), rr = r & 15, cc = c & 31, ob = rr * 64 + cc * 2; return st * 1024 + (ob ^ (((ob >> 9) & 1) << 5)); }
__host__ __device__ __forceinline__ void stage_rc(int b, int& R, int& C) { const int st = b / 1024, sb = b % 1024, swz = sb ^ (((sb >> 9) & 1) << 5); R = (st >> 1) * 16 + swz / 64; C = (st & 1) * 32 + (swz % 64) / 2; }
__host__ __device__ __forceinline__ int perm32(int rho) { const int n = rho >> 4, i = rho & 15; return 8 * (i >> 2) + 4 * n + (i & 3); }

struct Unit { int pm, pn; };
struct Gemm { const bf16_t* A; const bf16_t* Bt; int M, N, K; };

struct StaticOrder {
    int nM, nN, nwg, G, c;
    __device__ __forceinline__ void init(int M, int N, int G_, int c_) { nM = M / BM; nN = N / BM; nwg = nM * nN; G = G_; c = c_; }
    __device__ __forceinline__ bool next(int i, Unit& u) const {
        const long L = (long)i * G + c; if (L >= nwg) return false;
        int wgid = (int)L; { const int q = nwg / NXCD, r = nwg % NXCD, xcd = wgid % NXCD, off = wgid / NXCD; wgid = (xcd < r ? xcd * (q + 1) : r * (q + 1) + (xcd - r) * q) + off; }
        const int nig = WGM * nN, gid = wgid / nig, fm = gid * WGM, gsz = (nM - fm) < WGM ? (nM - fm) : WGM;
        u.pm = fm + ((wgid % nig) % gsz); u.pn = (wgid % nig) / gsz; return true;
    }
};

__device__ __forceinline__ unsigned cvt_pk_bf16(float lo, float hi) { unsigned r; asm volatile("v_cvt_pk_bf16_f32 %0, %1, %2" : "=v"(r) : "v"(lo), "v"(hi)); return r; }

template <class Epi, class Sched>
__device__ __forceinline__ void gemm_phase(const int tid, PG8_LAS unsigned char* lds, PG8_LAS unsigned char* xlds, const Gemm g, const Sched& S, const Epi& E) {
    const int wid = __builtin_amdgcn_readfirstlane(tid >> 6), lane = tid & 63, wr = wid >> 2, wc = wid & 3, fr = lane & 15, fq = lane >> 4;
    const int K = g.K, nt = K / BK;
    unsigned voffA, voffB;
    { int R, C; stage_rc(tid * 16, R, C); const int Rb = ((R & ~31) + perm32(R & 31));
      const int Ra = Epi::AROWPERM ? ((R & ~63) + 4 * (R & 15) + ((R >> 4) & 3)) : R;
      voffA = (unsigned)(Ra * K + C) * 2u; voffB = (unsigned)(Rb * K + C) * 2u; }
    const unsigned qstep = 64u * (unsigned)K * 2u;
    const unsigned kstep = (unsigned)(BK * 2);
    const unsigned hstep = (unsigned)HALF * (unsigned)K * 2u;
    const unsigned tstep = 2u * hstep;
    const char* const gA = (const char*)g.A; const char* const gB = (const char*)g.Bt;
    const unsigned ldsw = (unsigned)wid * 1024u;
    const int aoff = lds_byte(wr * 64 + fr, fq * 8), boff = lds_byte(wc * 32 + fr, fq * 8);
    unsigned ldsA_ = (unsigned)(uintptr_t)lds + (unsigned)aoff, ldsB_ = (unsigned)(uintptr_t)lds + 4u * HTB + (unsigned)boff; asm volatile("" : "+v"(ldsA_), "+v"(ldsB_));
    const PG8_LAS unsigned char* const ldsA = (const PG8_LAS unsigned char*)(uintptr_t)ldsA_; const PG8_LAS unsigned char* const ldsB = (const PG8_LAS unsigned char*)(uintptr_t)ldsB_;
#define PG8_SA(b, h) (((b) * 2 + (h)) * HTB)
#define PG8_SB(b, h) ((4 + (b) * 2 + (h)) * HTB)
#define PG8_STAGE(bufoff, gptr, goff, voff) do { _Pragma("unroll") for (int _i = 0; _i < 2; ++_i) \
        __builtin_amdgcn_global_load_lds((const unsigned*)((gptr) + (unsigned)((goff) + _i * qstep + (voff))), (PG8_LAS unsigned*)(lds + (bufoff) + ldsw + _i * 8192), 16, 0, 0); } while (0)
#define PG8_LDA(dst, b, h) do { _Pragma("unroll") for (int m = 0; m < 4; ++m) _Pragma("unroll") for (int k = 0; k < 2; ++k) dst[m][k] = *(const PG8_LAS bf16x8*)(ldsA + (PG8_SA(b, h) + m * 2048 + k * 1024)); } while (0)
#define PG8_LDB(dst, b, h) do { _Pragma("unroll") for (int n = 0; n < 2; ++n) _Pragma("unroll") for (int k = 0; k < 2; ++k) dst[n][k] = *(const PG8_LAS bf16x8*)(ldsB + (PG8_SB(b, h) - 4 * HTB + n * 2048 + k * 1024)); } while (0)
#define PG8_MMA(ai, bj, At, Bt) do { __builtin_amdgcn_s_setprio(1); _Pragma("unroll") for (int m = 0; m < 4; ++m) _Pragma("unroll") for (int n = 0; n < 2; ++n) _Pragma("unroll") for (int k = 0; k < 2; ++k) \
        acc[ai][bj][m][n] = __builtin_amdgcn_mfma_f32_16x16x32_bf16(Bt[n][k], At[m][k], acc[ai][bj][m][n], 0, 0, 0); __builtin_amdgcn_s_setprio(0); } while (0)
#define PG8_WAIT_V(n) asm volatile("s_waitcnt vmcnt(" #n ")" ::: "memory")
#define PG8_WAIT_L(n) asm volatile("s_waitcnt lgkmcnt(" #n ")" ::: "memory")
#define PG8_BAR __builtin_amdgcn_s_barrier()
#define PG8_SCHED __builtin_amdgcn_sched_barrier(0)
    Unit cur, nxt; int ui = 0;
    if (!S.next(0, cur)) return;
    f32x4 acc[2][2][4][2];
#pragma unroll
    for (int a = 0; a < 2; ++a)
#pragma unroll
        for (int b = 0; b < 2; ++b)
#pragma unroll
            for (int m = 0; m < 4; ++m)
#pragma unroll
                for (int n = 0; n < 2; ++n) acc[a][b][m][n] = (f32x4){0.f, 0.f, 0.f, 0.f};
    bf16x8 At[4][2], B0[2][2], B1[2][2];
    unsigned cA = (unsigned)cur.pm * tstep, cB = (unsigned)cur.pn * tstep;
    PG8_STAGE(PG8_SB(0, 0), gB, cB, voffB); PG8_STAGE(PG8_SB(0, 1), gB, cB + hstep, voffB); PG8_STAGE(PG8_SA(0, 0), gA, cA, voffA); PG8_STAGE(PG8_SA(0, 1), gA, cA + hstep, voffA);
    if (wr == 1) PG8_BAR;
    PG8_WAIT_V(2); PG8_BAR;
    PG8_STAGE(PG8_SB(1, 0), gB, cB + kstep, voffB); PG8_STAGE(PG8_SA(1, 0), gA, cA + kstep, voffA); PG8_STAGE(PG8_SB(1, 1), gB, cB + hstep + kstep, voffB);
    PG8_WAIT_V(0); PG8_BAR;
    for (;;) {
        PG8_BAR; { const int ln_ = fresh_lane(); E.prefetch(cur, xlds, wid, ln_); }
        const bool has_next = S.next(ui + 1, nxt);
        const unsigned nA = has_next ? (unsigned)nxt.pm * tstep : cA, nB = has_next ? (unsigned)nxt.pn * tstep : cB;
#if PROBE_K2
        for (int rep = 0; rep < 2; ++rep)
#endif
        for (int t = 0; t < nt; t += 2) {
            const bool last = (t == nt - 2);
            const unsigned a1 = cA + (unsigned)(t + 1) * kstep;
#if PROBE_K2
            const unsigned a2 = last ? (rep == 0 ? cA : nA) : cA + (unsigned)(t + 2) * kstep, b2 = last ? (rep == 0 ? cB : nB) : cB + (unsigned)(t + 2) * kstep;
#else
            const unsigned a2 = last ? nA : cA + (unsigned)(t + 2) * kstep, b2 = last ? nB : cB + (unsigned)(t + 2) * kstep;
#endif
            const unsigned a3 = a2 + kstep, b3 = b2 + kstep;
            const bool relax = (t == 0);
            PG8_LDB(B0, 0, 0); PG8_LDB(B1, 0, 1); PG8_SCHED; PG8_LDA(At, 0, 0); PG8_STAGE(PG8_SA(1, 1), gA, a1 + hstep, voffA);
            if (!relax) PG8_WAIT_V(8); PG8_WAIT_L(0); PG8_BAR; PG8_MMA(0, 0, At, B0); PG8_MMA(0, 1, At, B1); PG8_BAR; PG8_SCHED;
            PG8_LDA(At, 0, 1); PG8_STAGE(PG8_SB(0, 0), gB, b2, voffB); PG8_STAGE(PG8_SB(0, 1), gB, b2 + hstep, voffB); PG8_STAGE(PG8_SA(0, 0), gA, a2, voffA);
            if (!relax) PG8_WAIT_V(8); PG8_WAIT_L(0); PG8_BAR; PG8_MMA(1, 0, At, B0); PG8_MMA(1, 1, At, B1); PG8_BAR; PG8_SCHED;
            PG8_LDB(B0, 1, 0); PG8_LDB(B1, 1, 1); PG8_SCHED; PG8_LDA(At, 1, 0); PG8_STAGE(PG8_SA(0, 1), gA, a2 + hstep, voffA);
            PG8_WAIT_V(8); PG8_WAIT_L(0); PG8_BAR; PG8_MMA(0, 0, At, B0); PG8_MMA(0, 1, At, B1); PG8_BAR; PG8_SCHED;
            PG8_LDA(At, 1, 1); PG8_STAGE(PG8_SB(1, 0), gB, b3, voffB); PG8_STAGE(PG8_SB(1, 1), gB, b3 + hstep, voffB); PG8_STAGE(PG8_SA(1, 0), gA, a3, voffA);
            PG8_WAIT_V(8); PG8_WAIT_L(0); PG8_BAR; PG8_MMA(1, 0, At, B0); PG8_MMA(1, 1, At, B1); PG8_BAR; PG8_SCHED;
        }
#if PROBE_K2
#pragma unroll
        for (int a = 0; a < 2; ++a)
#pragma unroll
            for (int b = 0; b < 2; ++b)
#pragma unroll
                for (int m = 0; m < 4; ++m)
#pragma unroll
                    for (int n = 0; n < 2; ++n) acc[a][b][m][n] = acc[a][b][m][n] * 0.5f;
#endif
        if (wr == 0) PG8_BAR;
        PG8_WAIT_V(0);
        { const int ln_ = fresh_lane(); const int fr_ = ln_ & 15, fq_ = ln_ >> 4; E(acc, cur, wr, wc, fr_, fq_, xlds); if constexpr (Epi::PROBE2) { { const int l2_ = fresh_lane(); E(acc, cur, wr, wc, l2_ & 15, l2_ >> 4, xlds); } } }
        if (!has_next) break;
#pragma unroll
        for (int a = 0; a < 2; ++a)
#pragma unroll
            for (int b = 0; b < 2; ++b)
#pragma unroll
                for (int m = 0; m < 4; ++m)
#pragma unroll
                    for (int n = 0; n < 2; ++n) acc[a][b][m][n] = (f32x4){0.f, 0.f, 0.f, 0.f};
        cur = nxt; cA = nA; cB = nB; ++ui;
        if (wr == 1) PG8_BAR;
    }
    PG8_WAIT_V(0);
    PG8_BAR;
#undef PG8_SA
#undef PG8_SB
#undef PG8_STAGE
#undef PG8_LDA
#undef PG8_LDB
#undef PG8_MMA
#undef PG8_WAIT_V
#undef PG8_WAIT_L
#undef PG8_BAR
#undef PG8_SCHED
}
}

constexpr int BATCH = 8, SEQ = 4096, DMODEL = 1024, NHEADS = 16, HDIM = 64, DFF = 2816, NUP = 2 * DFF;
constexpr int MTOK = BATCH * SEQ;
constexpr float RMS_EPS = 1e-6f;
constexpr float QSCALE = 0.125f * 1.4426950408889634f;
constexpr int XL_EX = 0, XL_SS = 8192, XL_GAIN = XL_SS + 1024, XL_COS = XL_GAIN + 256, XL_SIN = XL_COS + 8192, XL_CW = XL_COS, XL_END = XL_SIN + 8192;

typedef unsigned short bf16;
typedef float f32x4 __attribute__((ext_vector_type(4)));
typedef float f32x2 __attribute__((ext_vector_type(2)));
typedef unsigned u32x4 __attribute__((ext_vector_type(4)));
typedef unsigned u32x2 __attribute__((ext_vector_type(2)));
#define LAS __attribute__((address_space(3)))

__device__ __forceinline__ float shx(float v, int m) { return __shfl_xor(v, m); }
__device__ __forceinline__ float xsum16(float v) { auto r = __builtin_amdgcn_permlane16_swap(__float_as_uint(v), __float_as_uint(v), false, false); return __uint_as_float(r[0]) + __uint_as_float(r[1]); }
__device__ __forceinline__ float xsum32(float v) { auto r = __builtin_amdgcn_permlane32_swap(__float_as_uint(v), __float_as_uint(v), false, false); return __uint_as_float(r[0]) + __uint_as_float(r[1]); }
__device__ __forceinline__ float fqsum(float v) { return xsum32(xsum16(v)); }
__device__ __forceinline__ float rsq(float v) { return __builtin_amdgcn_rsqf(v); }
__device__ __forceinline__ float bf2f(unsigned short b) { return __uint_as_float(((unsigned)b) << 16); }
__device__ __forceinline__ float sum4(f32x4 v) { return (v[0] + v[1]) + (v[2] + v[3]); }
__device__ __forceinline__ float dot4(f32x4 v) { return (v[0] * v[0] + v[1] * v[1]) + (v[2] * v[2] + v[3] * v[3]); }

__device__ __forceinline__ void dma1k(const void* src, LAS unsigned char* dst, unsigned voff) {
    __builtin_amdgcn_global_load_lds((const unsigned*)((const char*)src + voff), (LAS unsigned*)dst, 16, 0, 0); }
__device__ __forceinline__ float lds_rstd(LAS unsigned char* xlds, int r) { return rsq(((LAS float*)(xlds + XL_SS))[r] * (1.0f / DMODEL) + RMS_EPS); }
#ifndef PROBE_EPI2
#define PROBE_EPI2 0
#endif
template <int CTRL> __device__ __forceinline__ float dpp_ror(float v) { return __builtin_bit_cast(float, __builtin_amdgcn_update_dpp(0, __builtin_bit_cast(int, v), CTRL, 0xf, 0xf, false)); }
template <bool KMSUM> struct EpiQKV {
    static constexpr bool PROBE2 = (PROBE_EPI2 & 1) != 0, AROWPERM = false;
    float* kmsum;
    bf16 *Q; size_t qkv_stride; const float* ss; const float *qg, *kg; const float *cosT, *sinT;
    __device__ __forceinline__ void prefetch(const pg8::Unit& u, LAS unsigned char* xlds, int wid, int lane) const {
        const int which = u.pn >> 2; const unsigned l16 = (unsigned)lane * 16u;
        if (wid == 0) dma1k(ss + u.pm * 256, xlds + XL_SS, l16);
        if (which < 2) {
            const int pos0 = (u.pm * 256) & (SEQ - 1);
            dma1k(cosT + pos0 * 8 + wid * 256, xlds + XL_COS + wid * 1024, l16);
            dma1k(sinT + pos0 * 8 + wid * 256, xlds + XL_SIN + wid * 1024, l16);
            if (wid == 1 && lane < 16) dma1k((which == 0) ? qg : kg, xlds + XL_GAIN, l16);
        }
    }
    __device__ __forceinline__ void operator()(const f32x4 (&acc)[2][2][4][2], const pg8::Unit& u, int wr, int wc, int fr, int fq, LAS unsigned char* xlds) const {
        const int which = u.pn >> 2, head = (u.pn & 3) * 4 + wc;
        bf16* dst = Q + (size_t)which * qkv_stride;
        f32x4 g[2][2];
        if (which < 2) {
            const LAS float* gn = (const LAS float*)(xlds + XL_GAIN);
            const int b0 = (fq < 2) ? 4 * fq : 8 * fq, b1 = (fq < 2) ? 8 + 4 * fq : 8 * fq + 4;
            g[0][0] = *(const LAS f32x4*)(gn + b0); g[0][1] = *(const LAS f32x4*)(gn + b1);
            g[1][0] = *(const LAS f32x4*)(gn + 32 + 8 * fq); g[1][1] = *(const LAS f32x4*)(gn + 32 + 8 * fq + 4);
        }
        const float post = (which == 0) ? QSCALE : 1.0f;
        const bool ropeq = (which < 2) && (fq < 2);
        f32x4 ks[2][2];
        if (KMSUM) {
#pragma unroll
            for (int bj = 0; bj < 2; ++bj)
#pragma unroll
                for (int n = 0; n < 2; ++n) ks[bj][n] = (f32x4){0.f, 0.f, 0.f, 0.f};
        }
#pragma unroll
        for (int ai = 0; ai < 2; ++ai) {
#pragma unroll
            for (int m = 0; m < 4; ++m) {
                const int row = u.pm * 256 + ai * 128 + wr * 64 + m * 16 + fr;
                f32x4 cs = (f32x4){1.f, 1.f, 1.f, 1.f}, sn = (f32x4){0.f, 0.f, 0.f, 0.f};
                if (ropeq) { const int r = ai * 128 + wr * 64 + m * 16 + fr; cs = *(const LAS f32x4*)(xlds + XL_COS + r * 32 + 16 * fq); sn = *(const LAS f32x4*)(xlds + XL_SIN + r * 32 + 16 * fq); }
                const float rstd = lds_rstd(xlds, ai * 128 + wr * 64 + m * 16 + fr);
                f32x4 v[2][2];
                if (which < 2) {
                    const float q = fqsum((dot4(acc[ai][0][m][0]) + dot4(acc[ai][0][m][1])) + (dot4(acc[ai][1][m][0]) + dot4(acc[ai][1][m][1])));
                    const float sc = post * rstd * rsq(q * (rstd * rstd) * (1.0f / HDIM) + RMS_EPS);
#pragma unroll
                    for (int bj = 0; bj < 2; ++bj)
#pragma unroll
                        for (int n = 0; n < 2; ++n) v[bj][n] = acc[ai][bj][m][n] * (g[bj][n] * sc);
                    const f32x4 x1 = v[0][0], x2 = v[0][1];
                    v[0][0] = (x1 * cs - x2 * sn); v[0][1] = (x2 * cs + x1 * sn);
                    if (KMSUM && which == 1) {
#pragma unroll
                        for (int bj = 0; bj < 2; ++bj)
#pragma unroll
                            for (int n = 0; n < 2; ++n) ks[bj][n] += v[bj][n];
                    }
                } else {
#pragma unroll
                    for (int bj = 0; bj < 2; ++bj)
#pragma unroll
                        for (int n = 0; n < 2; ++n) v[bj][n] = acc[ai][bj][m][n] * rstd;
                }
                bf16* rowp = dst + (size_t)row * DMODEL + head * 64 + 8 * fq;
#pragma unroll
                for (int bj = 0; bj < 2; ++bj) {
                    u32x4 w; w.x = pg8::cvt_pk_bf16(v[bj][0][0], v[bj][0][1]); w.y = pg8::cvt_pk_bf16(v[bj][0][2], v[bj][0][3]);
                    w.z = pg8::cvt_pk_bf16(v[bj][1][0], v[bj][1][1]); w.w = pg8::cvt_pk_bf16(v[bj][1][2], v[bj][1][3]);
                    *(u32x4*)(rowp + bj * 32) = w;
                }
            }
            asm volatile("" ::: "memory");
        }
        if (KMSUM && which == 1) {
#pragma unroll
            for (int bj = 0; bj < 2; ++bj)
#pragma unroll
                for (int n = 0; n < 2; ++n)
#pragma unroll
                    for (int e = 0; e < 4; ++e) {
                        float x = ks[bj][n][e];
                        x += dpp_ror<0x128>(x); x += dpp_ror<0x124>(x); x += dpp_ror<0x122>(x); x += dpp_ror<0x121>(x);
                        ks[bj][n][e] = x;
                    }
            if (fr == 0) {
                float* kp = kmsum + ((size_t)((u.pm >> 4) * NHEADS + head) * 16 + (u.pm & 15)) * 64 + 8 * fq;
#pragma unroll
                for (int bj = 0; bj < 2; ++bj)
#pragma unroll
                    for (int n = 0; n < 2; ++n)
#pragma unroll
                        for (int e = 0; e < 4; ++e) atomicAdd(kp + bj * 32 + 4 * n + e, ks[bj][n][e]);
            }
        }
    }
};

__device__ __forceinline__ f32x4 bf_lo2(unsigned a, unsigned b) { return (f32x4){__uint_as_float(a << 16), __uint_as_float(a & 0xffff0000u), __uint_as_float(b << 16), __uint_as_float(b & 0xffff0000u)}; }
template <bool RES_F32, bool OUT_F32> struct EpiRes {
    static constexpr bool PROBE2 = false, AROWPERM = false;
    const void* resid; void* out; float* ss;
    __device__ __forceinline__ void prefetch(const pg8::Unit&, LAS unsigned char*, int, int) const {}
    __device__ __forceinline__ void operator()(const f32x4 (&acc)[2][2][4][2], const pg8::Unit& u, int wr, int wc, int fr, int fq, LAS unsigned char*) const {
        const int col0 = u.pn * 256 + wc * 32 + 8 * fq;
        if constexpr (!RES_F32) {
            u32x4 rb[2][4][2];
#pragma unroll
            for (int ai = 0; ai < 2; ++ai)
#pragma unroll
                for (int m = 0; m < 4; ++m) {
                    const size_t off = (size_t)(u.pm * 256 + ai * 128 + wr * 64 + m * 16 + fr) * DMODEL + col0;
#pragma unroll
                    for (int bj = 0; bj < 2; ++bj) rb[ai][m][bj] = __builtin_nontemporal_load((const u32x4*)((const bf16*)resid + off + bj * 128));
                }
            asm volatile("" ::: "memory");
#pragma unroll
            for (int ai = 0; ai < 2; ++ai)
#pragma unroll
                for (int m = 0; m < 4; ++m) {
                    const int row = u.pm * 256 + ai * 128 + wr * 64 + m * 16 + fr;
                    const size_t off = (size_t)row * DMODEL + col0;
                    float q = 0.f;
#pragma unroll
                    for (int bj = 0; bj < 2; ++bj) {
                        const f32x4 x0 = bf_lo2(rb[ai][m][bj].x, rb[ai][m][bj].y) + acc[ai][bj][m][0], x1 = bf_lo2(rb[ai][m][bj].z, rb[ai][m][bj].w) + acc[ai][bj][m][1];
                        q += dot4(x0) + dot4(x1);
                        if (OUT_F32) { *(f32x4*)((float*)out + off + bj * 128) = x0; *(f32x4*)((float*)out + off + bj * 128 + 4) = x1; }
                        else { u32x4 w; w.x = pg8::cvt_pk_bf16(x0[0], x0[1]); w.y = pg8::cvt_pk_bf16(x0[2], x0[3]); w.z = pg8::cvt_pk_bf16(x1[0], x1[1]); w.w = pg8::cvt_pk_bf16(x1[2], x1[3]);
                            *(u32x4*)((bf16*)out + off + bj * 128) = w; }
                    }
                    if (ss) { q = fqsum(q); if (fq == 0) atomicAdd(ss + row, q); }
                }
        } else {
#pragma unroll
            for (int ai = 0; ai < 2; ++ai)
#pragma unroll
                for (int mp = 0; mp < 4; mp += 2) {
                    f32x4 rr[2][2][2];
#pragma unroll
                    for (int mm = 0; mm < 2; ++mm) {
                        const size_t off = (size_t)(u.pm * 256 + ai * 128 + wr * 64 + (mp + mm) * 16 + fr) * DMODEL + col0;
#pragma unroll
                        for (int bj = 0; bj < 2; ++bj) { rr[mm][bj][0] = *(const f32x4*)((const float*)resid + off + bj * 128); rr[mm][bj][1] = *(const f32x4*)((const float*)resid + off + bj * 128 + 4); }
                    }
#pragma unroll
                    for (int mm = 0; mm < 2; ++mm) {
                        const int m = mp + mm;
                        const int row = u.pm * 256 + ai * 128 + wr * 64 + m * 16 + fr;
                        const size_t off = (size_t)row * DMODEL + col0;
                        float q = 0.f;
#pragma unroll
                        for (int bj = 0; bj < 2; ++bj) {
                            const f32x4 x0 = rr[mm][bj][0] + acc[ai][bj][m][0], x1 = rr[mm][bj][1] + acc[ai][bj][m][1];
                            q += dot4(x0) + dot4(x1);
                            if (OUT_F32) { *(f32x4*)((float*)out + off + bj * 128) = x0; *(f32x4*)((float*)out + off + bj * 128 + 4) = x1; }
                            else { u32x4 w; w.x = pg8::cvt_pk_bf16(x0[0], x0[1]); w.y = pg8::cvt_pk_bf16(x0[2], x0[3]); w.z = pg8::cvt_pk_bf16(x1[0], x1[1]); w.w = pg8::cvt_pk_bf16(x1[2], x1[3]);
                                *(u32x4*)((bf16*)out + off + bj * 128) = w; }
                        }
                        if (ss) { q = fqsum(q); if (fq == 0) atomicAdd(ss + row, q); }
                    }
                    asm volatile("" ::: "memory");
                }
        }
    }
};

__device__ __forceinline__ void shr1_into(f32x4& d, const f32x4 s) {
    float d0 = d[0], d1 = d[1], d2 = d[2], d3 = d[3];
    asm volatile("s_nop 1\n\tv_mov_b32_dpp %0, %4 row_shr:1 row_mask:0xf bank_mask:0xf\n\tv_mov_b32_dpp %1, %5 row_shr:1 row_mask:0xf bank_mask:0xf\n\t"
                 "v_mov_b32_dpp %2, %6 row_shr:1 row_mask:0xf bank_mask:0xf\n\tv_mov_b32_dpp %3, %7 row_shr:1 row_mask:0xf bank_mask:0xf"
                 : "+v"(d0), "+v"(d1), "+v"(d2), "+v"(d3) : "v"(s[0]), "v"(s[1]), "v"(s[2]), "v"(s[3]));
    d = (f32x4){d0, d1, d2, d3};
}
__device__ __forceinline__ f32x4 ror1(f32x4 v) { return (f32x4){dpp_ror<0x121>(v[0]), dpp_ror<0x121>(v[1]), dpp_ror<0x121>(v[2]), dpp_ror<0x121>(v[3])}; }
__device__ __forceinline__ f32x4 ror2(f32x4 v) { return (f32x4){dpp_ror<0x122>(v[0]), dpp_ror<0x122>(v[1]), dpp_ror<0x122>(v[2]), dpp_ror<0x122>(v[3])}; }
__device__ __forceinline__ float silu_mul(float gte, float val) { const float e = __builtin_amdgcn_exp2f(gte * -1.4426950408889634f); return gte * __builtin_amdgcn_rcpf(1.0f + e) * val; }
constexpr int EDGE_ROWS = 4;
struct EpiUpConv {
    static constexpr bool PROBE2 = (PROBE_EPI2 & 2) != 0, AROWPERM = true;
    const float* ss; const float* cw; const float* cb; bf16* Hh; float* edge;
    __device__ __forceinline__ void prefetch(const pg8::Unit& u, LAS unsigned char* xlds, int wid, int lane) const {
        const unsigned l16 = (unsigned)lane * 16u;
        if (wid == 0) dma1k(ss + u.pm * 256, xlds + XL_SS, l16);
        if (wid >= 1 && wid <= 4) {
            const float* src = ((wid == 4) ? cb : cw + (size_t)(wid - 1) * NUP) + u.pn * 128;
            dma1k(src, xlds + XL_CW + (wid - 1) * 1024, l16 + ((lane < 32) ? 0u : (unsigned)(DFF - 128) * 4u));
        }
    }
    __device__ __forceinline__ void operator()(const f32x4 (&acc)[2][2][4][2], const pg8::Unit& u, int wr, int wc, int fr, int fq, LAS unsigned char* xlds) const {
        float rs[2][4];
#pragma unroll
        for (int ai = 0; ai < 2; ++ai)
#pragma unroll
            for (int m = 0; m < 4; ++m) rs[ai][m] = lds_rstd(xlds, ai * 128 + wr * 64 + 4 * fr + m);
        LAS f32x4* EX = (LAS f32x4*)(xlds + XL_EX);
        if (fr == 15) {
#pragma unroll
            for (int ai = 0; ai < 2; ++ai)
#pragma unroll
                for (int mm = 0; mm < 2; ++mm)
#pragma unroll
                    for (int bj = 0; bj < 2; ++bj)
#pragma unroll
                        for (int n = 0; n < 2; ++n) EX[((((ai * 2 + wr) * 4 + wc) * 2 + mm) * 4 + fq) * 4 + bj * 2 + n] = acc[ai][bj][2 + mm][n] * rs[ai][2 + mm];
        }
        {
            const int pcol = u.pn * 256 + wc * 32 + 8 * fq;
            float* eb = edge + (size_t)u.pm * EDGE_ROWS * NUP + pcol;
            if (wr == 0 && fr == 0) {
#pragma unroll
                for (int mm = 0; mm < 2; ++mm)
#pragma unroll
                    for (int bj = 0; bj < 2; ++bj)
#pragma unroll
                        for (int n = 0; n < 2; ++n) *(f32x4*)(eb + (size_t)mm * NUP + bj * 128 + 4 * n) = acc[0][bj][mm][n] * rs[0][mm];
            }
            if (wr == 1 && fr == 15) {
#pragma unroll
                for (int mm = 0; mm < 2; ++mm)
#pragma unroll
                    for (int bj = 0; bj < 2; ++bj)
#pragma unroll
                        for (int n = 0; n < 2; ++n) *(f32x4*)(eb + (size_t)(2 + mm) * NUP + bj * 128 + 4 * n) = acc[1][bj][2 + mm][n] * rs[1][2 + mm];
            }
        }
        asm volatile("s_waitcnt lgkmcnt(0)" ::: "memory"); __builtin_amdgcn_s_barrier(); asm volatile("" ::: "memory");
        const bool seq_start = (u.pm & 15) == 0;
        const int jg0 = u.pn * 128 + wc * 32 + 8 * fq;
        u32x2 hold[2][4];
#pragma unroll
        for (int n = 0; n < 2; ++n) {
            f32x4 w0[2], w1[2], w2[2], bb[2];
#pragma unroll
            for (int bj = 0; bj < 2; ++bj) {
                const int pc = (bj * 128 + wc * 32 + 8 * fq + 4 * n) * 4;
                w0[bj] = *(const LAS f32x4*)(xlds + XL_CW + pc); w1[bj] = *(const LAS f32x4*)(xlds + XL_CW + 1024 + pc); w2[bj] = *(const LAS f32x4*)(xlds + XL_CW + 2048 + pc); bb[bj] = *(const LAS f32x4*)(xlds + XL_CW + 3072 + pc);
            }
#pragma unroll
            for (int ai = 0; ai < 2; ++ai) {
                f32x4 uc[2][4];
#pragma unroll
                for (int bj = 0; bj < 2; ++bj) {
                    f32x4 h62, h63;
                    if (ai == 0 && wr == 0) { h62 = (f32x4){0.f, 0.f, 0.f, 0.f}; h63 = h62; }
                    else { const int sa = (wr == 1) ? ai : ai - 1, sw = (wr == 1) ? 0 : 1;
                        h62 = EX[((((sa * 2 + sw) * 4 + wc) * 2 + 0) * 4 + fq) * 4 + bj * 2 + n]; h63 = EX[((((sa * 2 + sw) * 4 + wc) * 2 + 1) * 4 + fq) * 4 + bj * 2 + n]; }
                    f32x4 c[4];
#pragma unroll
                    for (int m = 0; m < 4; ++m) c[m] = acc[ai][bj][m][n] * rs[ai][m];
                    f32x4 x1 = h63, x2 = h62;
                    shr1_into(x1, c[3]); shr1_into(x2, c[2]);
                    uc[bj][0] = bb[bj] + w0[bj] * x2 + w1[bj] * x1 + w2[bj] * c[0];
                    uc[bj][1] = bb[bj] + w0[bj] * x1 + w1[bj] * c[0] + w2[bj] * c[1];
                    uc[bj][2] = bb[bj] + w0[bj] * c[0] + w1[bj] * c[1] + w2[bj] * c[2];
                    uc[bj][3] = bb[bj] + w0[bj] * c[1] + w1[bj] * c[2] + w2[bj] * c[3];
                }
#pragma unroll
                for (int m = 0; m < 4; ++m) {
                    const unsigned lo = pg8::cvt_pk_bf16(silu_mul(uc[0][m][0], uc[1][m][0]), silu_mul(uc[0][m][1], uc[1][m][1]));
                    const unsigned hi = pg8::cvt_pk_bf16(silu_mul(uc[0][m][2], uc[1][m][2]), silu_mul(uc[0][m][3], uc[1][m][3]));
                    if (n == 0) { hold[ai][m] = (u32x2){lo, hi}; }
                    else {
                        const int row = u.pm * 256 + ai * 128 + wr * 64 + 4 * fr + m;
                        const bool skip = (!seq_start) && ai == 0 && wr == 0 && m < 2 && fr == 0;
                        if (!skip) { u32x4 w; w.x = hold[ai][m].x; w.y = hold[ai][m].y; w.z = lo; w.w = hi; *(u32x4*)(Hh + (size_t)row * DFF + jg0) = w; }
                    }
                }
                asm volatile("" ::: "memory");
            }
        }
    }
};

namespace attn {
using bf16x8 = __attribute__((ext_vector_type(8))) short;
using s16x4 = __attribute__((ext_vector_type(4))) short;
using f32x16 = __attribute__((ext_vector_type(16))) float;
using u32x4 = ::u32x4;
constexpr int DM = 1024, NW = 8, QBLK = 32, QB = 256, KVBLK = 64;
constexpr int NSLOT = 3, SLOTB = 8192;
constexpr int LDS_K = 0, LDS_V = NSLOT * SLOTB, LDS_WS = 2 * NSLOT * SLOTB, LDS_OST = LDS_WS + NW * 64 * 4, LDS_BYTES = LDS_OST + NW * 4096;
constexpr int THRL = 8;
enum { OUT_FINAL = 0, OUT_PART = 1, OUT_MERGE = 2 };
struct Job {
    const bf16* Q; const bf16* K; const bf16* V;
    bf16* O;
    long rs;
    int q0, k0, NT;
    int ob;
    const float* kmean;
    float kbound;
    float* stat;
    const bf16* num0; const bf16* num1; const float* stat0; const float* stat1;
    long srs;
};
__device__ __forceinline__ int crow(int r, int hi) { return (r & 3) + 8 * (r >> 2) + 4 * hi; }
#define SBAR() __builtin_amdgcn_sched_barrier(0)
__device__ __forceinline__ void glds16_nt(const void* gsrc, unsigned lds_dst) { unsigned keep;
    asm volatile("s_mov_b32 %0, m0\n\ts_mov_b32 m0, %2\n\ts_nop 0\n\tglobal_load_lds_dwordx4 %1, off nt\n\ts_mov_b32 m0, %0" : "=&s"(keep) : "v"(gsrc), "s"(lds_dst) : "memory"); }
__device__ __forceinline__ void glds16(const void* gsrc, unsigned lds_dst) { unsigned keep;
    asm volatile("s_mov_b32 %0, m0\n\ts_mov_b32 m0, %2\n\ts_nop 0\n\tglobal_load_lds_dwordx4 %1, off\n\ts_mov_b32 m0, %0" : "=&s"(keep) : "v"(gsrc), "s"(lds_dst) : "memory"); }
typedef float f32x2_t __attribute__((ext_vector_type(2))); typedef __bf16 bf16x2_t __attribute__((ext_vector_type(2)));
__device__ __forceinline__ unsigned cvtpk_s(float lo, float hi) { f32x2_t v = {lo, hi}; bf16x2_t b = __builtin_convertvector(v, bf16x2_t); return __builtin_bit_cast(unsigned, b); }
#define WAIT_BAR(N) asm volatile("s_waitcnt vmcnt(" #N ") lgkmcnt(0)\n\ts_barrier" ::: "memory")
typedef __attribute__((address_space(3))) const char* lds_cptr;
typedef short v4i16_t __attribute__((ext_vector_type(4)));
__device__ __forceinline__ void kload8(bf16x8* kf, lds_cptr kp) {
    kf[0] = *(const __attribute__((address_space(3))) bf16x8*)(kp);        kf[1] = *(const __attribute__((address_space(3))) bf16x8*)(kp + 512);
    kf[2] = *(const __attribute__((address_space(3))) bf16x8*)(kp + 2048); kf[3] = *(const __attribute__((address_space(3))) bf16x8*)(kp + 2560);
    kf[4] = *(const __attribute__((address_space(3))) bf16x8*)(kp + 4096); kf[5] = *(const __attribute__((address_space(3))) bf16x8*)(kp + 4608);
    kf[6] = *(const __attribute__((address_space(3))) bf16x8*)(kp + 6144); kf[7] = *(const __attribute__((address_space(3))) bf16x8*)(kp + 6656);
}
__device__ __forceinline__ void kload2(bf16x8* kf, lds_cptr kp, int j) { kf[2 * j] = *(const __attribute__((address_space(3))) bf16x8*)(kp + j * 2048); kf[2 * j + 1] = *(const __attribute__((address_space(3))) bf16x8*)(kp + j * 2048 + 512); }
__device__ __forceinline__ s16x4 vtr(lds_cptr p) { return __builtin_bit_cast(s16x4, __builtin_amdgcn_ds_read_tr16_b64_v4i16((__attribute__((address_space(3))) v4i16_t*)p)); }
#define MX3(a, b, c) __builtin_fmaxf(__builtin_fmaxf((a), (b)), (c))
__device__ __forceinline__ float rowmax32(const f32x16& p0, const f32x16& p1) {
    float a = MX3(p0[0], p0[1], p1[0]), b = MX3(p0[2], p0[3], p1[1]); a = MX3(a, p1[2], p1[3]);
#pragma unroll
    for (int r = 4; r < 16; r += 4) { a = MX3(a, p0[r], p0[r + 1]); b = MX3(b, p0[r + 2], p0[r + 3]); a = MX3(a, p1[r], p1[r + 1]); b = MX3(b, p1[r + 2], p1[r + 3]); }
    float m = __builtin_fmaxf(a, b); auto rr = __builtin_amdgcn_permlane32_swap(__float_as_uint(m), __float_as_uint(m), false, false);
    return __builtin_fmaxf(__uint_as_float(rr[0]), __uint_as_float(rr[1]));
}
__device__ __forceinline__ float halves_sum(float v) { auto rr = __builtin_amdgcn_permlane32_swap(__float_as_uint(v), __float_as_uint(v), false, false); return __uint_as_float(rr[0]) + __uint_as_float(rr[1]); }
__device__ __forceinline__ void bmask(f32x16& p0, f32x16& p1, int Dt, unsigned lim) {
#pragma unroll
    for (int r = 0; r < 16; ++r) { const int x = Dt - ((r & 3) + 8 * (r >> 2)); if ((unsigned)x > lim) p0[r] = -INFINITY; if ((unsigned)(x - 32) > lim) p1[r] = -INFINITY; }
}
__device__ __forceinline__ void pv(f32x16* o, int vb, bf16x8 pa0, bf16x8 pa1, bf16x8 pa2, bf16x8 pa3) {
#pragma unroll
    for (int d0 = 0; d0 < 2; ++d0) { s16x4 lo[4], hi[4];
#pragma unroll
        for (int ks = 0; ks < 4; ++ks) {
            asm volatile("ds_read_b64_tr_b16 %0,%1 offset:%c2" : "=&v"(lo[ks]) : "v"(vb), "i"(d0 * 4096 + ks * 1024) : "memory");
            asm volatile("ds_read_b64_tr_b16 %0,%1 offset:%c2" : "=&v"(hi[ks]) : "v"(vb), "i"(d0 * 4096 + ks * 1024 + 512) : "memory"); }
        asm volatile("s_waitcnt lgkmcnt(0)" ::: "memory"); SBAR();
#define PK(k) (bf16x8){lo[k][0], lo[k][1], lo[k][2], lo[k][3], hi[k][0], hi[k][1], hi[k][2], hi[k][3]}
        o[d0] = __builtin_amdgcn_mfma_f32_32x32x16_bf16(pa0, PK(0), o[d0], 0, 0, 0);
        o[d0] = __builtin_amdgcn_mfma_f32_32x32x16_bf16(pa1, PK(1), o[d0], 0, 0, 0);
        o[d0] = __builtin_amdgcn_mfma_f32_32x32x16_bf16(pa2, PK(2), o[d0], 0, 0, 0);
        o[d0] = __builtin_amdgcn_mfma_f32_32x32x16_bf16(pa3, PK(3), o[d0], 0, 0, 0);
#undef PK
    }
}

template <int OUT> __device__ __forceinline__ void unit_epilogue(const Job& J, float* wsf, unsigned short* stg  , int wid, int lane, float l_reg, float mhat, const f32x16 (&o)[2]) {
    const int r32 = lane & 31, hi = lane >> 5; const long rs = J.rs;
    l_reg = halves_sum(l_reg);
    if (hi == 0) { wsf[32 + r32] = l_reg; wsf[r32] = mhat; }
    asm volatile("s_waitcnt lgkmcnt(0)" ::: "memory");
    const long orow0 = (long)(J.q0 + wid * QBLK);
    if (OUT == OUT_PART) { if (hi == 0) { float* sp = J.stat + (orow0 + r32) * J.srs; *(f32x2*)sp = (f32x2){l_reg, mhat}; } }
#pragma unroll
    for (int hf = 0; hf < 2; ++hf) {
#pragma unroll
        for (int rr = 0; rr < 8; ++rr) { const int r = 8 * hf + rr; const int orow = crow(rr, hi);
            const float sc = (OUT == OUT_FINAL) ? __builtin_amdgcn_rcpf(wsf[32 + crow(r, hi)]) : 1.0f;
#pragma unroll
            for (int d0 = 0; d0 < 2; ++d0) stg[orow * 64 + d0 * 32 + r32] = (unsigned short)(cvtpk_s(o[d0][r] * sc, 0.f) & 0xffffu); }
        asm volatile("s_waitcnt lgkmcnt(0)" ::: "memory");
#pragma unroll
        for (int i = 0; i < 2; ++i) {
            const int srow = i * 8 + (lane >> 3), row = 16 * hf + srow, ch = lane & 7;
            const u32x4 v = *(const u32x4*)(stg + srow * 64 + ch * 8);
            const long go = (orow0 + row) * rs + ch * 8;
            if (OUT == OUT_MERGE) {
                const float l2 = wsf[32 + row], m2 = wsf[row];
                const f32x2 s0 = *(const f32x2*)(J.stat0 + (orow0 + row) * J.srs), s1 = *(const f32x2*)(J.stat1 + (orow0 + row) * J.srs);
                const u32x4 n0 = *(const u32x4*)(J.num0 + go), n1 = *(const u32x4*)(J.num1 + go);
                const float mx = MX3(s0.y, s1.y, m2);
                const float w0 = __builtin_amdgcn_exp2f(s0.y - mx), w1 = __builtin_amdgcn_exp2f(s1.y - mx), w2 = __builtin_amdgcn_exp2f(m2 - mx);
                const float inv = 1.0f / (w0 * s0.x + w1 * s1.x + w2 * l2);
                const float a0 = w0 * inv, a1 = w1 * inv, a2 = w2 * inv;
                u32x4 w;
#pragma unroll
                for (int e = 0; e < 4; ++e) {
                    const float lo = a0 * __uint_as_float(n0[e] << 16) + a1 * __uint_as_float(n1[e] << 16) + a2 * __uint_as_float(v[e] << 16);
                    const float hh = a0 * __uint_as_float(n0[e] & 0xffff0000u) + a1 * __uint_as_float(n1[e] & 0xffff0000u) + a2 * __uint_as_float(v[e] & 0xffff0000u);
                    w[e] = cvtpk_s(lo, hh);
                }
                *(u32x4*)(J.O + go) = w;
            } else {
                *(u32x4*)(J.O + go) = v;
            }
        }
        asm volatile("s_waitcnt lgkmcnt(0)" ::: "memory");
    }
}

__device__ __forceinline__ void ring_issue(const int tid, const Job& J, char* shm) {
    const int lane = tid & 63; const int wid = __builtin_amdgcn_readfirstlane(tid >> 6);
    const long rs = J.rs;
    const bf16* Kh = J.K + (long)J.k0 * rs; const bf16* Vh = J.V + (long)J.k0 * rs;
    const unsigned lds0 = (unsigned)(uintptr_t)shm;
    const bf16* ksrc = Kh + (long)lane * rs + wid * 8;
    const bf16* vsrc = Vh + (long)(16 * (wid & 3) + (lane >> 2)) * rs + (wid >> 2) * 32 + (lane & 3) * 8;
    const unsigned kdst = lds0 + LDS_K + wid * 1024, vdst = lds0 + LDS_V + wid * 1024;
    glds16(ksrc, (unsigned)__builtin_amdgcn_readfirstlane(kdst)); glds16(vsrc, (unsigned)__builtin_amdgcn_readfirstlane(vdst));
    glds16(ksrc + (long)KVBLK * rs, (unsigned)__builtin_amdgcn_readfirstlane(kdst + SLOTB)); glds16(ksrc + (long)2 * KVBLK * rs, (unsigned)__builtin_amdgcn_readfirstlane(kdst + 2 * SLOTB));
}
template <bool MOBA, bool FIXED = false> __device__ __forceinline__ void attn_unit(const int tid, const Job& J, char* shm, float& l_out, float& m_out, f32x16 (&o)[2]) {
    const int lane = tid & 63, r32 = lane & 31, hi = lane >> 5; const int wid = __builtin_amdgcn_readfirstlane(tid >> 6);
    const long rs = J.rs; const int NT = J.NT;
    const bf16* Qw = J.Q + (long)(J.q0 + wid * QBLK) * rs;
    const bf16* Kh = J.K + (long)J.k0 * rs; const bf16* Vh = J.V + (long)J.k0 * rs;
    const unsigned lds0 = (unsigned)(uintptr_t)shm;
    float* wsf = (float*)(shm + LDS_WS) + wid * 64;
    const bf16* ksrc = Kh + (long)lane * rs + wid * 8;
    const bf16* vsrc = Vh + (long)(16 * (wid & 3) + (lane >> 2)) * rs + (wid >> 2) * 32 + (lane & 3) * 8;
    const unsigned kdst = lds0 + LDS_K + wid * 1024, vdst = lds0 + LDS_V + wid * 1024;
#define DMA_K(t, slot) glds16(ksrc + (long)(t) * KVBLK * rs, (unsigned)__builtin_amdgcn_readfirstlane(kdst + (slot)))
#define DMA_V(t, slot) glds16(vsrc + (long)(t) * KVBLK * rs, (unsigned)__builtin_amdgcn_readfirstlane(vdst + (slot)))
    const int vb0 = (int)(lds0 + LDS_V) + ((lane >> 4) & 1) * 32 + (lane & 3) * 8 + (4 * hi + ((lane & 15) >> 2)) * 64;
    bf16x8 kf[8];
    const lds_cptr shm3 = (lds_cptr)shm; const lds_cptr kp0 = shm3 + LDS_K + hi * 1024 + r32 * 16; const lds_cptr vp0 = shm3 + LDS_V + ((lane >> 4) & 1) * 32 + (lane & 3) * 8 + (4 * hi + ((lane & 15) >> 2)) * 64;
    bf16x8 qr[4];
#pragma unroll
    for (int d0 = 0; d0 < 4; ++d0) qr[d0] = *reinterpret_cast<const bf16x8*>(&Qw[(long)r32 * rs + d0 * 16 + hi * 8]);
    unsigned sel = 0xffffffffu;
    if (MOBA) {
        const int ob = J.ob; float gt[16];
        { const float* km = J.kmean + ((r32 < 16) ? r32 : 15) * 64 + hi * 8;
          f32x16 g = f32x16{};
#pragma unroll
          for (int d0 = 0; d0 < 4; ++d0) {
              const f32x4 a = *(const f32x4*)(km + d0 * 16), b = *(const f32x4*)(km + d0 * 16 + 4);
              u32x4 H, L;
              H[0] = cvtpk_s(a[0], a[1]); H[1] = cvtpk_s(a[2], a[3]); H[2] = cvtpk_s(b[0], b[1]); H[3] = cvtpk_s(b[2], b[3]);
              L[0] = cvtpk_s(a[0] - __uint_as_float(H[0] << 16), a[1] - __uint_as_float(H[0] & 0xffff0000u)); L[1] = cvtpk_s(a[2] - __uint_as_float(H[1] << 16), a[3] - __uint_as_float(H[1] & 0xffff0000u));
              L[2] = cvtpk_s(b[0] - __uint_as_float(H[2] << 16), b[1] - __uint_as_float(H[2] & 0xffff0000u)); L[3] = cvtpk_s(b[2] - __uint_as_float(H[3] << 16), b[3] - __uint_as_float(H[3] & 0xffff0000u));
              g = __builtin_amdgcn_mfma_f32_32x32x16_bf16(__builtin_bit_cast(bf16x8, H), qr[d0], g, 0, 0, 0);
              g = __builtin_amdgcn_mfma_f32_32x32x16_bf16(__builtin_bit_cast(bf16x8, L), qr[d0], g, 0, 0, 0);
          }
#pragma unroll
          for (int r = 0; r < 8; ++r) { auto rr = __builtin_amdgcn_permlane32_swap(__float_as_uint(g[r]), __float_as_uint(g[r]), false, false);
              gt[crow(r, 0)] = __uint_as_float(rr[0]); gt[crow(r, 1)] = __uint_as_float(rr[1]); }
        }
        sel = 0u;
#pragma unroll
        for (int k = 0; k < 3; ++k) {
            float best = -INFINITY; int bi = -1;
#pragma unroll
            for (int j = 0; j < 15; ++j) { const bool c = (j < ob) && (((sel >> j) & 1u) == 0u) && (gt[j] > best); best = c ? gt[j] : best; bi = c ? j : bi; }
            if (bi >= 0) sel |= 1u << bi;
        }
        sel |= 1u << ob;
    }
    float mhat = 0.f, l_reg = 0.f; o[0] = f32x16{}; o[1] = f32x16{};
    if (FIXED) { float qq = 0.f;
#pragma unroll
        for (int d0 = 0; d0 < 4; ++d0)
#pragma unroll
            for (int e = 0; e < 8; ++e) { const float v = bf2f((unsigned short)qr[d0][e]); qq += v * v; }
        mhat = __builtin_sqrtf(halves_sum(qq)) * J.kbound; }
    bool selc = MOBA ? ((sel & 1u) != 0u) : true;
    f32x16 negm;
    { const float nv = selc ? -mhat : -INFINITY;
#pragma unroll
      for (int r = 0; r < 16; ++r) negm[r] = nv; }
    asm volatile("" : "+v"(negm));
    const int qrel = wid * QBLK + r32;
    const int D0 = MOBA ? (qrel - 4 * hi) : (J.q0 + qrel - J.k0 - 4 * hi);
    const int toff = MOBA ? (NT - 4) : 0, tmlo = MOBA ? (NT - 4) : 0;
    const unsigned mlim = MOBA ? 0x7fffffffu : 128u;
#define CMASK(P0, P1, t) do { if ((t) >= tmlo) bmask(P0, P1, D0 - 64 * ((t) - toff), mlim); } while (0)
#define SETNEG(j) do { if (MOBA) { selc = ((sel >> (j)) & 1u) != 0u; const float nv_ = selc ? -mhat : -INFINITY; _Pragma("unroll") for (int r = 0; r < 16; ++r) negm[r] = nv_; asm volatile("" : "+v"(negm)); } } while (0)
    bool resc = false;
#define RESC() do { if (resc) { asm volatile("s_waitcnt lgkmcnt(0)" ::: "memory"); \
      _Pragma("unroll") for (int d_ = 0; d_ < 2; ++d_) _Pragma("unroll") for (int r = 0; r < 16; ++r) o[d_][r] *= wsf[crow(r, hi)]; } } while (0)
    f32x16 pA0, pA1, pB0, pB1;
    int sl_prev = 0, sl_cur = 0, sl_next = SLOTB;
#define ROT() do { sl_prev = sl_cur; sl_cur = sl_next; sl_next = (sl_next == (NSLOT - 1) * SLOTB) ? 0 : sl_next + SLOTB; } while (0)
    WAIT_BAR(3);
    kload8(kf, kp0);
    pA0 = __builtin_amdgcn_mfma_f32_32x32x16_bf16(kf[0], qr[0], negm, 0, 0, 0); pA1 = __builtin_amdgcn_mfma_f32_32x32x16_bf16(kf[1], qr[0], negm, 0, 0, 0);
    pA0 = __builtin_amdgcn_mfma_f32_32x32x16_bf16(kf[2], qr[1], pA0, 0, 0, 0);  pA1 = __builtin_amdgcn_mfma_f32_32x32x16_bf16(kf[3], qr[1], pA1, 0, 0, 0);
    pA0 = __builtin_amdgcn_mfma_f32_32x32x16_bf16(kf[4], qr[2], pA0, 0, 0, 0);  pA1 = __builtin_amdgcn_mfma_f32_32x32x16_bf16(kf[5], qr[2], pA1, 0, 0, 0);
    pA0 = __builtin_amdgcn_mfma_f32_32x32x16_bf16(kf[6], qr[3], pA0, 0, 0, 0);  pA1 = __builtin_amdgcn_mfma_f32_32x32x16_bf16(kf[7], qr[3], pA1, 0, 0, 0);
    CMASK(pA0, pA1, 0);
    { const float rm = FIXED ? 0.f : rowmax32(pA0, pA1);
      if (!FIXED && __any(rm > (float)THRL)) { const float dl = __builtin_fmaxf(rm, 0.f); mhat += dl;
#pragma unroll
          for (int r = 0; r < 16; ++r) { pA0[r] -= dl; pA1[r] -= dl; }
          const float nv = selc ? -mhat : -INFINITY;
#pragma unroll
          for (int r = 0; r < 16; ++r) negm[r] = nv;
          asm volatile("" : "+v"(negm)); }
#pragma unroll
      for (int r = 0; r < 16; ++r) { pA0[r] = __builtin_amdgcn_exp2f(pA0[r]); pA1[r] = __builtin_amdgcn_exp2f(pA1[r]); } }
    WAIT_BAR(0);
    DMA_K(3, 0); DMA_V(1, SLOTB);
    ROT();
    kload8(kf, kp0 + sl_cur);
    WAIT_BAR(2);
    s16x4 vlo[8], vhi[8]; u32x4 pw0, pw1, pw2, pw3;
#define PKW(P, B) cvtpk_s(P[B], P[B + 1])
#define PAF(k) __builtin_bit_cast(bf16x8, pw##k)
#define VFR(i) (bf16x8){vlo[i][0], vlo[i][1], vlo[i][2], vlo[i][3], vhi[i][0], vhi[i][1], vhi[i][2], vhi[i][3]}
#define PIN(x) asm volatile("" : "+v"(x))
#define GAPA(MF, A0, A1, A2, A3, W0, W1, PW) do { MF; sacc += A0; sacc += A1; sacc += A2; sacc += A3; PIN(sacc); W0; W1; PIN(PW); SBAR(); } while (0)
#define EX(v) __builtin_amdgcn_exp2f(v)
#define GAPB(MF, X, B) do { MF; X[B] = EX(X[B]); X[B + 1] = EX(X[B + 1]); X[B + 2] = EX(X[B + 2]); X[B + 3] = EX(X[B + 3]); PIN(X); SBAR(); } while (0)
#define VRD(i) do { vlo[i] = vtr(vp_ + (((i) >> 2) * 4096 + ((i) & 3) * 1024)); vhi[i] = vtr(vp_ + (((i) >> 2) * 4096 + ((i) & 3) * 1024 + 512)); } while (0)
#define KRD(G, j) do { if (G) { kload2(kf, kp0 + sl_next, j); SBAR(); } } while (0)
#define STEP(C0, C1, P0, P1, t, GK, GV, GL) do { SBAR(); \
    const lds_cptr vp_ = vp0 + sl_prev; \
    VRD(0); SBAR(); float sacc = (P0[0] + P0[1]); \
    GAPA(C0 = __builtin_amdgcn_mfma_f32_32x32x16_bf16(kf[0], qr[0], negm, 0, 0, 0), P0[2], P0[3], P0[4], P0[5],     pw0[0] = PKW(P0, 0), pw0[1] = PKW(P0, 2), pw0); \
    VRD(4); SBAR(); GAPA(C1 = __builtin_amdgcn_mfma_f32_32x32x16_bf16(kf[1], qr[0], negm, 0, 0, 0), P0[6], P0[7], P0[8], P0[9],     pw0[2] = PKW(P0, 4), pw0[3] = PKW(P0, 6), pw0); \
    VRD(1); SBAR(); GAPA(C0 = __builtin_amdgcn_mfma_f32_32x32x16_bf16(kf[2], qr[1], C0, 0, 0, 0),   P0[10], P0[11], P0[12], P0[13], pw1[0] = PKW(P0, 8), pw1[1] = PKW(P0, 10), pw1); \
    VRD(5); SBAR(); GAPA(C1 = __builtin_amdgcn_mfma_f32_32x32x16_bf16(kf[3], qr[1], C1, 0, 0, 0),   P0[14], P0[15], P1[0], P1[1],   pw1[2] = PKW(P0, 12), pw1[3] = PKW(P0, 14), pw1); \
    VRD(2); SBAR(); GAPA(C0 = __builtin_amdgcn_mfma_f32_32x32x16_bf16(kf[4], qr[2], C0, 0, 0, 0),   P1[2], P1[3], P1[4], P1[5],     pw2[0] = PKW(P1, 0), pw2[1] = PKW(P1, 2), pw2); \
    VRD(6); SBAR(); GAPA(C1 = __builtin_amdgcn_mfma_f32_32x32x16_bf16(kf[5], qr[2], C1, 0, 0, 0),   P1[6], P1[7], P1[8], P1[9],     pw2[2] = PKW(P1, 4), pw2[3] = PKW(P1, 6), pw2); \
    VRD(3); SBAR(); GAPA(C0 = __builtin_amdgcn_mfma_f32_32x32x16_bf16(kf[6], qr[3], C0, 0, 0, 0),   P1[10], P1[11], P1[12], P1[13], pw3[0] = PKW(P1, 8), pw3[1] = PKW(P1, 10), pw3); \
    VRD(7); SBAR(); GAPA(C1 = __builtin_amdgcn_mfma_f32_32x32x16_bf16(kf[7], qr[3], C1, 0, 0, 0),   P1[14], P1[15], 0.f, 0.f,       pw3[2] = PKW(P1, 12), pw3[3] = PKW(P1, 14), pw3); \
    l_reg += sacc; \
    if (GK) { DMA_K((t) + 3, sl_cur); } if (GV) { DMA_V((t) + 1, sl_next); } \
    CMASK(C0, C1, t); \
    if (!FIXED) { float a = MX3(C0[0], C0[1], C1[0]), b = MX3(C0[2], C0[3], C1[1]); a = MX3(a, C1[2], C1[3]); \
      _Pragma("unroll") for (int r = 4; r < 16; r += 4) { a = MX3(a, C0[r], C0[r + 1]); b = MX3(b, C0[r + 2], C0[r + 3]); a = MX3(a, C1[r], C1[r + 1]); b = MX3(b, C1[r + 2], C1[r + 3]); } \
      float rm = __builtin_fmaxf(a, b); { auto rr = __builtin_amdgcn_permlane32_swap(__float_as_uint(rm), __float_as_uint(rm), false, false); rm = __builtin_fmaxf(__uint_as_float(rr[0]), __uint_as_float(rr[1])); } \
      resc = false; \
      if (__builtin_expect(__any(rm > (float)THRL), 0)) { const float dl = __builtin_fmaxf(rm, 0.f); mhat += dl; \
        _Pragma("unroll") for (int r = 0; r < 16; ++r) { C0[r] -= dl; C1[r] -= dl; } \
        { const float nv_ = selc ? -mhat : -INFINITY; _Pragma("unroll") for (int r = 0; r < 16; ++r) negm[r] = nv_; } asm volatile("" : "+v"(negm)); \
        const float f = __builtin_amdgcn_exp2f(-dl); l_reg *= f; if (hi == 0) wsf[r32] = f; resc = true; } } \
    SBAR(); \
    GAPB(o[0] = __builtin_amdgcn_mfma_f32_32x32x16_bf16(PAF(0), VFR(0), o[0], 0, 0, 0), C0, 0); \
    GAPB(o[1] = __builtin_amdgcn_mfma_f32_32x32x16_bf16(PAF(0), VFR(4), o[1], 0, 0, 0), C0, 4); \
    KRD(GL, 0); GAPB(o[0] = __builtin_amdgcn_mfma_f32_32x32x16_bf16(PAF(1), VFR(1), o[0], 0, 0, 0), C0, 8); \
    KRD(GL, 1); GAPB(o[1] = __builtin_amdgcn_mfma_f32_32x32x16_bf16(PAF(1), VFR(5), o[1], 0, 0, 0), C0, 12); \
    KRD(GL, 2); GAPB(o[0] = __builtin_amdgcn_mfma_f32_32x32x16_bf16(PAF(2), VFR(2), o[0], 0, 0, 0), C1, 0); \
    KRD(GL, 3); GAPB(o[1] = __builtin_amdgcn_mfma_f32_32x32x16_bf16(PAF(2), VFR(6), o[1], 0, 0, 0), C1, 4); \
    GAPB(o[0] = __builtin_amdgcn_mfma_f32_32x32x16_bf16(PAF(3), VFR(3), o[0], 0, 0, 0), C1, 8); \
    GAPB(o[1] = __builtin_amdgcn_mfma_f32_32x32x16_bf16(PAF(3), VFR(7), o[1], 0, 0, 0), C1, 12); \
    } while (0)
#define NEWBLK(t) do { if (MOBA && (((t) & 3) == 0)) SETNEG((t) >> 2); } while (0)
    int t = 1;
    if (MOBA) {
        for (; t + 5 < NT; t += 2) {
#undef CMASK
#define CMASK(P0, P1, t) do { } while (0)
            STEP(pB0, pB1, pA0, pA1, t, true, true, true);       WAIT_BAR(2); RESC(); ROT(); NEWBLK(t + 1);
            STEP(pA0, pA1, pB0, pB1, t + 1, true, true, true);   WAIT_BAR(2); RESC(); ROT();
        }
    }
#undef CMASK
#define CMASK(P0, P1, t) do { if ((t) >= tmlo) bmask(P0, P1, D0 - 64 * ((t) - toff), mlim); } while (0)
#define ENDW(tt) do { if ((tt) + 3 < NT) { WAIT_BAR(2); } else if ((tt) + 2 < NT) { WAIT_BAR(1); } else { WAIT_BAR(0); } } while (0)
    for (; t + 1 < NT; t += 2) {
        STEP(pB0, pB1, pA0, pA1, t, (t + 3 < NT), (t + 1 < NT), (t + 1 < NT));       ENDW(t);     RESC(); ROT(); NEWBLK(t + 1);
        STEP(pA0, pA1, pB0, pB1, t + 1, (t + 4 < NT), (t + 2 < NT), (t + 2 < NT));   ENDW(t + 1); RESC(); ROT();
    }
    STEP(pB0, pB1, pA0, pA1, NT - 1, false, false, false); RESC();
    { float sacc = pB0[0] + pB0[1];
#pragma unroll
      for (int r = 2; r < 16; ++r) sacc += pB0[r];
#pragma unroll
      for (int r = 0; r < 16; ++r) sacc += pB1[r];
      l_reg += sacc;
      pw0 = (u32x4){PKW(pB0, 0), PKW(pB0, 2), PKW(pB0, 4), PKW(pB0, 6)}; pw1 = (u32x4){PKW(pB0, 8), PKW(pB0, 10), PKW(pB0, 12), PKW(pB0, 14)};
      pw2 = (u32x4){PKW(pB1, 0), PKW(pB1, 2), PKW(pB1, 4), PKW(pB1, 6)}; pw3 = (u32x4){PKW(pB1, 8), PKW(pB1, 10), PKW(pB1, 12), PKW(pB1, 14)};
      SBAR(); pv(o, vb0 + sl_cur, PAF(0), PAF(1), PAF(2), PAF(3)); }
    l_out = l_reg; m_out = mhat;
    asm volatile("s_waitcnt lgkmcnt(0)\n\ts_barrier" ::: "memory");
#undef DMA_K
#undef DMA_V
#undef CMASK
#undef SETNEG
#undef NEWBLK
#undef RESC
#undef ROT
#undef PKW
#undef PAF
#undef VFR
#undef PIN
#undef GAPA
#undef GAPB
#undef EX
#undef VRD
#undef KRD
#undef STEP
#undef ENDW
}

constexpr int BK_K = 0, BK_V = 6 * SLOTB, BK_Q = 12 * SLOTB, BK_WS = 16 * SLOTB, BK_OST = BK_WS + NW * 256, BK_BYTES = BK_OST + NW * 2048;
__device__ __forceinline__ int ring6(int t, int rot) { const int s_ = t + rot; return s_ >= 6 ? s_ - 6 : s_; }
__device__ __forceinline__ void band_issue_kq(const int tid, const Job& J, char* shm, const bool first, const bool cont, const int rot) {
    const int lane = tid & 63; const int wid = __builtin_amdgcn_readfirstlane(tid >> 6);
    const long rs = J.rs; const unsigned lds0 = (unsigned)(uintptr_t)shm;
    const int prow = 8 * wid + (lane >> 3), pch = (lane & 7) ^ (lane >> 3);
    const bf16* ksrc = J.K + (long)(J.q0 - 128 + prow) * rs + pch * 8;
    const unsigned kdst = lds0 + BK_K + wid * 1024;
#pragma unroll
    for (int t = 0; t < 6; ++t) { if (cont && t < 2) continue; const int ts = (first && t < 2) ? 2 : t; glds16(ksrc + (long)ts * KVBLK * rs, (unsigned)__builtin_amdgcn_readfirstlane(kdst + ring6(t, rot) * SLOTB)); }
    const bf16* qsrc = J.Q + (long)(J.q0 + prow) * rs + pch * 8;
    const unsigned qdst = lds0 + BK_Q + wid * 1024;
#pragma unroll
    for (int g = 0; g < 4; ++g) glds16_nt(qsrc + (long)g * KVBLK * rs, (unsigned)__builtin_amdgcn_readfirstlane(qdst + g * SLOTB));
}
__device__ __forceinline__ void band_issue_v(const int tid, const Job& J, char* shm, const bool first, const bool cont, const int rot) {
    const int lane = tid & 63; const int wid = __builtin_amdgcn_readfirstlane(tid >> 6);
    const long rs = J.rs; const unsigned lds0 = (unsigned)(uintptr_t)shm;
    const bf16* vsrc = J.V + (long)(J.q0 - 128 + 16 * (wid & 3) + (lane >> 2)) * rs + (wid >> 2) * 32 + (lane & 3) * 8;
    const unsigned vdst = lds0 + BK_V + wid * 1024;
#pragma unroll
    for (int t = 0; t < 6; ++t) { if (cont && t < 2) continue; const int ts = (first && t < 2) ? 2 : t; glds16(vsrc + (long)ts * KVBLK * rs, (unsigned)__builtin_amdgcn_readfirstlane(vdst + ring6(t, rot) * SLOTB)); }
}
__device__ __forceinline__ void band_pass1(const int tid, char* shm, const bool first, const bool cont  , const int rot, u32x4 (&pw)[5][2], float& l_out, float& m_out) {
    const int lane = tid & 63, r32 = lane & 31, hi = lane >> 5; const int wid = __builtin_amdgcn_readfirstlane(tid >> 6);
    const lds_cptr shm3 = (lds_cptr)shm;
    int foff[4];
#pragma unroll
    for (int d0 = 0; d0 < 4; ++d0) foff[d0] = r32 * 128 + (((2 * d0 + hi) ^ (r32 & 7)) * 16);
    const lds_cptr kp0 = shm3 + BK_K;
    if (cont) asm volatile("s_waitcnt vmcnt(4)" ::: "memory"); else asm volatile("s_waitcnt vmcnt(6)" ::: "memory");
    asm volatile("s_waitcnt lgkmcnt(0)\n\ts_barrier" ::: "memory");
    bf16x8 qr[4];
    { const lds_cptr qp = shm3 + BK_Q + (wid >> 1) * SLOTB + (wid & 1) * 4096;
#pragma unroll
      for (int d0 = 0; d0 < 4; ++d0) qr[d0] = *(const __attribute__((address_space(3))) bf16x8*)(qp + foff[d0]); }
    f32x16 p[5];
#pragma unroll
    for (int j = 0; j < 5; ++j) {
        const int s = wid + j;
        if (first && s < 4) {
#pragma unroll
            for (int r = 0; r < 16; ++r) p[j][r] = -INFINITY;
        } else {
            const lds_cptr kp = kp0 + ring6(s >> 1, rot) * SLOTB + (s & 1) * 4096;
            bf16x8 kf[4];
#pragma unroll
            for (int d0 = 0; d0 < 4; ++d0) kf[d0] = *(const __attribute__((address_space(3))) bf16x8*)(kp + foff[d0]);
            f32x16 q = __builtin_amdgcn_mfma_f32_32x32x16_bf16(kf[0], qr[0], f32x16{}, 0, 0, 0);
            q = __builtin_amdgcn_mfma_f32_32x32x16_bf16(kf[1], qr[1], q, 0, 0, 0);
            q = __builtin_amdgcn_mfma_f32_32x32x16_bf16(kf[2], qr[2], q, 0, 0, 0);
            p[j] = __builtin_amdgcn_mfma_f32_32x32x16_bf16(kf[3], qr[3], q, 0, 0, 0);
        }
    }
#pragma unroll
    for (int r = 0; r < 16; ++r) { if (crow(r, hi) < r32) p[0][r] = -INFINITY; if (crow(r, hi) > r32) p[4][r] = -INFINITY; }
    float rm;
    { float a = MX3(p[0][0], p[0][1], p[0][2]);
#pragma unroll
      for (int j = 0; j < 5; ++j)
#pragma unroll
          for (int r = (j == 0 ? 3 : 0); r + 1 < 16; r += 2) a = MX3(a, p[j][r], p[j][r + 1]);
      a = __builtin_fmaxf(a, p[0][15]);
      auto rr = __builtin_amdgcn_permlane32_swap(__float_as_uint(a), __float_as_uint(a), false, false); rm = __builtin_fmaxf(__uint_as_float(rr[0]), __uint_as_float(rr[1])); }
    float mhat = 0.f;
    if (__builtin_expect(__any(rm > (float)THRL), 0)) { mhat = __builtin_fmaxf(rm, 0.f);
#pragma unroll
        for (int j = 0; j < 5; ++j)
#pragma unroll
            for (int r = 0; r < 16; ++r) p[j][r] -= mhat; }
    float l_reg = 0.f;
#pragma unroll
    for (int j = 0; j < 5; ++j) {
        float sacc = 0.f;
#pragma unroll
        for (int r = 0; r < 16; ++r) { p[j][r] = __builtin_amdgcn_exp2f(p[j][r]); sacc += p[j][r]; }
        l_reg += sacc;
        pw[j][0] = (u32x4){cvtpk_s(p[j][0], p[j][1]), cvtpk_s(p[j][2], p[j][3]), cvtpk_s(p[j][4], p[j][5]), cvtpk_s(p[j][6], p[j][7])};
        pw[j][1] = (u32x4){cvtpk_s(p[j][8], p[j][9]), cvtpk_s(p[j][10], p[j][11]), cvtpk_s(p[j][12], p[j][13]), cvtpk_s(p[j][14], p[j][15])};
    }
    l_out = l_reg; m_out = mhat;
    asm volatile("s_waitcnt lgkmcnt(0)\n\ts_barrier" ::: "memory");
}
__device__ __forceinline__ void band_pass2(const int tid, char* shm, const bool first, const bool last_unit, const bool cont_next  , const int rot, const u32x4 (&pw)[5][2], f32x16 (&o)[2]) {
    const int lane = tid & 63, hi = lane >> 5; const int wid = __builtin_amdgcn_readfirstlane(tid >> 6);
    const lds_cptr shm3 = (lds_cptr)shm;
    const lds_cptr vp0 = shm3 + BK_V + ((lane >> 4) & 1) * 32 + (lane & 3) * 8 + (4 * hi + ((lane & 15) >> 2)) * 64;
    if (last_unit) asm volatile("s_waitcnt vmcnt(0)" ::: "memory"); else if (cont_next) asm volatile("s_waitcnt vmcnt(8)" ::: "memory"); else asm volatile("s_waitcnt vmcnt(10)" ::: "memory");
    asm volatile("s_waitcnt lgkmcnt(0)\n\ts_barrier" ::: "memory");
    o[0] = f32x16{}; o[1] = f32x16{};
#pragma unroll
    for (int j = 0; j < 5; ++j) {
        const int s = wid + j;
        if (first && s < 4) continue;
        const lds_cptr vp = vp0 + ring6(s >> 1, rot) * SLOTB + (s & 1) * 2048;
#pragma unroll
        for (int d0 = 0; d0 < 2; ++d0) {
            const s16x4 l0 = vtr(vp + d0 * 4096), h0 = vtr(vp + d0 * 4096 + 512), l1 = vtr(vp + d0 * 4096 + 1024), h1 = vtr(vp + d0 * 4096 + 1024 + 512);
            const bf16x8 v0 = (bf16x8){l0[0], l0[1], l0[2], l0[3], h0[0], h0[1], h0[2], h0[3]}, v1 = (bf16x8){l1[0], l1[1], l1[2], l1[3], h1[0], h1[1], h1[2], h1[3]};
            o[d0] = __builtin_amdgcn_mfma_f32_32x32x16_bf16(__builtin_bit_cast(bf16x8, pw[j][0]), v0, o[d0], 0, 0, 0);
            o[d0] = __builtin_amdgcn_mfma_f32_32x32x16_bf16(__builtin_bit_cast(bf16x8, pw[j][1]), v1, o[d0], 0, 0, 0);
        }
    }
    asm volatile("s_waitcnt lgkmcnt(0)\n\ts_barrier" ::: "memory");
}
#undef SBAR
#undef WAIT_BAR
#undef MX3
}

constexpr int NWAVES = 8;
constexpr size_t MiB = 1u << 20;
constexpr size_t WS_CTL = 0, CTL_ZERO_BYTES = 1 * MiB;
constexpr size_t WS_ROPE = 1 * MiB;
constexpr size_t WS_SS = 2 * MiB;
constexpr size_t SS_B_OFF = (size_t)MTOK * 4;
constexpr size_t WS_KMEAN = 4 * MiB;
constexpr size_t WS_STAT = 5 * MiB;
constexpr size_t WS_EDGE = 16 * MiB;
constexpr size_t WS_W = 32 * MiB;
constexpr size_t W_QKVA = 0, W_OA = W_QKVA + (size_t)9216 * 1024, W_UP0 = W_OA + (size_t)1024 * 1024, W_DN0 = W_UP0 + (size_t)NUP * 1024,
                 W_QKVB = W_DN0 + (size_t)1024 * DFF, W_OB = W_QKVB + (size_t)3072 * 1024, W_UP1 = W_OB + (size_t)1024 * 1024, W_DN1 = W_UP1 + (size_t)NUP * 1024,
                 W_END = W_DN1 + (size_t)1024 * DFF;
static_assert(W_END * 2 <= 64 * MiB, "weights fit 64 MiB");
constexpr size_t WS_XN = 96 * MiB;
constexpr size_t WS_Q = 160 * MiB, WS_K = 224 * MiB, WS_V = 288 * MiB, WS_ATT = 352 * MiB;
constexpr size_t WS_HH = 160 * MiB;
constexpr size_t WS_END = 416 * MiB;
static_assert(WS_HH + (size_t)MTOK * DFF * 2 <= WS_ATT, "Hh overlay");

constexpr int RING_BYTES = 131072, XLDS_OFF = RING_BYTES, XLDS_BYTES = XL_END, LDS_BYTES = 163840;
static_assert(attn::LDS_BYTES <= RING_BYTES && attn::BK_BYTES <= LDS_BYTES - 64 && XLDS_OFF + XLDS_BYTES <= LDS_BYTES, "LDS map");

struct Args { const float* in[15]; float* out; unsigned char* ws; int ph_lo, ph_hi; };
static_assert(sizeof(Args) == 15 * 8 + 8 + 8 + 8, "no padding");

__device__ __forceinline__ unsigned f2bf(float f) { unsigned u = __builtin_bit_cast(unsigned, f); return (u + 0x7fffu + ((u >> 16) & 1u)) >> 16; }
__device__ __forceinline__ unsigned pk2(float lo, float hi) { return f2bf(lo) | (f2bf(hi) << 16); }
__device__ __forceinline__ float wave_sum(float v) {
#pragma unroll
    for (int o = 1; o < 64; o <<= 1) v += __shfl_xor(v, o);
    return v;
}
__device__ __forceinline__ int dinv(int d) { return (d < 4) ? d : (d < 8) ? d + 4 : (d < 12) ? d - 4 : d; }
__device__ __forceinline__ int tileperm(int which_is_qk, int h, int d) { const int p = (which_is_qk && d < 16) ? dinv(d) : d; return (h >> 2) * 256 + (p >> 5) * 128 + (h & 3) * 32 + (p & 31); }
template <int KIND> __device__ __forceinline__ int permrow(int n) {
    if (KIND == 1) { const int which = n / 3072, g = (n % 3072) / 1024, h = (n % 1024) / 64, d = n % 64; return g * 3072 + which * 1024 + tileperm(which < 2, h, d); }
    if (KIND == 2) { const int which = n / 1024, h = (n % 1024) / 64, d = n % 64; return which * 1024 + tileperm(which < 2, h, d); }
    if (KIND == 3) { const int isval = n >= DFF, j = n - isval * DFF; return 256 * (j >> 7) + 128 * isval + (j & 127); }
    return n;
}
template <int KIND> __device__ __forceinline__ void transpose_item(const float* W, int K, int N, bf16* WT, LAS float* scr, int item, int lane, const float* gk = nullptr) {
    const int nblk = N / 32, kb = item / nblk, nb = item % nblk, k0 = 64 * kb, n0 = 32 * nb;
    float wv[32];
#pragma unroll
    for (int i = 0; i < 32; ++i) wv[i] = __builtin_nontemporal_load(&W[(size_t)(k0 + 2 * i + (lane >> 5)) * N + n0 + (lane & 31)]);
#pragma unroll
    for (int i = 0; i < 32; ++i) scr[(2 * i + (lane >> 5)) * 33 + (lane & 31)] = wv[i];
    asm volatile("s_waitcnt lgkmcnt(0)" ::: "memory");
    const int c = lane & 7;
    f32x4 ga = (f32x4){1.f, 1.f, 1.f, 1.f}, gb = ga;
    if (gk) { ga = *(const f32x4*)(gk + k0 + 8 * c); gb = *(const f32x4*)(gk + k0 + 8 * c + 4); }
#pragma unroll
    for (int j = 0; j < 4; ++j) { const int n = (lane >> 3) + 8 * j; const LAS float* s = scr + (8 * c) * 33 + n;
        u32x4 o; o.x = pk2(s[0 * 33] * ga[0], s[1 * 33] * ga[1]); o.y = pk2(s[2 * 33] * ga[2], s[3 * 33] * ga[3]); o.z = pk2(s[4 * 33] * gb[0], s[5 * 33] * gb[1]); o.w = pk2(s[6 * 33] * gb[2], s[7 * 33] * gb[3]);
        *(u32x4*)(WT + (size_t)permrow<KIND>(n0 + n) * K + k0 + 8 * c) = o; }
    asm volatile("s_waitcnt lgkmcnt(0)" ::: "memory");
}

template <class T> __device__ __forceinline__ T* uptr(T* p) {
    const unsigned long long v = (unsigned long long)p; const unsigned lo = __builtin_amdgcn_readfirstlane((unsigned)v), hi = __builtin_amdgcn_readfirstlane((unsigned)(v >> 32));
    return (T*)(__attribute__((address_space(1))) T*)(((unsigned long long)hi << 32) | lo); }
struct Frame {
    LAS unsigned char* lds; char* lds_generic;
    int tid, wave, vcu, bx, G;
    unsigned long long karg; float* out; unsigned char* ws;
    __device__ __forceinline__ const float* inp(int k) const {
        typedef unsigned long long __attribute__((address_space(4))) const* kp_t;
        return (const float*)(const __attribute__((address_space(1))) float*)(((kp_t)karg)[k]); }
};
#define FLANE (F.tid & 63)

__device__ __forceinline__ void phase_prologue(Frame& F) {
    LAS float* scr = (LAS float*)(F.lds + F.wave * 16384);
    const int gw = F.vcu * NWAVES + F.wave, NGW = F.G * NWAVES;
    bf16* WB = (bf16*)(F.ws + WS_W);
    constexpr int I_QKVA = 16 * (9216 / 32), I_O = 16 * 32, I_UP = 16 * (NUP / 32), I_DN = (DFF / 64) * 32, I_QKVB = 16 * (3072 / 32);
    constexpr int NITEMS = I_QKVA + I_O + I_UP + I_DN + I_QKVB + I_O + I_UP + I_DN;
    for (int it = gw; it < NITEMS; it += NGW) {
        int r = it;
        if (r < I_QKVA) { transpose_item<1>(F.inp(2), 1024, 9216, WB + W_QKVA, scr, r, FLANE, F.inp(1)); continue; } r -= I_QKVA;
        if (r < I_O) { transpose_item<0>(F.inp(5), 1024, 1024, WB + W_OA, scr, r, FLANE); continue; } r -= I_O;
        if (r < I_UP) { transpose_item<3>(F.inp(11), 1024, NUP, WB + W_UP0, scr, r, FLANE, F.inp(10)); continue; } r -= I_UP;
        if (r < I_DN) { transpose_item<0>(F.inp(14), DFF, 1024, WB + W_DN0, scr, r, FLANE); continue; } r -= I_DN;
        if (r < I_QKVB) { transpose_item<2>(F.inp(6), 1024, 3072, WB + W_QKVB, scr, r, FLANE, F.inp(1) + 1024); continue; } r -= I_QKVB;
        if (r < I_O) { transpose_item<0>(F.inp(9), 1024, 1024, WB + W_OB, scr, r, FLANE); continue; } r -= I_O;
        if (r < I_UP) { transpose_item<3>(F.inp(11) + (size_t)1024 * NUP, 1024, NUP, WB + W_UP1, scr, r, FLANE, F.inp(10) + 1024); continue; } r -= I_UP;
        transpose_item<0>(F.inp(14) + (size_t)DFF * 1024, DFF, 1024, WB + W_DN1, scr, r, FLANE);
    }
    { float* km = (float*)(F.ws + WS_KMEAN); for (int i = (F.vcu * NWAVES + F.wave) * 64 + FLANE; i < BATCH * NHEADS * 16 * 64; i += F.G * NWAVES * 64) km[i] = 0.f; }
    {
        float* cosT = (float*)(F.ws + WS_ROPE); float* sinT = cosT + SEQ * 8;
        const int gt = (F.vcu * NWAVES + F.wave) * 64 + FLANE;
        if (gt < SEQ * 8) { const int pos = gt >> 3, i = gt & 7;
            const float inv = (i == 0) ? 1.0f : (i == 1) ? 1.939227432e-01f : (i == 2) ? 3.760603070e-02f : (i == 3) ? 7.292664610e-03f : (i == 4) ? 1.414213562e-03f : (i == 5) ? 2.742481884e-04f : (i == 6) ? 5.318295734e-05f : 1.031338525e-05f;
            const float ang = (float)pos * inv; cosT[gt] = cosf(ang); sinT[gt] = sinf(ang); }
    }
    {
        const float* x = F.inp(0); bf16* XN = (bf16*)(F.ws + WS_XN); float* SS = (float*)(F.ws + WS_SS);
        for (int m0 = gw * 4; m0 < MTOK; m0 += NGW * 4) {
            f32x4 v[4][4]; float s[4];
#pragma unroll
            for (int r = 0; r < 4; ++r) { const f32x4* xr = (const f32x4*)(x + (size_t)(m0 + r) * DMODEL) + FLANE;
#pragma unroll
                for (int j = 0; j < 4; ++j) v[r][j] = __builtin_nontemporal_load(&xr[64 * j]); }
#pragma unroll
            for (int r = 0; r < 4; ++r) { s[r] = (dot4(v[r][0]) + dot4(v[r][1])) + (dot4(v[r][2]) + dot4(v[r][3])); s[r] = wave_sum(s[r]); }
#pragma unroll
            for (int r = 0; r < 4; ++r) {
                unsigned long long* o8 = (unsigned long long*)(XN + (size_t)(m0 + r) * DMODEL) + FLANE;
#pragma unroll
                for (int j = 0; j < 4; ++j) { const f32x4 y = v[r][j]; o8[64 * j] = (unsigned long long)pk2(y[0], y[1]) | ((unsigned long long)pk2(y[2], y[3]) << 32); }
                if (FLANE == 0) { SS[m0 + r] = s[r]; SS[MTOK + m0 + r] = 0.f; }
            }
        }
    }
}

template <bool KMSUM> __device__ __forceinline__ void phase_gemm_qkv(Frame& F, const bf16* Wt, const float* qg, const float* kg) {
    Wt = uptr(Wt); qg = uptr(qg); kg = uptr(kg);
    pg8::Gemm g{(const bf16*)(F.ws + WS_XN), Wt, MTOK, 3072, 1024}; pg8::StaticOrder S; S.init(MTOK, 3072, F.G, F.bx);
    const float* cosT = (const float*)(F.ws + WS_ROPE);
    EpiQKV<KMSUM> E{(float*)(F.ws + WS_KMEAN), (bf16*)(F.ws + WS_Q), (WS_K - WS_Q) / 2, (const float*)(F.ws + WS_SS), qg, kg, cosT, cosT + SEQ * 8};
    static_assert(WS_V - WS_K == WS_K - WS_Q, "Q|K|V equally spaced");
    pg8::gemm_phase<EpiQKV<KMSUM>, pg8::StaticOrder>(F.tid, F.lds, F.lds + XLDS_OFF, g, S, E);
}
__device__ __forceinline__ void fixup_tile(Frame& F, const int pm, const float* cw, const float* cb);
template <bool RES_F32, bool OUT_F32, bool FIX = false> __device__ __forceinline__ void phase_gemm_res(Frame& F, const bf16* A, const bf16* Wt, int K, const void* resid, void* out, bool has_ss, size_t ssoff, const float* cw = nullptr, const float* cb = nullptr) {
    A = uptr(A); Wt = uptr(Wt); resid = (const void*)uptr((const char*)resid); out = (void*)uptr((char*)out); K = __builtin_amdgcn_readfirstlane(K);
    pg8::Gemm g{A, Wt, MTOK, 1024, K}; pg8::StaticOrder S; S.init(MTOK, 1024, F.G, F.bx);
    if (FIX) {
        const int gt = (F.vcu * NWAVES + F.wave) * 64 + FLANE, NT = F.G * NWAVES * 64;
        { float* ssb = (float*)(F.ws + WS_SS + SS_B_OFF); for (int i = gt; i < MTOK; i += NT) ssb[i] = 0.f; }
        cw = uptr(cw); cb = uptr(cb);
        for (int i = 0; ; ++i) { pg8::Unit u; if (!S.next(i, u)) break; fixup_tile(F, u.pm, cw, cb); }
        asm volatile("s_waitcnt vmcnt(0)" ::: "memory"); __syncthreads();
    }
    EpiRes<RES_F32, OUT_F32> E{resid, out, has_ss ? (float*)(F.ws + WS_SS + ssoff) : nullptr};
    pg8::gemm_phase<EpiRes<RES_F32, OUT_F32>, pg8::StaticOrder>(F.tid, F.lds, F.lds + XLDS_OFF, g, S, E);
}
__device__ __forceinline__ void phase_gemm_up(Frame& F, const bf16* Wt, const float* cw, const float* cb) {
    Wt = uptr(Wt); cw = uptr(cw); cb = uptr(cb);
    pg8::Gemm g{(const bf16*)(F.ws + WS_XN), Wt, MTOK, NUP, 1024}; pg8::StaticOrder S; S.init(MTOK, NUP, F.G, F.bx);
    { const int gt = (F.vcu * NWAVES + F.wave) * 64 + FLANE, NT = F.G * NWAVES * 64; float* ssa = (float*)(F.ws + WS_SS); for (int i = gt; i < MTOK; i += NT) ssa[i] = 0.f; }
    EpiUpConv E{(const float*)(F.ws + WS_SS + SS_B_OFF), cw, cb, (bf16*)(F.ws + WS_HH), (float*)(F.ws + WS_EDGE)};
    pg8::gemm_phase<EpiUpConv, pg8::StaticOrder>(F.tid, F.lds, F.lds + XLDS_OFF, g, S, E);
}
__device__ __forceinline__ void fixup_tile(Frame& F, const int pm, const float* cw, const float* cb) {
    if ((pm & 15) == 0) return;
    const float* edge = (const float*)(F.ws + WS_EDGE); bf16* Hh = (bf16*)(F.ws + WS_HH);
    constexpr int NJ = DFF / 4;
    for (int it = F.tid; it < NJ; it += NWAVES * 64) {
        const int j = it * 4;
        const int pg = 256 * (j >> 7) + (j & 127);
        f32x4 uc[2][2];
#pragma unroll
        for (int bj = 0; bj < 2; ++bj) {
            const int lc = bj * DFF + j, pc = pg + bj * 128;
            const f32x4 w0 = *(const f32x4*)(cw + lc), w1 = *(const f32x4*)(cw + NUP + lc), w2 = *(const f32x4*)(cw + 2 * NUP + lc), bb = *(const f32x4*)(cb + lc);
            const float* ep = edge + (size_t)(pm - 1) * EDGE_ROWS * NUP + pc; const float* ec = edge + (size_t)pm * EDGE_ROWS * NUP + pc;
            const f32x4 u254 = *(const f32x4*)(ep + 2 * (size_t)NUP), u255 = *(const f32x4*)(ep + 3 * (size_t)NUP), u0 = *(const f32x4*)(ec), u1 = *(const f32x4*)(ec + NUP);
            uc[bj][0] = bb + w0 * u254 + w1 * u255 + w2 * u0;
            uc[bj][1] = bb + w0 * u255 + w1 * u0 + w2 * u1;
        }
#pragma unroll
        for (int r = 0; r < 2; ++r) {
            u32x2 w; w.x = pg8::cvt_pk_bf16(silu_mul(uc[0][r][0], uc[1][r][0]), silu_mul(uc[0][r][1], uc[1][r][1]));
            w.y = pg8::cvt_pk_bf16(silu_mul(uc[0][r][2], uc[1][r][2]), silu_mul(uc[0][r][3], uc[1][r][3]));
            *(u32x2*)(Hh + (size_t)(pm * 256 + r) * DFF + j) = w;
        }
    }
}
__device__ __forceinline__ void phase_kmean(Frame& F) {
    const bf16* Kb = (const bf16*)(F.ws + WS_K); float* KM = (float*)(F.ws + WS_KMEAN);
    const int gw = F.vcu * NWAVES + F.wave, NGW = F.G * NWAVES;
    { float* ssb = (float*)(F.ws + WS_SS + SS_B_OFF); for (int i = gw * 64 + FLANE; i < MTOK; i += NGW * 64) ssb[i] = 0.f; }
    for (int task = gw; task < BATCH * NHEADS * 16; task += NGW) {
        const int b = task >> 8, h = (task >> 4) & 15, n = task & 15;
        const int sub = FLANE >> 3, ch = FLANE & 7;
        const bf16* base = Kb + (size_t)(b * SEQ + n * 256 + sub) * DMODEL + h * 64 + ch * 8;
        float a[8];
#pragma unroll
        for (int e = 0; e < 8; ++e) a[e] = 0.f;
#pragma unroll 8
        for (int i = 0; i < 32; ++i) {
            const u32x4 v = *(const u32x4*)(base + (size_t)i * 8 * DMODEL);
#pragma unroll
            for (int e = 0; e < 4; ++e) { a[2 * e] += __uint_as_float(v[e] << 16); a[2 * e + 1] += __uint_as_float(v[e] & 0xffff0000u); }
        }
#pragma unroll
        for (int e = 0; e < 8; ++e) { a[e] += __shfl_xor(a[e], 8); a[e] += __shfl_xor(a[e], 16); a[e] += __shfl_xor(a[e], 32); a[e] *= (1.0f / 256.0f); }
        if (sub == 0) { float* o = KM + (size_t)task * 64 + ch * 8; *(f32x4*)o = (f32x4){a[0], a[1], a[2], a[3]}; *(f32x4*)(o + 4) = (f32x4){a[4], a[5], a[6], a[7]}; }
    }
}
template <int OUT> __device__ __forceinline__ void band_job(Frame& F, int i, int dil, int gidx, attn::Job& J, bool& first) {
    const bf16* Q = (const bf16*)(F.ws + WS_Q); const bf16* K = (const bf16*)(F.ws + WS_K); const bf16* V = (const bf16*)(F.ws + WS_V);
    bf16* num0 = (bf16*)F.out; bf16* num1 = (bf16*)F.out + (size_t)MTOK * DMODEL;
    float* st0 = (float*)(F.ws + WS_STAT); float* st1 = (float*)(F.ws + WS_STAT) + (size_t)MTOK * 32;
    const int u = F.vcu * 8 + i;
    const int nblk = 16 / dil;
    const int bh = u >> 4, b = bh >> 4, h = bh & 15, sub = u & 15, r = sub / nblk, blk = sub % nblk;
    const size_t tok0 = (size_t)b * SEQ + r;
    J.Q = Q + tok0 * DMODEL + h * 64; J.K = K + tok0 * DMODEL + h * 64; J.V = V + tok0 * DMODEL + h * 64;
    J.rs = (long)dil * DMODEL; J.q0 = 256 * blk; J.k0 = J.q0 - 128; J.NT = 6; J.ob = 0; J.kmean = nullptr;
    J.srs = (long)dil * 32;
    J.O = ((OUT == attn::OUT_MERGE) ? (bf16*)(F.ws + WS_ATT) : (gidx == 0 ? num0 : num1)) + tok0 * DMODEL + h * 64;
    J.stat = (OUT == attn::OUT_PART) ? (gidx == 0 ? st0 : st1) + (tok0 * 16 + h) * 2 : nullptr;
    J.num0 = num0 + tok0 * DMODEL + h * 64; J.num1 = num1 + tok0 * DMODEL + h * 64;
    J.stat0 = st0 + (tok0 * 16 + h) * 2; J.stat1 = st1 + (tok0 * 16 + h) * 2;
    first = (blk == 0);
}
template <int OUT> __device__ __forceinline__ void phase_band(Frame& F, int dil, int gidx) {
    if (F.vcu * 8 >= BATCH * NHEADS * 16) return;
    attn::Job J; bool first;
    band_job<OUT>(F, 0, dil, gidx, J, first);
    bool cont = false; int rot = 0;
    { int t_ = F.tid; asm volatile("" : "+v"(t_)); attn::band_issue_kq(t_, J, F.lds_generic, first, false, 0); attn::band_issue_v(t_, J, F.lds_generic, first, false, 0); }
    for (int i = 0; i < 8; ++i) {
        int t_ = F.tid; asm volatile("" : "+v"(t_));
        float l_reg, mhat; attn::f32x16 o[2]; attn::u32x4 pw[5][2];
        attn::band_pass1(t_, F.lds_generic, first, cont, rot, pw, l_reg, mhat);
        attn::Job Jn = J; bool firstn = first;
        bool contn = false; int rotn = 0;
        if (i + 1 < 8) { band_job<OUT>(F, i + 1, dil, gidx, Jn, firstn);
            contn = !firstn;
            rotn = contn ? (rot >= 2 ? rot - 2 : rot + 4) : 0;
            attn::band_issue_kq(t_, Jn, F.lds_generic, firstn, contn, rotn); }
        attn::band_pass2(t_, F.lds_generic, first, i == 7, contn, rot, pw, o);
        if (i + 1 < 8) attn::band_issue_v(t_, Jn, F.lds_generic, firstn, contn, rotn);
        { const int lane = t_ & 63, wid = __builtin_amdgcn_readfirstlane(t_ >> 6);
          attn::unit_epilogue<OUT>(J, (float*)(F.lds_generic + attn::BK_WS) + wid * 64, (unsigned short*)(F.lds_generic + attn::BK_OST) + wid * 1024, wid, lane, l_reg, mhat, o); }
        J = Jn; first = firstn; cont = contn; rot = rotn;
    }
}
__device__ __forceinline__ void moba_job(Frame& F, int i, attn::Job& J) {
    const bf16* Q = (const bf16*)(F.ws + WS_Q); const bf16* K = (const bf16*)(F.ws + WS_K); const bf16* V = (const bf16*)(F.ws + WS_V);
    const int bh = F.vcu >> 1, b = bh >> 4, h = bh & 15;
    const int s = (F.vcu & 1) * 4 + (i >> 1), ob = (i & 1) ? 15 - s : s;
    const size_t tok0 = (size_t)b * SEQ;
    J.Q = Q + tok0 * DMODEL + h * 64; J.K = K + tok0 * DMODEL + h * 64; J.V = V + tok0 * DMODEL + h * 64;
    J.rs = DMODEL; J.q0 = 256 * ob; J.k0 = 0; J.NT = 4 * (ob + 1); J.ob = ob; J.kmean = (const float*)(F.ws + WS_KMEAN) + (size_t)bh * 16 * 64;
    J.O = (bf16*)(F.ws + WS_ATT) + tok0 * DMODEL + h * 64; J.stat = nullptr; J.num0 = J.num1 = nullptr; J.stat0 = J.stat1 = nullptr; J.srs = 32;
}
__device__ __forceinline__ void phase_moba(Frame& F) {
    if ((F.vcu >> 1) >= BATCH * NHEADS) return;
    float gq = __builtin_fabsf(F.inp(7)[FLANE]), gk = __builtin_fabsf(F.inp(8)[FLANE]);
#pragma unroll
    for (int o_ = 1; o_ < 64; o_ <<= 1) { gq = __builtin_fmaxf(gq, __shfl_xor(gq, o_)); gk = __builtin_fmaxf(gk, __shfl_xor(gk, o_)); }
    const float kbound = 8.0f * 1.02f * gk;
    const bool fixed_ok = (QSCALE * 8.0f * 1.02f * gq * kbound) <= 60.0f;
    attn::Job J; moba_job(F, 0, J); J.kbound = kbound;
    { int t_ = F.tid; asm volatile("" : "+v"(t_)); attn::ring_issue(t_, J, F.lds_generic); }
    for (int i = 0; i < 8; ++i) {
        int t_ = F.tid; asm volatile("" : "+v"(t_));
        float l_reg, mhat; attn::f32x16 o[2];
        if (fixed_ok) attn::attn_unit<true, true>(t_, J, F.lds_generic, l_reg, mhat, o); else attn::attn_unit<true, false>(t_, J, F.lds_generic, l_reg, mhat, o);
        attn::Job Jn = J;
        if (i + 1 < 8) { moba_job(F, i + 1, Jn); attn::ring_issue(t_, Jn, F.lds_generic); }
        { const int lane = t_ & 63, wid = __builtin_amdgcn_readfirstlane(t_ >> 6);
          attn::unit_epilogue<attn::OUT_FINAL>(J, (float*)(F.lds_generic + attn::LDS_WS) + wid * 64, (unsigned short*)(F.lds_generic + attn::LDS_OST) + wid * 1024, wid, lane, l_reg, mhat, o); }
        J = Jn;
    }
}

#define XB_TMO      128
#define XB_XCNT(j)  (256  + 64 * (j))
#define XB_XSUB(j)  (1280 + 64 * (j))
#define XB_XGEN(j)  (2304 + 64 * (j))
#define XB_TOP      3328
#define XB_TOPGEN   3392
#define XCD_BAR_WORDS 3456
#define XB_SPIN_CAP (1u << 18)

__device__ __forceinline__ unsigned xb_ld(unsigned* p)              { return __hip_atomic_load(p, __ATOMIC_RELAXED, __HIP_MEMORY_SCOPE_AGENT); }
__device__ __forceinline__ unsigned xb_add(unsigned* p, unsigned v) { return __hip_atomic_fetch_add(p, v, __ATOMIC_RELAXED, __HIP_MEMORY_SCOPE_AGENT); }
__device__ __forceinline__ unsigned xb_xcc_id() { return (unsigned)__builtin_amdgcn_s_getreg((3 << 11) | 20) & 0xFu; }
#define XB_SPIN(cond, bar) do { unsigned _sp = 0; while (cond) { __builtin_amdgcn_s_sleep(1); \
    if ((++_sp & 255u) == 0u) { if (xb_ld(&(bar)[XB_TMO])) break; if (_sp > XB_SPIN_CAP) { atomicAdd(&(bar)[XB_TMO], 1u); break; } } } } while (0)

struct XcdBarrier {
    unsigned* bar; unsigned x;
    volatile LAS unsigned* st;
};

__device__ __forceinline__ XcdBarrier xcd_barrier_post(unsigned* bar, volatile LAS unsigned* st, int tid) {
    XcdBarrier b; b.bar = bar; b.x = xb_xcc_id(); b.st = st;
    if (tid == 0) (void)xb_add(&bar[XB_XCNT(b.x)], 1u);
    return b;
}
__device__ __forceinline__ void xcd_barrier_complete(unsigned* bar, unsigned x, unsigned& nloc, unsigned& nx) {
    const unsigned G = gridDim.x * gridDim.y * gridDim.z;
    unsigned sum, cnt, mine, sp = 0u;
    for (;;) {
        sum = 0u; cnt = 0u; mine = 0u;
#pragma unroll
        for (unsigned j = 0; j < 16; ++j) { const unsigned c = xb_ld(&bar[XB_XCNT(j)]); sum += c; cnt += (c > 0u) ? 1u : 0u; mine = (j == x) ? c : mine; }
        if (sum == G) break;
        __builtin_amdgcn_s_sleep(1);
        if ((++sp & 255u) == 0u) { if (xb_ld(&bar[XB_TMO])) break; if (sp > XB_SPIN_CAP) { atomicAdd(&bar[XB_TMO], 1u); break; } }
    }
    nloc = mine > 0u ? mine : 1u; nx = cnt > 0u ? cnt : 1u;
}

__device__ __forceinline__ void xcd_barrier(const XcdBarrier& b, int tid) {
    asm volatile("s_waitcnt vmcnt(0)" ::: "memory");
    __syncthreads();
    if (tid == 0) {
        unsigned* bar = b.bar;
        __builtin_amdgcn_s_waitcnt(0);
        unsigned nloc = b.st[0], nx = b.st[1];
        if (nloc == 0u) { xcd_barrier_complete(bar, b.x, nloc, nx); b.st[0] = nloc; b.st[1] = nx; }
        const unsigned old = xb_add(&bar[XB_XSUB(b.x)], 1u);
        const unsigned gen = old / nloc;
        if (old + 1u == (gen + 1u) * nloc) {
            __builtin_amdgcn_fence(__ATOMIC_RELEASE, "agent");
            asm volatile("s_waitcnt vmcnt(0)" ::: "memory");
            const unsigned og = xb_add(&bar[XB_TOP], 1u);
            const unsigned tg = og / nx;
            if (og + 1u == (tg + 1u) * nx) xb_add(&bar[XB_TOPGEN], 1u);
            else XB_SPIN(xb_ld(&bar[XB_TOPGEN]) == tg, bar);
            __builtin_amdgcn_fence(__ATOMIC_ACQUIRE, "agent");
            xb_add(&bar[XB_XGEN(b.x)], 1u);
            asm volatile("s_waitcnt vmcnt(0)" ::: "memory");
        } else {
            XB_SPIN(xb_ld(&bar[XB_XGEN(b.x)]) == gen, bar);
            __builtin_amdgcn_fence(__ATOMIC_ACQUIRE, "agent");
            asm volatile("s_waitcnt vmcnt(0)" ::: "memory");
        }
    }
    __syncthreads();
}

constexpr int N_PHASES = 18;
constexpr int CW_BAR = 4096;
constexpr int BARST_OFF = XLDS_OFF + XLDS_BYTES;
static_assert(BARST_OFF + 64 <= LDS_BYTES && (CW_BAR + XCD_BAR_WORDS) * 4 <= (int)CTL_ZERO_BYTES, "barrier state placement");
__device__ __forceinline__ void frame_setup(Frame& F, int wave0, unsigned char* lds) {
    { int t_ = wave0 * 64 + fresh_lane(); asm volatile("" : "+v"(t_)); F.tid = t_; }
    { int b_ = blockIdx.x, g_ = gridDim.x; asm volatile("" : "+s"(b_), "+s"(g_)); F.bx = b_; F.G = g_; }
    F.wave = __builtin_amdgcn_readfirstlane(F.tid >> 6);
    F.vcu = (F.G % 8 == 0) ? (F.bx % 8) * (F.G / 8) + F.bx / 8 : F.bx;
    { unsigned long long k_ = (unsigned long long)__builtin_amdgcn_kernarg_segment_ptr(); asm volatile("" : "+s"(k_)); F.karg = k_; F.out = (float*)F.inp(15); F.ws = (unsigned char*)F.inp(16); }
    F.lds = (LAS unsigned char*)lds; F.lds_generic = (char*)lds;
}
template <int PH> __device__ __forceinline__ void run_phase(Frame& F) {
    const bf16* WB = (const bf16*)(F.ws + WS_W);
    const bf16* ATT = (const bf16*)(F.ws + WS_ATT); const bf16* HH = (const bf16*)(F.ws + WS_HH);
    constexpr int L = (PH >= 11) ? 1 : 0;
    if constexpr (PH == 0) phase_prologue(F);
    else if constexpr (PH == 1 || PH == 3 || PH == 5) { constexpr int g = PH >> 1; phase_gemm_qkv<false>(F, WB + W_QKVA + (size_t)g * 3072 * 1024, F.inp(3) + 64 * g, F.inp(4) + 64 * g); }
    else if constexpr (PH == 11) phase_gemm_qkv<true>(F, WB + W_QKVB, F.inp(7), F.inp(8));
    else if constexpr (PH == 2) phase_band<attn::OUT_PART>(F, 1, 0);
    else if constexpr (PH == 4) phase_band<attn::OUT_PART>(F, 4, 1);
    else if constexpr (PH == 6) phase_band<attn::OUT_MERGE>(F, 16, 2);
    else if constexpr (PH == 7) phase_gemm_res<false, false>(F, ATT, WB + W_OA, 1024, F.ws + WS_XN, F.ws + WS_XN, true, SS_B_OFF);
    else if constexpr (PH == 10) phase_gemm_res<false, false, true>(F, HH, WB + W_DN0, DFF, F.ws + WS_XN, F.ws + WS_XN, true, 0, F.inp(12), F.inp(13));
    else if constexpr (PH == 14) phase_gemm_res<false, false>(F, ATT, WB + W_OB, 1024, F.ws + WS_XN, F.ws + WS_XN, true, SS_B_OFF);
    else if constexpr (PH == 17) phase_gemm_res<false, true, true>(F, HH, WB + W_DN1, DFF, F.ws + WS_XN, F.out, false, 0, F.inp(12) + (size_t)3 * NUP, F.inp(13) + (size_t)NUP);
    else if constexpr (PH == 8 || PH == 15) phase_gemm_up(F, WB + (L ? W_UP1 : W_UP0), F.inp(12) + (size_t)L * 3 * NUP, F.inp(13) + (size_t)L * NUP);
    else if constexpr (PH == 13) phase_moba(F);
}
template <unsigned PHASE_MASK> __global__ void __launch_bounds__(NWAVES * 64, 2) fwd_kernel(const Args args) {
    extern __shared__ __attribute__((aligned(16))) unsigned char lds[];
    const int lo = args.ph_lo, hi = args.ph_hi;
    const int wave0 = __builtin_amdgcn_readfirstlane(threadIdx.x >> 6);
    constexpr bool FUSED = (PHASE_MASK & (PHASE_MASK - 1u)) != 0u;
    volatile LAS unsigned* bst = (volatile LAS unsigned*)((LAS unsigned char*)lds + BARST_OFF);
    XcdBarrier xb; xb.bar = nullptr; xb.x = 0; xb.st = bst;
    if constexpr (FUSED) {
        if (threadIdx.x < 16) bst[threadIdx.x] = 0u;
        __syncthreads();
        xb = xcd_barrier_post((unsigned*)(args.ws + WS_CTL) + CW_BAR, bst, (int)threadIdx.x);
    }
#define PHASE_FENCE() asm volatile("; phase boundary" ::: "v8", "v9", "v10", "v11", "v12", "v13", "v14", "v15", "v16", "v17", "v18", "v19", "v20", "v21", "v22", "v23", "v24", "v25", "v26", "v27", "v28", "v29", "v30", "v31", "v32", "v33", "v34", "v35", "v36", "v37", "v38", "v39", "v40", "v41", "v42", "v43", "v44", "v45", "v46", "v47", "v48", "v49", "v50", "v51", "v52", "v53", "v54", "v55", "v56", "v57", "v58", "v59", "v60", "v61", "v62", "v63", "v64", "v65", "v66", "v67", "v68", "v69", "v70", "v71", "v72", "v73", "v74", "v75", "v76", "v77", "v78", "v79", "v80", "v81", "v82", "v83", "v84", "v85", "v86", "v87", "v88", "v89", "v90", "v91", "v92", "v93", "v94", "v95", "v96", "v97", "v98", "v99", "v100", "v101", "v102", "v103", "v104", "v105", "v106", "v107", "v108", "v109", "v110", "v111", "v112", "v113", "v114", "v115", "v116", "v117", "v118", "v119", "v120", "v121", "v122", "v123", "v124", "v125", "v126", "v127", "v128", "v129", "v130", "v131", "v132", "v133", "v134", "v135", "v136", "v137", "v138", "v139", "v140", "v141", "v142", "v143", "v144", "v145", "v146", "v147", "v148", "v149", "v150", "v151", "v152", "v153", "v154", "v155", "v156", "v157", "v158", "v159", "v160", "v161", "v162", "v163", "v164", "v165", "v166", "v167", "v168", "v169", "v170", "v171", "v172", "v173", "v174", "v175", "v176", "v177", "v178", "v179", "v180", "v181", "v182", "v183", "v184", "v185", "v186", "v187", "v188", "v189", "v190", "v191", "v192", "v193", "v194", "v195", "v196", "v197", "v198", "v199", "v200", "v201", "v202", "v203", "v204", "v205", "v206", "v207", "v208", "v209", "v210", "v211", "v212", "v213", "v214", "v215", "v216", "v217", "v218", "v219", "v220", "v221", "v222", "v223", "v224", "v225", "v226", "v227", "v228", "v229", "v230", "v231", "v232", "v233", "v234", "v235", "v236", "v237", "v238", "v239", "v240", "v241", "v242", "v243", "v244", "v245", "v246", "v247", "v248", "v249", "v250", "v251", "v252", "v253", "v254", "v255", "s36", "s37", "s38", "s39", "s40", "s41", "s42", "s43", "s44", "s45", "s46", "s47", "s48", "s49", "s50", "s51", "s52", "s53", "s54", "s55", "s56", "s57", "s58", "s59", "s60", "s61", "s62", "s63", "s64", "s65", "s66", "s67", "s68", "s69", "s70", "s71", "s72", "s73", "s74", "s75", "s76", "s77", "s78", "s79", "s80", "s81", "s82", "s83", "s84", "s85", "s86", "s87", "s88", "s89", "s90", "s91", "s92", "s93", "s94", "s95", "s96", "s97", "s98", "s99", "s100", "s101", "memory")
#define TID_NOW() (wave0 * 64 + fresh_lane())
#ifndef PROBE_DUP
#define PROBE_DUP 0u
#endif
#ifndef MK_CG_FIRST
#define MK_CG_FIRST 0
#endif
#define PHASE(k) if constexpr (((PHASE_MASK >> (k)) & 1u) != 0u) { PHASE_FENCE(); if (lo <= (k) && (k) < hi) { { Frame F; frame_setup(F, wave0, lds); run_phase<(k)>(F); } \
        if constexpr (((PROBE_DUP >> (k)) & 1u) != 0u) { Frame F; frame_setup(F, wave0, lds); run_phase<(k)>(F); } \
        if constexpr (FUSED && (k) + 1 < N_PHASES) { if ((k) + 1 < hi) { if (MK_CG_FIRST && (k) == 0) cg::this_grid().sync(); else xcd_barrier(xb, TID_NOW()); } } } }
    PHASE(0) PHASE(1) PHASE(2) PHASE(3) PHASE(4) PHASE(5) PHASE(6) PHASE(7) PHASE(8) PHASE(10) PHASE(11) PHASE(13) PHASE(14) PHASE(15) PHASE(17)
#undef TID_NOW
#undef PHASE
}

constexpr unsigned PM_ALL = 0x3ffffu;
typedef void (*kern_t)(const Args);
#ifndef MK_SPLIT
#define MK_SPLIT 0
#endif
#if MK_SPLIT
static kern_t kernel_of_phase(int ph) {
    switch (ph) {
#define KP(k) case k: return fwd_kernel<(1u << k)>;
    KP(0) KP(1) KP(2) KP(3) KP(4) KP(5) KP(6) KP(7) KP(8) KP(9) KP(10) KP(11) KP(12) KP(13) KP(14) KP(15) KP(16)
#undef KP
    default: return fwd_kernel<(1u << 17)>;
    }
}
#endif
extern "C" void kernel_launch(void* const* d_in, const int* in_sizes, int n_in, void* d_out, int out_size, void* d_ws, size_t ws_size, hipStream_t stream) {
    static int grid = 0;
    if (grid == 0) {
        if (n_in != 15 || out_size != MTOK * DMODEL || ws_size < WS_END) { fprintf(stderr, "kernel_launch: unexpected shapes (n_in %d, out %d, ws %zu)\n", n_in, out_size, ws_size); grid = -1; return; }
        int dev = 0, cus = 0;
        if (hipGetDevice(&dev) != hipSuccess || hipDeviceGetAttribute(&cus, hipDeviceAttributeMultiprocessorCount, dev) != hipSuccess) { grid = -1; return; }
#if MK_SPLIT
        for (int ph = 0; ph < N_PHASES; ++ph)
            if (hipFuncSetAttribute((const void*)kernel_of_phase(ph), hipFuncAttributeMaxDynamicSharedMemorySize, LDS_BYTES) != hipSuccess) { fprintf(stderr, "kernel_launch: hipFuncSetAttribute failed\n"); grid = -1; return; }
#else
        if (hipFuncSetAttribute((const void*)fwd_kernel<PM_ALL>, hipFuncAttributeMaxDynamicSharedMemorySize, LDS_BYTES) != hipSuccess) { fprintf(stderr, "kernel_launch: hipFuncSetAttribute failed\n"); grid = -1; return; }
        int per_cu = 0;
        if (hipOccupancyMaxActiveBlocksPerMultiprocessor(&per_cu, (const void*)fwd_kernel<PM_ALL>, NWAVES * 64, LDS_BYTES) != hipSuccess || per_cu < 1) fprintf(stderr, "kernel_launch: occupancy query says %d blocks/CU\n", per_cu);
        (void)hipGetLastError();
#endif
        grid = cus;
    }
    if (grid < 0) return;
    Args a{};
    for (int i = 0; i < 15; ++i) a.in[i] = (const float*)d_in[i];
    a.out = (float*)d_out; a.ws = (unsigned char*)d_ws;
#if MK_SPLIT
    for (int ph = 0; ph < N_PHASES; ++ph) { a.ph_lo = ph; a.ph_hi = ph + 1; hipLaunchKernelGGL(kernel_of_phase(ph), dim3(grid), dim3(NWAVES * 64), LDS_BYTES, stream, a); }
#else
    a.ph_lo = 0; a.ph_hi = N_PHASES;
    if (hipMemsetAsync((char*)d_ws + WS_CTL, 0, 65536, stream) != hipSuccess) { fprintf(stderr, "kernel_launch: memset failed\n"); return; }
    void* kargs[] = {&a};
    hipError_t e = hipLaunchCooperativeKernel((const void*)fwd_kernel<PM_ALL>, dim3(grid), dim3(NWAVES * 64), kargs, LDS_BYTES, stream);
    if (e != hipSuccess) fprintf(stderr, "cooperative launch failed: %s (grid %d)\n", hipGetErrorString(e), grid);
#endif
}
```

```cpp
#include <hip/hip_runtime.h>
#include <hip/hip_bf16.h>
#include <hip/hip_cooperative_groups.h>
#include <cstdio>
#include <cstdint>
#include <cmath>
namespace cg = cooperative_groups;

__device__ __forceinline__ int fresh_lane() { unsigned z = 0u; asm volatile("" : "+v"(z)); return (int)__builtin_amdgcn_mbcnt_hi(~0u, __builtin_amdgcn_mbcnt_lo(~0u, z)); }
#ifndef PROBE_K2
#define PROBE_K2 0
#endif
namespace pg8 {
#define PG8_LAS __attribute__((address_space(3)))
typedef unsigned short bf16_t;
typedef short bf16x8 __attribute__((ext_vector_type(8)));
typedef float f32x4 __attribute__((ext_vector_type(4)));
typedef unsigned u32x4 __attribute__((ext_vector_type(4)));
typedef unsigned u32x2 __attribute__((ext_vector_type(2)));
constexpr int BM = 256, BK = 64, HALF = 128, HTB = HALF * BK * 2  , STAGE_BYTES = 8 * HTB, NXCD = 8, WGM = 8;

__host__ __device__ __forceinline__ int lds_byte(int r, int c) { const int st = (r >> 4) * 2 + (c >> 5), rr = r & 15, cc = c & 31, ob = rr * 64 + cc * 2; return st * 1024 + (ob ^ (((ob >> 9) & 1) << 5)); }
__host__ __device__ __forceinline__ void stage_rc(int b, int& R, int& C) { const int st = b / 1024, sb = b % 1024, swz = sb ^ (((sb >> 9) & 1) << 5); R = (st >> 1) * 16 + swz / 64; C = (st & 1) * 32 + (swz % 64) / 2; }
__host__ __device__ __forceinline__ int perm32(int rho) { const int n = rho >> 4, i = rho & 15; return 8 * (i >> 2) + 4 * n + (i & 3); }

struct Unit { int pm, pn; };
struct Gemm { const bf16_t* A; const bf16_t* Bt; int M, N, K; };

struct StaticOrder {
    int nM, nN, nwg, G, c, wgm;
    __device__ __forceinline__ void init(int M, int N, int G_, int c_, int wgm_ = WGM) { nM = M / BM; nN = N / BM; nwg = nM * nN; G = G_; c = c_; wgm = wgm_; }
    __device__ __forceinline__ bool next(int i, Unit& u) const {
        const long L = (long)i * G + c; if (L >= nwg) return false;
        int wgid = (int)L; { const int q = nwg / NXCD, r = nwg % NXCD, xcd = wgid % NXCD, off = wgid / NXCD; wgid = (xcd < r ? xcd * (q + 1) : r * (q + 1) + (xcd - r) * q) + off; }
        const int nig = wgm * nN, gid = wgid / nig, fm = gid * wgm, gsz = (nM - fm) < wgm ? (nM - fm) : wgm;
        u.pm = fm + ((wgid % nig) % gsz); u.pn = (wgid % nig) / gsz; return true;
    }
};

__device__ __forceinline__ unsigned cvt_pk_bf16(float lo, float hi) { unsigned r; asm volatile("v_cvt_pk_bf16_f32 %0, %1, %2" : "=v"(r) : "v"(lo), "v"(hi)); return r; }

template <class Epi, class Sched>
__device__ __forceinline__ void gemm_phase(const int tid, PG8_LAS unsigned char* lds, PG8_LAS unsigned char* xlds, const Gemm g, const Sched& S, const Epi& E) {
    const int wid = __builtin_amdgcn_readfirstlane(tid >> 6), lane = tid & 63, wr = wid >> 2, wc = wid & 3, fr = lane & 15, fq = lane >> 4;
    const int K = g.K, nt = K / BK;
    unsigned voffA, voffB;
    { int R, C; stage_rc(tid * 16, R, C); const int Rb = ((R & ~31) + perm32(R & 31));
      const int Ra = Epi::AROWPERM ? ((R & ~63) + 4 * (R & 15) + ((R >> 4) & 3)) : R;
      voffA = (unsigned)(Ra * K + C) * 2u; voffB = (unsigned)(Rb * K + C) * 2u; }
    const unsigned qstep = 64u * (unsigned)K * 2u;
    const unsigned kstep = (unsigned)(BK * 2);
    const unsigned hstep = (unsigned)HALF * (unsigned)K * 2u;
    const unsigned tstep = 2u * hstep;
    const char* const gA = (const char*)g.A; const char* const gB = (const char*)g.Bt;
    const unsigned ldsw = (unsigned)wid * 1024u;
    const int aoff = lds_byte(wr * 64 + fr, fq * 8), boff = lds_byte(wc * 32 + fr, fq * 8);
    unsigned ldsA_ = (unsigned)(uintptr_t)lds + (unsigned)aoff, ldsB_ = (unsigned)(uintptr_t)lds + 4u * HTB + (unsigned)boff; asm volatile("" : "+v"(ldsA_), "+v"(ldsB_));
    const PG8_LAS unsigned char* const ldsA = (const PG8_LAS unsigned char*)(uintptr_t)ldsA_; const PG8_LAS unsigned char* const ldsB = (const PG8_LAS unsigned char*)(uintptr_t)ldsB_;
#define PG8_SA(b, h) (((b) * 2 + (h)) * HTB)
#define PG8_SB(b, h) ((4 + (b) * 2 + (h)) * HTB)
#define PG8_STAGE(bufoff, gptr, goff, voff) do { _Pragma("unroll") for (int _i = 0; _i < 2; ++_i) \
        __builtin_amdgcn_global_load_lds((const unsigned*)((gptr) + (unsigned)((goff) + _i * qstep + (voff))), (PG8_LAS unsigned*)(lds + (bufoff) + ldsw + _i * 8192), 16, 0, 0); } while (0)
#define PG8_LDA(dst, b, h) do { _Pragma("unroll") for (int m = 0; m < 4; ++m) _Pragma("unroll") for (int k = 0; k < 2; ++k) dst[m][k] = *(const PG8_LAS bf16x8*)(ldsA + (PG8_SA(b, h) + m * 2048 + k * 1024)); } while (0)
#define PG8_LDB(dst, b, h) do { _Pragma("unroll") for (int n = 0; n < 2; ++n) _Pragma("unroll") for (int k = 0; k < 2; ++k) dst[n][k] = *(const PG8_LAS bf16x8*)(ldsB + (PG8_SB(b, h) - 4 * HTB + n * 2048 + k * 1024)); } while (0)
#define PG8_MMA(ai, bj, At, Bt) do { __builtin_amdgcn_s_setprio(1); _Pragma("unroll") for (int m = 0; m < 4; ++m) _Pragma("unroll") for (int n = 0; n < 2; ++n) _Pragma("unroll") for (int k = 0; k < 2; ++k) \
        acc[ai][bj][m][n] = __builtin_amdgcn_mfma_f32_16x16x32_bf16(Bt[n][k], At[m][k], acc[ai][bj][m][n], 0, 0, 0); __builtin_amdgcn_s_setprio(0); } while (0)
#define PG8_WAIT_V(n) asm volatile("s_waitcnt vmcnt(" #n ")" ::: "memory")
#define PG8_WAIT_L(n) asm volatile("s_waitcnt lgkmcnt(" #n ")" ::: "memory")
#define PG8_BAR __builtin_amdgcn_s_barrier()
#define PG8_SCHED __builtin_amdgcn_sched_barrier(0)
    Unit cur, nxt; int ui = 0;
    if (!S.next(0, cur)) return;
    f32x4 acc[2][2][4][2];
#pragma unroll
    for (int a = 0; a < 2; ++a)
#pragma unroll
        for (int b = 0; b < 2; ++b)
#pragma unroll
            for (int m = 0; m < 4; ++m)
#pragma unroll
                for (int n = 0; n < 2; ++n) acc[a][b][m][n] = (f32x4){0.f, 0.f, 0.f, 0.f};
    bf16x8 At[4][2], B0[2][2], B1[2][2];
    unsigned cA = (unsigned)cur.pm * tstep, cB = (unsigned)cur.pn * tstep;
    PG8_STAGE(PG8_SB(0, 0), gB, cB, voffB); PG8_STAGE(PG8_SB(0, 1), gB, cB + hstep, voffB); PG8_STAGE(PG8_SA(0, 0), gA, cA, voffA); PG8_STAGE(PG8_SA(0, 1), gA, cA + hstep, voffA);
    if (wr == 1) PG8_BAR;
    PG8_WAIT_V(2); PG8_BAR;
    PG8_STAGE(PG8_SB(1, 0), gB, cB + kstep, voffB); PG8_STAGE(PG8_SA(1, 0), gA, cA + kstep, voffA); PG8_STAGE(PG8_SB(1, 1), gB, cB + hstep + kstep, voffB);
    PG8_WAIT_V(0); PG8_BAR;
    for (;;) {
        PG8_BAR; { const int ln_ = fresh_lane(); E.prefetch(cur, xlds, wid, ln_); }
        const bool has_next = S.next(ui + 1, nxt);
        const unsigned nA = has_next ? (unsigned)nxt.pm * tstep : cA, nB = has_next ? (unsigned)nxt.pn * tstep : cB;
#if PROBE_K2
        for (int rep = 0; rep < 2; ++rep)
#endif
        for (int t = 0; t < nt; t += 2) {
            const bool last = (t == nt - 2);
            const unsigned a1 = cA + (unsigned)(t + 1) * kstep;
#if PROBE_K2
            const unsigned a2 = last ? (rep == 0 ? cA : nA) : cA + (unsigned)(t + 2) * kstep, b2 = last ? (rep == 0 ? cB : nB) : cB + (unsigned)(t + 2) * kstep;
#else
            const unsigned a2 = last ? nA : cA + (unsigned)(t + 2) * kstep, b2 = last ? nB : cB + (unsigned)(t + 2) * kstep;
#endif
            const unsigned a3 = a2 + kstep, b3 = b2 + kstep;
            const bool relax = (t == 0);
            PG8_LDB(B0, 0, 0); PG8_LDB(B1, 0, 1); PG8_SCHED; PG8_LDA(At, 0, 0); PG8_STAGE(PG8_SA(1, 1), gA, a1 + hstep, voffA);
            if (!relax) PG8_WAIT_V(8); PG8_WAIT_L(0); PG8_BAR; PG8_MMA(0, 0, At, B0); PG8_MMA(0, 1, At, B1); PG8_BAR; PG8_SCHED;
            PG8_LDA(At, 0, 1); PG8_STAGE(PG8_SB(0, 0), gB, b2, voffB); PG8_STAGE(PG8_SB(0, 1), gB, b2 + hstep, voffB); PG8_STAGE(PG8_SA(0, 0), gA, a2, voffA);
            if (!relax) PG8_WAIT_V(8); PG8_WAIT_L(0); PG8_BAR; PG8_MMA(1, 0, At, B0); PG8_MMA(1, 1, At, B1); PG8_BAR; PG8_SCHED;
            PG8_LDB(B0, 1, 0); PG8_LDB(B1, 1, 1); PG8_SCHED; PG8_LDA(At, 1, 0); PG8_STAGE(PG8_SA(0, 1), gA, a2 + hstep, voffA);
            PG8_WAIT_V(8); PG8_WAIT_L(0); PG8_BAR; PG8_MMA(0, 0, At, B0); PG8_MMA(0, 1, At, B1); PG8_BAR; PG8_SCHED;
            PG8_LDA(At, 1, 1); PG8_STAGE(PG8_SB(1, 0), gB, b3, voffB); PG8_STAGE(PG8_SB(1, 1), gB, b3 + hstep, voffB); PG8_STAGE(PG8_SA(1, 0), gA, a3, voffA);
            PG8_WAIT_V(8); PG8_WAIT_L(0); PG8_BAR; PG8_MMA(1, 0, At, B0); PG8_MMA(1, 1, At, B1); PG8_BAR; PG8_SCHED;
        }
#if PROBE_K2
#pragma unroll
        for (int a = 0; a < 2; ++a)
#pragma unroll
            for (int b = 0; b < 2; ++b)
#pragma unroll
                for (int m = 0; m < 4; ++m)
#pragma unroll
                    for (int n = 0; n < 2; ++n) acc[a][b][m][n] = acc[a][b][m][n] * 0.5f;
#endif
        if (wr == 0) PG8_BAR;
        PG8_WAIT_V(0);
        { const int ln_ = fresh_lane(); const int fr_ = ln_ & 15, fq_ = ln_ >> 4; E(acc, cur, wr, wc, fr_, fq_, xlds); if constexpr (Epi::PROBE2) { { const int l2_ = fresh_lane(); E(acc, cur, wr, wc, l2_ & 15, l2_ >> 4, xlds); } } }
        if (!has_next) break;
#pragma unroll
        for (int a = 0; a < 2; ++a)
#pragma unroll
            for (int b = 0; b < 2; ++b)
#pragma unroll
                for (int m = 0; m < 4; ++m)
#pragma unroll
                    for (int n = 0; n < 2; ++n) acc[a][b][m][n] = (f32x4){0.f, 0.f, 0.f, 0.f};
        cur = nxt; cA = nA; cB = nB; ++ui;
        if (wr == 1) PG8_BAR;
    }
    PG8_WAIT_V(0);
    PG8_BAR;
#undef PG8_SA
#undef PG8_SB
#undef PG8_STAGE
#undef PG8_LDA
#undef PG8_LDB
#undef PG8_MMA
#undef PG8_WAIT_V
#undef PG8_WAIT_L
#undef PG8_BAR
#undef PG8_SCHED
}
}

constexpr int BATCH = 8, SEQ = 4096, DMODEL = 1024, NHEADS = 16, HDIM = 64, DFF = 2816, NUP = 2 * DFF;
constexpr int MTOK = BATCH * SEQ;
constexpr float RMS_EPS = 1e-6f;
constexpr float QSCALE = 0.125f * 1.4426950408889634f;
constexpr int XL_EX = 0, XL_SS = 8192, XL_GAIN = XL_SS + 1024, XL_COS = XL_GAIN + 256, XL_SIN = XL_COS + 8192, XL_CW = XL_COS, XL_END = XL_SIN + 8192;

typedef unsigned short bf16;
typedef float f32x4 __attribute__((ext_vector_type(4)));
typedef float f32x2 __attribute__((ext_vector_type(2)));
typedef unsigned u32x4 __attribute__((ext_vector_type(4)));
typedef unsigned u32x2 __attribute__((ext_vector_type(2)));
#define LAS __attribute__((address_space(3)))

__device__ __forceinline__ float shx(float v, int m) { return __shfl_xor(v, m); }
__device__ __forceinline__ float xsum16(float v) { auto r = __builtin_amdgcn_permlane16_swap(__float_as_uint(v), __float_as_uint(v), false, false); return __uint_as_float(r[0]) + __uint_as_float(r[1]); }
__device__ __forceinline__ float xsum32(float v) { auto r = __builtin_amdgcn_permlane32_swap(__float_as_uint(v), __float_as_uint(v), false, false); return __uint_as_float(r[0]) + __uint_as_float(r[1]); }
__device__ __forceinline__ float fqsum(float v) { return xsum32(xsum16(v)); }
__device__ __forceinline__ float rsq(float v) { return __builtin_amdgcn_rsqf(v); }
__device__ __forceinline__ float bf2f(unsigned short b) { return __uint_as_float(((unsigned)b) << 16); }
__device__ __forceinline__ float sum4(f32x4 v) { return (v[0] + v[1]) + (v[2] + v[3]); }
__device__ __forceinline__ float dot4(f32x4 v) { return (v[0] * v[0] + v[1] * v[1]) + (v[2] * v[2] + v[3] * v[3]); }

__device__ __forceinline__ void dma1k(const void* src, LAS unsigned char* dst, unsigned voff) {
    __builtin_amdgcn_global_load_lds((const unsigned*)((const char*)src + voff), (LAS unsigned*)dst, 16, 0, 0); }
__device__ __forceinline__ float lds_rstd(LAS unsigned char* xlds, int r) { return rsq(((LAS float*)(xlds + XL_SS))[r] * (1.0f / DMODEL) + RMS_EPS); }
#ifndef PROBE_EPI2
#define PROBE_EPI2 0
#endif
template <int CTRL> __device__ __forceinline__ float dpp_ror(float v) { return __builtin_bit_cast(float, __builtin_amdgcn_update_dpp(0, __builtin_bit_cast(int, v), CTRL, 0xf, 0xf, false)); }
template <bool KMSUM> struct EpiQKV {
    static constexpr bool PROBE2 = (PROBE_EPI2 & 1) != 0, AROWPERM = false;
    float* kmsum;
    bf16 *Q; size_t qkv_stride; const float* ss; const float *qg, *kg; const float *cosT, *sinT;
    __device__ __forceinline__ void prefetch(const pg8::Unit& u, LAS unsigned char* xlds, int wid, int lane) const {
        const int which = u.pn >> 2; const unsigned l16 = (unsigned)lane * 16u;
        if (wid == 0) dma1k(ss + u.pm * 256, xlds + XL_SS, l16);
        if (which < 2) {
            const int pos0 = (u.pm * 256) & (SEQ - 1);
            dma1k(cosT + pos0 * 8 + wid * 256, xlds + XL_COS + wid * 1024, l16);
            dma1k(sinT + pos0 * 8 + wid * 256, xlds + XL_SIN + wid * 1024, l16);
            if (wid == 1 && lane < 16) dma1k((which == 0) ? qg : kg, xlds + XL_GAIN, l16);
        }
    }
    __device__ __forceinline__ void operator()(const f32x4 (&acc)[2][2][4][2], const pg8::Unit& u, int wr, int wc, int fr, int fq, LAS unsigned char* xlds) const {
        const int which = u.pn >> 2, head = (u.pn & 3) * 4 + wc;
        bf16* dst = Q + (size_t)which * qkv_stride;
        f32x4 g[2][2];
        if (which < 2) {
            const LAS float* gn = (const LAS float*)(xlds + XL_GAIN);
            const int b0 = (fq < 2) ? 4 * fq : 8 * fq, b1 = (fq < 2) ? 8 + 4 * fq : 8 * fq + 4;
            g[0][0] = *(const LAS f32x4*)(gn + b0); g[0][1] = *(const LAS f32x4*)(gn + b1);
            g[1][0] = *(const LAS f32x4*)(gn + 32 + 8 * fq); g[1][1] = *(const LAS f32x4*)(gn + 32 + 8 * fq + 4);
        }
        const float post = (which == 0) ? QSCALE : 1.0f;
        const bool ropeq = (which < 2) && (fq < 2);
        f32x4 ks[2][2];
        if (KMSUM) {
#pragma unroll
            for (int bj = 0; bj < 2; ++bj)
#pragma unroll
                for (int n = 0; n < 2; ++n) ks[bj][n] = (f32x4){0.f, 0.f, 0.f, 0.f};
        }
#pragma unroll
        for (int ai = 0; ai < 2; ++ai) {
#pragma unroll
            for (int m = 0; m < 4; ++m) {
                const int row = u.pm * 256 + ai * 128 + wr * 64 + m * 16 + fr;
                f32x4 cs = (f32x4){1.f, 1.f, 1.f, 1.f}, sn = (f32x4){0.f, 0.f, 0.f, 0.f};
                if (ropeq) { const int r = ai * 128 + wr * 64 + m * 16 + fr; cs = *(const LAS f32x4*)(xlds + XL_COS + r * 32 + 16 * fq); sn = *(const LAS f32x4*)(xlds + XL_SIN + r * 32 + 16 * fq); }
                const float rstd = lds_rstd(xlds, ai * 128 + wr * 64 + m * 16 + fr);
                f32x4 v[2][2];
                if (which < 2) {
                    const float q = fqsum((dot4(acc[ai][0][m][0]) + dot4(acc[ai][0][m][1])) + (dot4(acc[ai][1][m][0]) + dot4(acc[ai][1][m][1])));
                    const float sc = post * rstd * rsq(q * (rstd * rstd) * (1.0f / HDIM) + RMS_EPS);
#pragma unroll
                    for (int bj = 0; bj < 2; ++bj)
#pragma unroll
                        for (int n = 0; n < 2; ++n) v[bj][n] = acc[ai][bj][m][n] * (g[bj][n] * sc);
                    const f32x4 x1 = v[0][0], x2 = v[0][1];
                    v[0][0] = (x1 * cs - x2 * sn); v[0][1] = (x2 * cs + x1 * sn);
                    if (KMSUM && which == 1) {
#pragma unroll
                        for (int bj = 0; bj < 2; ++bj)
#pragma unroll
                            for (int n = 0; n < 2; ++n) ks[bj][n] += v[bj][n];
                    }
                } else {
#pragma unroll
                    for (int bj = 0; bj < 2; ++bj)
#pragma unroll
                        for (int n = 0; n < 2; ++n) v[bj][n] = acc[ai][bj][m][n] * rstd;
                }
                bf16* rowp = dst + (size_t)row * DMODEL + head * 64 + 8 * fq;
#pragma unroll
                for (int bj = 0; bj < 2; ++bj) {
                    u32x4 w; w.x = pg8::cvt_pk_bf16(v[bj][0][0], v[bj][0][1]); w.y = pg8::cvt_pk_bf16(v[bj][0][2], v[bj][0][3]);
                    w.z = pg8::cvt_pk_bf16(v[bj][1][0], v[bj][1][1]); w.w = pg8::cvt_pk_bf16(v[bj][1][2], v[bj][1][3]);
                    *(u32x4*)(rowp + bj * 32) = w;
                }
            }
            asm volatile("" ::: "memory");
        }
        if (KMSUM && which == 1) {
#pragma unroll
            for (int bj = 0; bj < 2; ++bj)
#pragma unroll
                for (int n = 0; n < 2; ++n)
#pragma unroll
                    for (int e = 0; e < 4; ++e) {
                        float x = ks[bj][n][e];
                        x += dpp_ror<0x128>(x); x += dpp_ror<0x124>(x); x += dpp_ror<0x122>(x); x += dpp_ror<0x121>(x);
                        ks[bj][n][e] = x;
                    }
            if (fr == 0) {
                float* kp = kmsum + ((size_t)((u.pm >> 4) * NHEADS + head) * 16 + (u.pm & 15)) * 64 + 8 * fq;
#pragma unroll
                for (int bj = 0; bj < 2; ++bj)
#pragma unroll
                    for (int n = 0; n < 2; ++n)
#pragma unroll
                        for (int e = 0; e < 4; ++e) atomicAdd(kp + bj * 32 + 4 * n + e, ks[bj][n][e]);
            }
        }
    }
};

__device__ __forceinline__ f32x4 bf_lo2(unsigned a, unsigned b) { return (f32x4){__uint_as_float(a << 16), __uint_as_float(a & 0xffff0000u), __uint_as_float(b << 16), __uint_as_float(b & 0xffff0000u)}; }
template <bool RES_F32, bool OUT_F32> struct EpiRes {
    static constexpr bool PROBE2 = false, AROWPERM = false;
    const void* resid; void* out; float* ss;
    __device__ __forceinline__ void prefetch(const pg8::Unit&, LAS unsigned char*, int, int) const {}
    __device__ __forceinline__ void operator()(const f32x4 (&acc)[2][2][4][2], const pg8::Unit& u, int wr, int wc, int fr, int fq, LAS unsigned char*) const {
        const int col0 = u.pn * 256 + wc * 32 + 8 * fq;
        if constexpr (!RES_F32) {
            u32x4 rb[2][4][2];
#pragma unroll
            for (int ai = 0; ai < 2; ++ai)
#pragma unroll
                for (int m = 0; m < 4; ++m) {
                    const size_t off = (size_t)(u.pm * 256 + ai * 128 + wr * 64 + m * 16 + fr) * DMODEL + col0;
#pragma unroll
                    for (int bj = 0; bj < 2; ++bj) rb[ai][m][bj] = __builtin_nontemporal_load((const u32x4*)((const bf16*)resid + off + bj * 128));
                }
            asm volatile("" ::: "memory");
#pragma unroll
            for (int ai = 0; ai < 2; ++ai)
#pragma unroll
                for (int m = 0; m < 4; ++m) {
                    const int row = u.pm * 256 + ai * 128 + wr * 64 + m * 16 + fr;
                    const size_t off = (size_t)row * DMODEL + col0;
                    float q = 0.f;
#pragma unroll
                    for (int bj = 0; bj < 2; ++bj) {
                        const f32x4 x0 = bf_lo2(rb[ai][m][bj].x, rb[ai][m][bj].y) + acc[ai][bj][m][0], x1 = bf_lo2(rb[ai][m][bj].z, rb[ai][m][bj].w) + acc[ai][bj][m][1];
                        q += dot4(x0) + dot4(x1);
                        if (OUT_F32) { *(f32x4*)((float*)out + off + bj * 128) = x0; *(f32x4*)((float*)out + off + bj * 128 + 4) = x1; }
                        else { u32x4 w; w.x = pg8::cvt_pk_bf16(x0[0], x0[1]); w.y = pg8::cvt_pk_bf16(x0[2], x0[3]); w.z = pg8::cvt_pk_bf16(x1[0], x1[1]); w.w = pg8::cvt_pk_bf16(x1[2], x1[3]);
                            *(u32x4*)((bf16*)out + off + bj * 128) = w; }
                    }
                    if (ss) { q = fqsum(q); if (fq == 0) atomicAdd(ss + row, q); }
                }
        } else {
#pragma unroll
            for (int ai = 0; ai < 2; ++ai)
#pragma unroll
                for (int mp = 0; mp < 4; mp += 2) {
                    f32x4 rr[2][2][2];
#pragma unroll
                    for (int mm = 0; mm < 2; ++mm) {
                        const size_t off = (size_t)(u.pm * 256 + ai * 128 + wr * 64 + (mp + mm) * 16 + fr) * DMODEL + col0;
#pragma unroll
                        for (int bj = 0; bj < 2; ++bj) { rr[mm][bj][0] = *(const f32x4*)((const float*)resid + off + bj * 128); rr[mm][bj][1] = *(const f32x4*)((const float*)resid + off + bj * 128 + 4); }
                    }
#pragma unroll
                    for (int mm = 0; mm < 2; ++mm) {
                        const int m = mp + mm;
                        const int row = u.pm * 256 + ai * 128 + wr * 64 + m * 16 + fr;
                        const size_t off = (size_t)row * DMODEL + col0;
                        float q = 0.f;
#pragma unroll
                        for (int bj = 0; bj < 2; ++bj) {
                            const f32x4 x0 = rr[mm][bj][0] + acc[ai][bj][m][0], x1 = rr[mm][bj][1] + acc[ai][bj][m][1];
                            q += dot4(x0) + dot4(x1);
                            if (OUT_F32) { *(f32x4*)((float*)out + off + bj * 128) = x0; *(f32x4*)((float*)out + off + bj * 128 + 4) = x1; }
                            else { u32x4 w; w.x = pg8::cvt_pk_bf16(x0[0], x0[1]); w.y = pg8::cvt_pk_bf16(x0[2], x0[3]); w.z = pg8::cvt_pk_bf16(x1[0], x1[1]); w.w = pg8::cvt_pk_bf16(x1[2], x1[3]);
                                *(u32x4*)((bf16*)out + off + bj * 128) = w; }
                        }
                        if (ss) { q = fqsum(q); if (fq == 0) atomicAdd(ss + row, q); }
                    }
                    asm volatile("" ::: "memory");
                }
        }
    }
};

__device__ __forceinline__ void shr1_into(f32x4& d, const f32x4 s) {
    float d0 = d[0], d1 = d[1], d2 = d[2], d3 = d[3];
    asm volatile("s_nop 1\n\tv_mov_b32_dpp %0, %4 row_shr:1 row_mask:0xf bank_mask:0xf\n\tv_mov_b32_dpp %1, %5 row_shr:1 row_mask:0xf bank_mask:0xf\n\t"
                 "v_mov_b32_dpp %2, %6 row_shr:1 row_mask:0xf bank_mask:0xf\n\tv_mov_b32_dpp %3, %7 row_shr:1 row_mask:0xf bank_mask:0xf"
                 : "+v"(d0), "+v"(d1), "+v"(d2), "+v"(d3) : "v"(s[0]), "v"(s[1]), "v"(s[2]), "v"(s[3]));
    d = (f32x4){d0, d1, d2, d3};
}
__device__ __forceinline__ f32x4 ror1(f32x4 v) { return (f32x4){dpp_ror<0x121>(v[0]), dpp_ror<0x121>(v[1]), dpp_ror<0x121>(v[2]), dpp_ror<0x121>(v[3])}; }
__device__ __forceinline__ f32x4 ror2(f32x4 v) { return (f32x4){dpp_ror<0x122>(v[0]), dpp_ror<0x122>(v[1]), dpp_ror<0x122>(v[2]), dpp_ror<0x122>(v[3])}; }
__device__ __forceinline__ float silu_mul(float gte, float val) { const float e = __builtin_amdgcn_exp2f(gte * -1.4426950408889634f); return gte * __builtin_amdgcn_rcpf(1.0f + e) * val; }
constexpr int EDGE_ROWS = 4;
struct EpiUpConv {
    static constexpr bool PROBE2 = (PROBE_EPI2 & 2) != 0, AROWPERM = true;
    const float* ss; const float* cw; const float* cb; bf16* Hh; float* edge;
    __device__ __forceinline__ void prefetch(const pg8::Unit& u, LAS unsigned char* xlds, int wid, int lane) const {
        const unsigned l16 = (unsigned)lane * 16u;
        if (wid == 0) dma1k(ss + u.pm * 256, xlds + XL_SS, l16);
        if (wid >= 1 && wid <= 4) {
            const float* src = ((wid == 4) ? cb : cw + (size_t)(wid - 1) * NUP) + u.pn * 128;
            dma1k(src, xlds + XL_CW + (wid - 1) * 1024, l16 + ((lane < 32) ? 0u : (unsigned)(DFF - 128) * 4u));
        }
    }
    __device__ __forceinline__ void operator()(const f32x4 (&acc)[2][2][4][2], const pg8::Unit& u, int wr, int wc, int fr, int fq, LAS unsigned char* xlds) const {
        float rs[2][4];
#pragma unroll
        for (int ai = 0; ai < 2; ++ai)
#pragma unroll
            for (int m = 0; m < 4; ++m) rs[ai][m] = lds_rstd(xlds, ai * 128 + wr * 64 + 4 * fr + m);
        LAS f32x4* EX = (LAS f32x4*)(xlds + XL_EX);
        if (fr == 15) {
#pragma unroll
            for (int ai = 0; ai < 2; ++ai)
#pragma unroll
                for (int mm = 0; mm < 2; ++mm)
#pragma unroll
                    for (int bj = 0; bj < 2; ++bj)
#pragma unroll
                        for (int n = 0; n < 2; ++n) EX[((((ai * 2 + wr) * 4 + wc) * 2 + mm) * 4 + fq) * 4 + bj * 2 + n] = acc[ai][bj][2 + mm][n] * rs[ai][2 + mm];
        }
        {
            const int pcol = u.pn * 256 + wc * 32 + 8 * fq;
            float* eb = edge + (size_t)u.pm * EDGE_ROWS * NUP + pcol;
            if (wr == 0 && fr == 0) {
#pragma unroll
                for (int mm = 0; mm < 2; ++mm)
#pragma unroll
                    for (int bj = 0; bj < 2; ++bj)
#pragma unroll
                        for (int n = 0; n < 2; ++n) *(f32x4*)(eb + (size_t)mm * NUP + bj * 128 + 4 * n) = acc[0][bj][mm][n] * rs[0][mm];
            }
            if (wr == 1 && fr == 15) {
#pragma unroll
                for (int mm = 0; mm < 2; ++mm)
#pragma unroll
                    for (int bj = 0; bj < 2; ++bj)
#pragma unroll
                        for (int n = 0; n < 2; ++n) *(f32x4*)(eb + (size_t)(2 + mm) * NUP + bj * 128 + 4 * n) = acc[1][bj][2 + mm][n] * rs[1][2 + mm];
            }
        }
        asm volatile("s_waitcnt lgkmcnt(0)" ::: "memory"); __builtin_amdgcn_s_barrier(); asm volatile("" ::: "memory");
        const bool seq_start = (u.pm & 15) == 0;
        const int jg0 = u.pn * 128 + wc * 32 + 8 * fq;
        u32x2 hold[2][4];
#pragma unroll
        for (int n = 0; n < 2; ++n) {
            f32x4 w0[2], w1[2], w2[2], bb[2];
#pragma unroll
            for (int bj = 0; bj < 2; ++bj) {
                const int pc = (bj * 128 + wc * 32 + 8 * fq + 4 * n) * 4;
                w0[bj] = *(const LAS f32x4*)(xlds + XL_CW + pc); w1[bj] = *(const LAS f32x4*)(xlds + XL_CW + 1024 + pc); w2[bj] = *(const LAS f32x4*)(xlds + XL_CW + 2048 + pc); bb[bj] = *(const LAS f32x4*)(xlds + XL_CW + 3072 + pc);
            }
#pragma unroll
            for (int ai = 0; ai < 2; ++ai) {
                f32x4 uc[2][4];
#pragma unroll
                for (int bj = 0; bj < 2; ++bj) {
                    f32x4 h62, h63;
                    if (ai == 0 && wr == 0) { h62 = (f32x4){0.f, 0.f, 0.f, 0.f}; h63 = h62; }
                    else { const int sa = (wr == 1) ? ai : ai - 1, sw = (wr == 1) ? 0 : 1;
                        h62 = EX[((((sa * 2 + sw) * 4 + wc) * 2 + 0) * 4 + fq) * 4 + bj * 2 + n]; h63 = EX[((((sa * 2 + sw) * 4 + wc) * 2 + 1) * 4 + fq) * 4 + bj * 2 + n]; }
                    f32x4 c[4];
#pragma unroll
                    for (int m = 0; m < 4; ++m) c[m] = acc[ai][bj][m][n] * rs[ai][m];
                    f32x4 x1 = h63, x2 = h62;
                    shr1_into(x1, c[3]); shr1_into(x2, c[2]);
                    uc[bj][0] = bb[bj] + w0[bj] * x2 + w1[bj] * x1 + w2[bj] * c[0];
                    uc[bj][1] = bb[bj] + w0[bj] * x1 + w1[bj] * c[0] + w2[bj] * c[1];
                    uc[bj][2] = bb[bj] + w0[bj] * c[0] + w1[bj] * c[1] + w2[bj] * c[2];
                    uc[bj][3] = bb[bj] + w0[bj] * c[1] + w1[bj] * c[2] + w2[bj] * c[3];
                }
#pragma unroll
                for (int m = 0; m < 4; ++m) {
                    const unsigned lo = pg8::cvt_pk_bf16(silu_mul(uc[0][m][0], uc[1][m][0]), silu_mul(uc[0][m][1], uc[1][m][1]));
                    const unsigned hi = pg8::cvt_pk_bf16(silu_mul(uc[0][m][2], uc[1][m][2]), silu_mul(uc[0][m][3], uc[1][m][3]));
                    if (n == 0) { hold[ai][m] = (u32x2){lo, hi}; }
                    else {
                        const int row = u.pm * 256 + ai * 128 + wr * 64 + 4 * fr + m;
                        const bool skip = (!seq_start) && ai == 0 && wr == 0 && m < 2 && fr == 0;
                        if (!skip) { u32x4 w; w.x = hold[ai][m].x; w.y = hold[ai][m].y; w.z = lo; w.w = hi; *(u32x4*)(Hh + (size_t)row * DFF + jg0) = w; }
                    }
                }
                asm volatile("" ::: "memory");
            }
        }
    }
};

namespace attn {
using bf16x8 = __attribute__((ext_vector_type(8))) short;
using s16x4 = __attribute__((ext_vector_type(4))) short;
using f32x16 = __attribute__((ext_vector_type(16))) float;
using u32x4 = ::u32x4;
constexpr int DM = 1024, NW = 8, QBLK = 32, QB = 256, KVBLK = 64;
constexpr int NSLOT = 3, SLOTB = 8192;
constexpr int LDS_K = 0, LDS_V = NSLOT * SLOTB, LDS_WS = 2 * NSLOT * SLOTB, LDS_OST = LDS_WS + NW * 64 * 4, LDS_BYTES = LDS_OST + NW * 4096;
constexpr int THRL = 8;
enum { OUT_FINAL = 0, OUT_PART = 1, OUT_MERGE = 2 };
struct Job {
    const bf16* Q; const bf16* K; const bf16* V;
    bf16* O;
    long rs;
    int q0, k0, NT;
    int ob;
    const float* kmean;
    float kbound;
    float* stat;
    const bf16* num0; const bf16* num1; const float* stat0; const float* stat1;
    long srs;
};
__device__ __forceinline__ int crow(int r, int hi) { return (r & 3) + 8 * (r >> 2) + 4 * hi; }
#define SBAR() __builtin_amdgcn_sched_barrier(0)
__device__ __forceinline__ void glds16_nt(const void* gsrc, unsigned lds_dst) { unsigned keep;
    asm volatile("s_mov_b32 %0, m0\n\ts_mov_b32 m0, %2\n\ts_nop 0\n\tglobal_load_lds_dwordx4 %1, off nt\n\ts_mov_b32 m0, %0" : "=&s"(keep) : "v"(gsrc), "s"(lds_dst) : "memory"); }
__device__ __forceinline__ void glds16(const void* gsrc, unsigned lds_dst) { unsigned keep;
    asm volatile("s_mov_b32 %0, m0\n\ts_mov_b32 m0, %2\n\ts_nop 0\n\tglobal_load_lds_dwordx4 %1, off\n\ts_mov_b32 m0, %0" : "=&s"(keep) : "v"(gsrc), "s"(lds_dst) : "memory"); }
typedef float f32x2_t __attribute__((ext_vector_type(2))); typedef __bf16 bf16x2_t __attribute__((ext_vector_type(2)));
__device__ __forceinline__ unsigned cvtpk_s(float lo, float hi) { f32x2_t v = {lo, hi}; bf16x2_t b = __builtin_convertvector(v, bf16x2_t); return __builtin_bit_cast(unsigned, b); }
#define WAIT_BAR(N) asm volatile("s_waitcnt vmcnt(" #N ") lgkmcnt(0)\n\ts_barrier" ::: "memory")
typedef __attribute__((address_space(3))) const char* lds_cptr;
typedef short v4i16_t __attribute__((ext_vector_type(4)));
__device__ __forceinline__ void kload8(bf16x8* kf, lds_cptr kp) {
    kf[0] = *(const __attribute__((address_space(3))) bf16x8*)(kp);        kf[1] = *(const __attribute__((address_space(3))) bf16x8*)(kp + 512);
    kf[2] = *(const __attribute__((address_space(3))) bf16x8*)(kp + 2048); kf[3] = *(const __attribute__((address_space(3))) bf16x8*)(kp + 2560);
    kf[4] = *(const __attribute__((address_space(3))) bf16x8*)(kp + 4096); kf[5] = *(const __attribute__((address_space(3))) bf16x8*)(kp + 4608);
    kf[6] = *(const __attribute__((address_space(3))) bf16x8*)(kp + 6144); kf[7] = *(const __attribute__((address_space(3))) bf16x8*)(kp + 6656);
}
__device__ __forceinline__ void kload2(bf16x8* kf, lds_cptr kp, int j) { kf[2 * j] = *(const __attribute__((address_space(3))) bf16x8*)(kp + j * 2048); kf[2 * j + 1] = *(const __attribute__((address_space(3))) bf16x8*)(kp + j * 2048 + 512); }
__device__ __forceinline__ s16x4 vtr(lds_cptr p) { return __builtin_bit_cast(s16x4, __builtin_amdgcn_ds_read_tr16_b64_v4i16((__attribute__((address_space(3))) v4i16_t*)p)); }
#define MX3(a, b, c) __builtin_fmaxf(__builtin_fmaxf((a), (b)), (c))
__device__ __forceinline__ float rowmax32(const f32x16& p0, const f32x16& p1) {
    float a = MX3(p0[0], p0[1], p1[0]), b = MX3(p0[2], p0[3], p1[1]); a = MX3(a, p1[2], p1[3]);
#pragma unroll
    for (int r = 4; r < 16; r += 4) { a = MX3(a, p0[r], p0[r + 1]); b = MX3(b, p0[r + 2], p0[r + 3]); a = MX3(a, p1[r], p1[r + 1]); b = MX3(b, p1[r + 2], p1[r + 3]); }
    float m = __builtin_fmaxf(a, b); auto rr = __builtin_amdgcn_permlane32_swap(__float_as_uint(m), __float_as_uint(m), false, false);
    return __builtin_fmaxf(__uint_as_float(rr[0]), __uint_as_float(rr[1]));
}
__device__ __forceinline__ float halves_sum(float v) { auto rr = __builtin_amdgcn_permlane32_swap(__float_as_uint(v), __float_as_uint(v), false, false); return __uint_as_float(rr[0]) + __uint_as_float(rr[1]); }
__device__ __forceinline__ void bmask(f32x16& p0, f32x16& p1, int Dt, unsigned lim) {
#pragma unroll
    for (int r = 0; r < 16; ++r) { const int x = Dt - ((r & 3) + 8 * (r >> 2)); if ((unsigned)x > lim) p0[r] = -INFINITY; if ((unsigned)(x - 32) > lim) p1[r] = -INFINITY; }
}
__device__ __forceinline__ void pv(f32x16* o, int vb, bf16x8 pa0, bf16x8 pa1, bf16x8 pa2, bf16x8 pa3) {
#pragma unroll
    for (int d0 = 0; d0 < 2; ++d0) { s16x4 lo[4], hi[4];
#pragma unroll
        for (int ks = 0; ks < 4; ++ks) {
            asm volatile("ds_read_b64_tr_b16 %0,%1 offset:%c2" : "=&v"(lo[ks]) : "v"(vb), "i"(d0 * 4096 + ks * 1024) : "memory");
            asm volatile("ds_read_b64_tr_b16 %0,%1 offset:%c2" : "=&v"(hi[ks]) : "v"(vb), "i"(d0 * 4096 + ks * 1024 + 512) : "memory"); }
        asm volatile("s_waitcnt lgkmcnt(0)" ::: "memory"); SBAR();
#define PK(k) (bf16x8){lo[k][0], lo[k][1], lo[k][2], lo[k][3], hi[k][0], hi[k][1], hi[k][2], hi[k][3]}
        o[d0] = __builtin_amdgcn_mfma_f32_32x32x16_bf16(pa0, PK(0), o[d0], 0, 0, 0);
        o[d0] = __builtin_amdgcn_mfma_f32_32x32x16_bf16(pa1, PK(1), o[d0], 0, 0, 0);
        o[d0] = __builtin_amdgcn_mfma_f32_32x32x16_bf16(pa2, PK(2), o[d0], 0, 0, 0);
        o[d0] = __builtin_amdgcn_mfma_f32_32x32x16_bf16(pa3, PK(3), o[d0], 0, 0, 0);
#undef PK
    }
}

template <int OUT> __device__ __forceinline__ void unit_epilogue(const Job& J, float* wsf, unsigned short* stg  , int wid, int lane, float l_reg, float mhat, const f32x16 (&o)[2]) {
    const int r32 = lane & 31, hi = lane >> 5; const long rs = J.rs;
    l_reg = halves_sum(l_reg);
    if (hi == 0) { wsf[32 + r32] = l_reg; wsf[r32] = mhat; }
    asm volatile("s_waitcnt lgkmcnt(0)" ::: "memory");
    const long orow0 = (long)(J.q0 + wid * QBLK);
    if (OUT == OUT_PART) { if (hi == 0) { float* sp = J.stat + (orow0 + r32) * J.srs; *(f32x2*)sp = (f32x2){l_reg, mhat}; } }
#pragma unroll
    for (int hf = 0; hf < 2; ++hf) {
#pragma unroll
        for (int rr = 0; rr < 8; ++rr) { const int r = 8 * hf + rr; const int orow = crow(rr, hi);
            const float sc = (OUT == OUT_FINAL) ? __builtin_amdgcn_rcpf(wsf[32 + crow(r, hi)]) : 1.0f;
#pragma unroll
            for (int d0 = 0; d0 < 2; ++d0) stg[orow * 64 + d0 * 32 + r32] = (unsigned short)(cvtpk_s(o[d0][r] * sc, 0.f) & 0xffffu); }
        asm volatile("s_waitcnt lgkmcnt(0)" ::: "memory");
#pragma unroll
        for (int i = 0; i < 2; ++i) {
            const int srow = i * 8 + (lane >> 3), row = 16 * hf + srow, ch = lane & 7;
            const u32x4 v = *(const u32x4*)(stg + srow * 64 + ch * 8);
            const long go = (orow0 + row) * rs + ch * 8;
            if (OUT == OUT_MERGE) {
                const float l2 = wsf[32 + row], m2 = wsf[row];
                const f32x2 s0 = *(const f32x2*)(J.stat0 + (orow0 + row) * J.srs), s1 = *(const f32x2*)(J.stat1 + (orow0 + row) * J.srs);
                const u32x4 n0 = *(const u32x4*)(J.num0 + go), n1 = *(const u32x4*)(J.num1 + go);
                const float mx = MX3(s0.y, s1.y, m2);
                const float w0 = __builtin_amdgcn_exp2f(s0.y - mx), w1 = __builtin_amdgcn_exp2f(s1.y - mx), w2 = __builtin_amdgcn_exp2f(m2 - mx);
                const float inv = 1.0f / (w0 * s0.x + w1 * s1.x + w2 * l2);
                const float a0 = w0 * inv, a1 = w1 * inv, a2 = w2 * inv;
                u32x4 w;
#pragma unroll
                for (int e = 0; e < 4; ++e) {
                    const float lo = a0 * __uint_as_float(n0[e] << 16) + a1 * __uint_as_float(n1[e] << 16) + a2 * __uint_as_float(v[e] << 16);
                    const float hh = a0 * __uint_as_float(n0[e] & 0xffff0000u) + a1 * __uint_as_float(n1[e] & 0xffff0000u) + a2 * __uint_as_float(v[e] & 0xffff0000u);
                    w[e] = cvtpk_s(lo, hh);
                }
                *(u32x4*)(J.O + go) = w;
            } else {
                *(u32x4*)(J.O + go) = v;
            }
        }
        asm volatile("s_waitcnt lgkmcnt(0)" ::: "memory");
    }
}

__device__ __forceinline__ void ring_issue(const int tid, const Job& J, char* shm) {
    const int lane = tid & 63; const int wid = __builtin_amdgcn_readfirstlane(tid >> 6);
    const long rs = J.rs;
    const bf16* Kh = J.K + (long)J.k0 * rs; const bf16* Vh = J.V + (long)J.k0 * rs;
    const unsigned lds0 = (unsigned)(uintptr_t)shm;
    const bf16* ksrc = Kh + (long)lane * rs + wid * 8;
    const bf16* vsrc = Vh + (long)(16 * (wid & 3) + (lane >> 2)) * rs + (wid >> 2) * 32 + (lane & 3) * 8;
    const unsigned kdst = lds0 + LDS_K + wid * 1024, vdst = lds0 + LDS_V + wid * 1024;
    glds16(ksrc, (unsigned)__builtin_amdgcn_readfirstlane(kdst)); glds16(vsrc, (unsigned)__builtin_amdgcn_readfirstlane(vdst));
    glds16(ksrc + (long)KVBLK * rs, (unsigned)__builtin_amdgcn_readfirstlane(kdst + SLOTB)); glds16(ksrc + (long)2 * KVBLK * rs, (unsigned)__builtin_amdgcn_readfirstlane(kdst + 2 * SLOTB));
}
template <bool MOBA, bool FIXED = false> __device__ __forceinline__ void attn_unit(const int tid, const Job& J, char* shm, float& l_out, float& m_out, f32x16 (&o)[2]) {
    const int lane = tid & 63, r32 = lane & 31, hi = lane >> 5; const int wid = __builtin_amdgcn_readfirstlane(tid >> 6);
    const long rs = J.rs; const int NT = J.NT;
    const bf16* Qw = J.Q + (long)(J.q0 + wid * QBLK) * rs;
    const bf16* Kh = J.K + (long)J.k0 * rs; const bf16* Vh = J.V + (long)J.k0 * rs;
    const unsigned lds0 = (unsigned)(uintptr_t)shm;
    float* wsf = (float*)(shm + LDS_WS) + wid * 64;
    const bf16* ksrc = Kh + (long)lane * rs + wid * 8;
    const bf16* vsrc = Vh + (long)(16 * (wid & 3) + (lane >> 2)) * rs + (wid >> 2) * 32 + (lane & 3) * 8;
    const unsigned kdst = lds0 + LDS_K + wid * 1024, vdst = lds0 + LDS_V + wid * 1024;
#define DMA_K(t, slot) glds16(ksrc + (long)(t) * KVBLK * rs, (unsigned)__builtin_amdgcn_readfirstlane(kdst + (slot)))
#define DMA_V(t, slot) glds16(vsrc + (long)(t) * KVBLK * rs, (unsigned)__builtin_amdgcn_readfirstlane(vdst + (slot)))
    const int vb0 = (int)(lds0 + LDS_V) + ((lane >> 4) & 1) * 32 + (lane & 3) * 8 + (4 * hi + ((lane & 15) >> 2)) * 64;
    bf16x8 kf[8];
    const lds_cptr shm3 = (lds_cptr)shm; const lds_cptr kp0 = shm3 + LDS_K + hi * 1024 + r32 * 16; const lds_cptr vp0 = shm3 + LDS_V + ((lane >> 4) & 1) * 32 + (lane & 3) * 8 + (4 * hi + ((lane & 15) >> 2)) * 64;
    bf16x8 qr[4];
#pragma unroll
    for (int d0 = 0; d0 < 4; ++d0) qr[d0] = *reinterpret_cast<const bf16x8*>(&Qw[(long)r32 * rs + d0 * 16 + hi * 8]);
    unsigned sel = 0xffffffffu;
    if (MOBA) {
        const int ob = J.ob; float gt[16];
        { const float* km = J.kmean + ((r32 < 16) ? r32 : 15) * 64 + hi * 8;
          f32x16 g = f32x16{};
#pragma unroll
          for (int d0 = 0; d0 < 4; ++d0) {
              const f32x4 a = *(const f32x4*)(km + d0 * 16), b = *(const f32x4*)(km + d0 * 16 + 4);
              u32x4 H, L;
              H[0] = cvtpk_s(a[0], a[1]); H[1] = cvtpk_s(a[2], a[3]); H[2] = cvtpk_s(b[0], b[1]); H[3] = cvtpk_s(b[2], b[3]);
              L[0] = cvtpk_s(a[0] - __uint_as_float(H[0] << 16), a[1] - __uint_as_float(H[0] & 0xffff0000u)); L[1] = cvtpk_s(a[2] - __uint_as_float(H[1] << 16), a[3] - __uint_as_float(H[1] & 0xffff0000u));
              L[2] = cvtpk_s(b[0] - __uint_as_float(H[2] << 16), b[1] - __uint_as_float(H[2] & 0xffff0000u)); L[3] = cvtpk_s(b[2] - __uint_as_float(H[3] << 16), b[3] - __uint_as_float(H[3] & 0xffff0000u));
              g = __builtin_amdgcn_mfma_f32_32x32x16_bf16(__builtin_bit_cast(bf16x8, H), qr[d0], g, 0, 0, 0);
              g = __builtin_amdgcn_mfma_f32_32x32x16_bf16(__builtin_bit_cast(bf16x8, L), qr[d0], g, 0, 0, 0);
          }
#pragma unroll
          for (int r = 0; r < 8; ++r) { auto rr = __builtin_amdgcn_permlane32_swap(__float_as_uint(g[r]), __float_as_uint(g[r]), false, false);
              gt[crow(r, 0)] = __uint_as_float(rr[0]); gt[crow(r, 1)] = __uint_as_float(rr[1]); }
        }
        sel = 0u;
#pragma unroll
        for (int k = 0; k < 3; ++k) {
            float best = -INFINITY; int bi = -1;
#pragma unroll
            for (int j = 0; j < 15; ++j) { const bool c = (j < ob) && (((sel >> j) & 1u) == 0u) && (gt[j] > best); best = c ? gt[j] : best; bi = c ? j : bi; }
            if (bi >= 0) sel |= 1u << bi;
        }
        sel |= 1u << ob;
    }
    float mhat = 0.f, l_reg = 0.f; o[0] = f32x16{}; o[1] = f32x16{};
    if (FIXED) { float qq = 0.f;
#pragma unroll
        for (int d0 = 0; d0 < 4; ++d0)
#pragma unroll
            for (int e = 0; e < 8; ++e) { const float v = bf2f((unsigned short)qr[d0][e]); qq += v * v; }
        mhat = __builtin_sqrtf(halves_sum(qq)) * J.kbound; }
    bool selc = MOBA ? ((sel & 1u) != 0u) : true;
    f32x16 negm;
    { const float nv = selc ? -mhat : -INFINITY;
#pragma unroll
      for (int r = 0; r < 16; ++r) negm[r] = nv; }
    asm volatile("" : "+v"(negm));
    const int qrel = wid * QBLK + r32;
    const int D0 = MOBA ? (qrel - 4 * hi) : (J.q0 + qrel - J.k0 - 4 * hi);
    const int toff = MOBA ? (NT - 4) : 0, tmlo = MOBA ? (NT - 4) : 0;
    const unsigned mlim = MOBA ? 0x7fffffffu : 128u;
#define CMASK(P0, P1, t) do { if ((t) >= tmlo) bmask(P0, P1, D0 - 64 * ((t) - toff), mlim); } while (0)
#define SETNEG(j) do { if (MOBA) { selc = ((sel >> (j)) & 1u) != 0u; const float nv_ = selc ? -mhat : -INFINITY; _Pragma("unroll") for (int r = 0; r < 16; ++r) negm[r] = nv_; asm volatile("" : "+v"(negm)); } } while (0)
    bool resc = false;
#define RESC() do { if (resc) { asm volatile("s_waitcnt lgkmcnt(0)" ::: "memory"); \
      _Pragma("unroll") for (int d_ = 0; d_ < 2; ++d_) _Pragma("unroll") for (int r = 0; r < 16; ++r) o[d_][r] *= wsf[crow(r, hi)]; } } while (0)
    f32x16 pA0, pA1, pB0, pB1;
    int sl_prev = 0, sl_cur = 0, sl_next = SLOTB;
#define ROT() do { sl_prev = sl_cur; sl_cur = sl_next; sl_next = (sl_next == (NSLOT - 1) * SLOTB) ? 0 : sl_next + SLOTB; } while (0)
    WAIT_BAR(3);
    kload8(kf, kp0);
    pA0 = __builtin_amdgcn_mfma_f32_32x32x16_bf16(kf[0], qr[0], negm, 0, 0, 0); pA1 = __builtin_amdgcn_mfma_f32_32x32x16_bf16(kf[1], qr[0], negm, 0, 0, 0);
    pA0 = __builtin_amdgcn_mfma_f32_32x32x16_bf16(kf[2], qr[1], pA0, 0, 0, 0);  pA1 = __builtin_amdgcn_mfma_f32_32x32x16_bf16(kf[3], qr[1], pA1, 0, 0, 0);
    pA0 = __builtin_amdgcn_mfma_f32_32x32x16_bf16(kf[4], qr[2], pA0, 0, 0, 0);  pA1 = __builtin_amdgcn_mfma_f32_32x32x16_bf16(kf[5], qr[2], pA1, 0, 0, 0);
    pA0 = __builtin_amdgcn_mfma_f32_32x32x16_bf16(kf[6], qr[3], pA0, 0, 0, 0);  pA1 = __builtin_amdgcn_mfma_f32_32x32x16_bf16(kf[7], qr[3], pA1, 0, 0, 0);
    CMASK(pA0, pA1, 0);
    { const float rm = FIXED ? 0.f : rowmax32(pA0, pA1);
      if (!FIXED && __any(rm > (float)THRL)) { const float dl = __builtin_fmaxf(rm, 0.f); mhat += dl;
#pragma unroll
          for (int r = 0; r < 16; ++r) { pA0[r] -= dl; pA1[r] -= dl; }
          const float nv = selc ? -mhat : -INFINITY;
#pragma unroll
          for (int r = 0; r < 16; ++r) negm[r] = nv;
          asm volatile("" : "+v"(negm)); }
#pragma unroll
      for (int r = 0; r < 16; ++r) { pA0[r] = __builtin_amdgcn_exp2f(pA0[r]); pA1[r] = __builtin_amdgcn_exp2f(pA1[r]); } }
    WAIT_BAR(0);
    DMA_K(3, 0); DMA_V(1, SLOTB);
    ROT();
    kload8(kf, kp0 + sl_cur);
    WAIT_BAR(2);
    s16x4 vlo[8], vhi[8]; u32x4 pw0, pw1, pw2, pw3;
#define PKW(P, B) cvtpk_s(P[B], P[B + 1])
#define PAF(k) __builtin_bit_cast(bf16x8, pw##k)
#define VFR(i) (bf16x8){vlo[i][0], vlo[i][1], vlo[i][2], vlo[i][3], vhi[i][0], vhi[i][1], vhi[i][2], vhi[i][3]}
#define PIN(x) asm volatile("" : "+v"(x))
#define GAPA(MF, A0, A1, A2, A3, W0, W1, PW) do { MF; sacc += A0; sacc += A1; sacc += A2; sacc += A3; PIN(sacc); W0; W1; PIN(PW); SBAR(); } while (0)
#define EX(v) __builtin_amdgcn_exp2f(v)
#define GAPB(MF, X, B) do { MF; X[B] = EX(X[B]); X[B + 1] = EX(X[B + 1]); X[B + 2] = EX(X[B + 2]); X[B + 3] = EX(X[B + 3]); PIN(X); SBAR(); } while (0)
#define VRD(i) do { vlo[i] = vtr(vp_ + (((i) >> 2) * 4096 + ((i) & 3) * 1024)); vhi[i] = vtr(vp_ + (((i) >> 2) * 4096 + ((i) & 3) * 1024 + 512)); } while (0)
#define KRD(G, j) do { if (G) { kload2(kf, kp0 + sl_next, j); SBAR(); } } while (0)
#define STEP(C0, C1, P0, P1, t, GK, GV, GL) do { SBAR(); \
    const lds_cptr vp_ = vp0 + sl_prev; \
    VRD(0); SBAR(); float sacc = (P0[0] + P0[1]); \
    GAPA(C0 = __builtin_amdgcn_mfma_f32_32x32x16_bf16(kf[0], qr[0], negm, 0, 0, 0), P0[2], P0[3], P0[4], P0[5],     pw0[0] = PKW(P0, 0), pw0[1] = PKW(P0, 2), pw0); \
    VRD(4); SBAR(); GAPA(C1 = __builtin_amdgcn_mfma_f32_32x32x16_bf16(kf[1], qr[0], negm, 0, 0, 0), P0[6], P0[7], P0[8], P0[9],     pw0[2] = PKW(P0, 4), pw0[3] = PKW(P0, 6), pw0); \
    VRD(1); SBAR(); GAPA(C0 = __builtin_amdgcn_mfma_f32_32x32x16_bf16(kf[2], qr[1], C0, 0, 0, 0),   P0[10], P0[11], P0[12], P0[13], pw1[0] = PKW(P0, 8), pw1[1] = PKW(P0, 10), pw1); \
    VRD(5); SBAR(); GAPA(C1 = __builtin_amdgcn_mfma_f32_32x32x16_bf16(kf[3], qr[1], C1, 0, 0, 0),   P0[14], P0[15], P1[0], P1[1],   pw1[2] = PKW(P0, 12), pw1[3] = PKW(P0, 14), pw1); \
    VRD(2); SBAR(); GAPA(C0 = __builtin_amdgcn_mfma_f32_32x32x16_bf16(kf[4], qr[2], C0, 0, 0, 0),   P1[2], P1[3], P1[4], P1[5],     pw2[0] = PKW(P1, 0), pw2[1] = PKW(P1, 2), pw2); \
    VRD(6); SBAR(); GAPA(C1 = __builtin_amdgcn_mfma_f32_32x32x16_bf16(kf[5], qr[2], C1, 0, 0, 0),   P1[6], P1[7], P1[8], P1[9],     pw2[2] = PKW(P1, 4), pw2[3] = PKW(P1, 6), pw2); \
    VRD(3); SBAR(); GAPA(C0 = __builtin_amdgcn_mfma_f32_32x32x16_bf16(kf[6], qr[3], C0, 0, 0, 0),   P1[10], P1[11], P1[12], P1[13], pw3[0] = PKW(P1, 8), pw3[1] = PKW(P1, 10), pw3); \
    VRD(7); SBAR(); GAPA(C1 = __builtin_amdgcn_mfma_f32_32x32x16_bf16(kf[7], qr[3], C1, 0, 0, 0),   P1[14], P1[15], 0.f, 0.f,       pw3[2] = PKW(P1, 12), pw3[3] = PKW(P1, 14), pw3); \
    l_reg += sacc; \
    if (GK) { DMA_K((t) + 3, sl_cur); } if (GV) { DMA_V((t) + 1, sl_next); } \
    CMASK(C0, C1, t); \
    if (!FIXED) { float a = MX3(C0[0], C0[1], C1[0]), b = MX3(C0[2], C0[3], C1[1]); a = MX3(a, C1[2], C1[3]); \
      _Pragma("unroll") for (int r = 4; r < 16; r += 4) { a = MX3(a, C0[r], C0[r + 1]); b = MX3(b, C0[r + 2], C0[r + 3]); a = MX3(a, C1[r], C1[r + 1]); b = MX3(b, C1[r + 2], C1[r + 3]); } \
      float rm = __builtin_fmaxf(a, b); { auto rr = __builtin_amdgcn_permlane32_swap(__float_as_uint(rm), __float_as_uint(rm), false, false); rm = __builtin_fmaxf(__uint_as_float(rr[0]), __uint_as_float(rr[1])); } \
      resc = false; \
      if (__builtin_expect(__any(rm > (float)THRL), 0)) { const float dl = __builtin_fmaxf(rm, 0.f); mhat += dl; \
        _Pragma("unroll") for (int r = 0; r < 16; ++r) { C0[r] -= dl; C1[r] -= dl; } \
        { const float nv_ = selc ? -mhat : -INFINITY; _Pragma("unroll") for (int r = 0; r < 16; ++r) negm[r] = nv_; } asm volatile("" : "+v"(negm)); \
        const float f = __builtin_amdgcn_exp2f(-dl); l_reg *= f; if (hi == 0) wsf[r32] = f; resc = true; } } \
    SBAR(); \
    GAPB(o[0] = __builtin_amdgcn_mfma_f32_32x32x16_bf16(PAF(0), VFR(0), o[0], 0, 0, 0), C0, 0); \
    GAPB(o[1] = __builtin_amdgcn_mfma_f32_32x32x16_bf16(PAF(0), VFR(4), o[1], 0, 0, 0), C0, 4); \
    KRD(GL, 0); GAPB(o[0] = __builtin_amdgcn_mfma_f32_32x32x16_bf16(PAF(1), VFR(1), o[0], 0, 0, 0), C0, 8); \
    KRD(GL, 1); GAPB(o[1] = __builtin_amdgcn_mfma_f32_32x32x16_bf16(PAF(1), VFR(5), o[1], 0, 0, 0), C0, 12); \
    KRD(GL, 2); GAPB(o[0] = __builtin_amdgcn_mfma_f32_32x32x16_bf16(PAF(2), VFR(2), o[0], 0, 0, 0), C1, 0); \
    KRD(GL, 3); GAPB(o[1] = __builtin_amdgcn_mfma_f32_32x32x16_bf16(PAF(2), VFR(6), o[1], 0, 0, 0), C1, 4); \
    GAPB(o[0] = __builtin_amdgcn_mfma_f32_32x32x16_bf16(PAF(3), VFR(3), o[0], 0, 0, 0), C1, 8); \
    GAPB(o[1] = __builtin_amdgcn_mfma_f32_32x32x16_bf16(PAF(3), VFR(7), o[1], 0, 0, 0), C1, 12); \
    } while (0)
#define NEWBLK(t) do { if (MOBA && (((t) & 3) == 0)) SETNEG((t) >> 2); } while (0)
    int t = 1;
    if (MOBA) {
        for (; t + 5 < NT; t += 2) {
#undef CMASK
#define CMASK(P0, P1, t) do { } while (0)
            STEP(pB0, pB1, pA0, pA1, t, true, true, true);       WAIT_BAR(2); RESC(); ROT(); NEWBLK(t + 1);
            STEP(pA0, pA1, pB0, pB1, t + 1, true, true, true);   WAIT_BAR(2); RESC(); ROT();
        }
    }
#undef CMASK
#define CMASK(P0, P1, t) do { if ((t) >= tmlo) bmask(P0, P1, D0 - 64 * ((t) - toff), mlim); } while (0)
#define ENDW(tt) do { if ((tt) + 3 < NT) { WAIT_BAR(2); } else if ((tt) + 2 < NT) { WAIT_BAR(1); } else { WAIT_BAR(0); } } while (0)
    for (; t + 1 < NT; t += 2) {
        STEP(pB0, pB1, pA0, pA1, t, (t + 3 < NT), (t + 1 < NT), (t + 1 < NT));       ENDW(t);     RESC(); ROT(); NEWBLK(t + 1);
        STEP(pA0, pA1, pB0, pB1, t + 1, (t + 4 < NT), (t + 2 < NT), (t + 2 < NT));   ENDW(t + 1); RESC(); ROT();
    }
    STEP(pB0, pB1, pA0, pA1, NT - 1, false, false, false); RESC();
    { float sacc = pB0[0] + pB0[1];
#pragma unroll
      for (int r = 2; r < 16; ++r) sacc += pB0[r];
#pragma unroll
      for (int r = 0; r < 16; ++r) sacc += pB1[r];
      l_reg += sacc;
      pw0 = (u32x4){PKW(pB0, 0), PKW(pB0, 2), PKW(pB0, 4), PKW(pB0, 6)}; pw1 = (u32x4){PKW(pB0, 8), PKW(pB0, 10), PKW(pB0, 12), PKW(pB0, 14)};
      pw2 = (u32x4){PKW(pB1, 0), PKW(pB1, 2), PKW(pB1, 4), PKW(pB1, 6)}; pw3 = (u32x4){PKW(pB1, 8), PKW(pB1, 10), PKW(pB1, 12), PKW(pB1, 14)};
      SBAR(); pv(o, vb0 + sl_cur, PAF(0), PAF(1), PAF(2), PAF(3)); }
    l_out = l_reg; m_out = mhat;
    asm volatile("s_waitcnt lgkmcnt(0)\n\ts_barrier" ::: "memory");
#undef DMA_K
#undef DMA_V
#undef CMASK
#undef SETNEG
#undef NEWBLK
#undef RESC
#undef ROT
#undef PKW
#undef PAF
#undef VFR
#undef PIN
#undef GAPA
#undef GAPB
#undef EX
#undef VRD
#undef KRD
#undef STEP
#undef ENDW
}

constexpr int BK_K = 0, BK_V = 6 * SLOTB, BK_Q = 12 * SLOTB, BK_WS = 16 * SLOTB, BK_OST = BK_WS + NW * 256, BK_BYTES = BK_OST + NW * 2048;
__device__ __forceinline__ int ring6(int t, int rot) { const int s_ = t + rot; return s_ >= 6 ? s_ - 6 : s_; }
__device__ __forceinline__ void band_issue_kq(const int tid, const Job& J, char* shm, const bool first, const bool cont, const int rot) {
    const int lane = tid & 63; const int wid = __builtin_amdgcn_readfirstlane(tid >> 6);
    const long rs = J.rs; const unsigned lds0 = (unsigned)(uintptr_t)shm;
    const int prow = 8 * wid + (lane >> 3), pch = (lane & 7) ^ (lane >> 3);
    const bf16* ksrc = J.K + (long)(J.q0 - 128 + prow) * rs + pch * 8;
    const unsigned kdst = lds0 + BK_K + wid * 1024;
#pragma unroll
    for (int t = 0; t < 6; ++t) { if (cont && t < 2) continue; const int ts = (first && t < 2) ? 2 : t; glds16(ksrc + (long)ts * KVBLK * rs, (unsigned)__builtin_amdgcn_readfirstlane(kdst + ring6(t, rot) * SLOTB)); }
    const bf16* qsrc = J.Q + (long)(J.q0 + prow) * rs + pch * 8;
    const unsigned qdst = lds0 + BK_Q + wid * 1024;
#pragma unroll
    for (int g = 0; g < 4; ++g) glds16_nt(qsrc + (long)g * KVBLK * rs, (unsigned)__builtin_amdgcn_readfirstlane(qdst + g * SLOTB));
}
__device__ __forceinline__ void band_issue_v(const int tid, const Job& J, char* shm, const bool first, const bool cont, const int rot) {
    const int lane = tid & 63; const int wid = __builtin_amdgcn_readfirstlane(tid >> 6);
    const long rs = J.rs; const unsigned lds0 = (unsigned)(uintptr_t)shm;
    const bf16* vsrc = J.V + (long)(J.q0 - 128 + 16 * (wid & 3) + (lane >> 2)) * rs + (wid >> 2) * 32 + (lane & 3) * 8;
    const unsigned vdst = lds0 + BK_V + wid * 1024;
#pragma unroll
    for (int t = 0; t < 6; ++t) { if (cont && t < 2) continue; const int ts = (first && t < 2) ? 2 : t; glds16(vsrc + (long)ts * KVBLK * rs, (unsigned)__builtin_amdgcn_readfirstlane(vdst + ring6(t, rot) * SLOTB)); }
}
__device__ __forceinline__ void band_pass1(const int tid, char* shm, const bool first, const bool cont  , const int rot, u32x4 (&pw)[5][2], float& l_out, float& m_out) {
    const int lane = tid & 63, r32 = lane & 31, hi = lane >> 5; const int wid = __builtin_amdgcn_readfirstlane(tid >> 6);
    const lds_cptr shm3 = (lds_cptr)shm;
    int foff[4];
#pragma unroll
    for (int d0 = 0; d0 < 4; ++d0) foff[d0] = r32 * 128 + (((2 * d0 + hi) ^ (r32 & 7)) * 16);
    const lds_cptr kp0 = shm3 + BK_K;
    if (cont) asm volatile("s_waitcnt vmcnt(4)" ::: "memory"); else asm volatile("s_waitcnt vmcnt(6)" ::: "memory");
    asm volatile("s_waitcnt lgkmcnt(0)\n\ts_barrier" ::: "memory");
    bf16x8 qr[4];
    { const lds_cptr qp = shm3 + BK_Q + (wid >> 1) * SLOTB + (wid & 1) * 4096;
#pragma unroll
      for (int d0 = 0; d0 < 4; ++d0) qr[d0] = *(const __attribute__((address_space(3))) bf16x8*)(qp + foff[d0]); }
    f32x16 p[5];
#pragma unroll
    for (int j = 0; j < 5; ++j) {
        const int s = wid + j;
        if (first && s < 4) {
#pragma unroll
            for (int r = 0; r < 16; ++r) p[j][r] = -INFINITY;
        } else {
            const lds_cptr kp = kp0 + ring6(s >> 1, rot) * SLOTB + (s & 1) * 4096;
            bf16x8 kf[4];
#pragma unroll
            for (int d0 = 0; d0 < 4; ++d0) kf[d0] = *(const __attribute__((address_space(3))) bf16x8*)(kp + foff[d0]);
            f32x16 q = __builtin_amdgcn_mfma_f32_32x32x16_bf16(kf[0], qr[0], f32x16{}, 0, 0, 0);
            q = __builtin_amdgcn_mfma_f32_32x32x16_bf16(kf[1], qr[1], q, 0, 0, 0);
            q = __builtin_amdgcn_mfma_f32_32x32x16_bf16(kf[2], qr[2], q, 0, 0, 0);
            p[j] = __builtin_amdgcn_mfma_f32_32x32x16_bf16(kf[3], qr[3], q, 0, 0, 0);
        }
    }
#pragma unroll
    for (int r = 0; r < 16; ++r) { if (crow(r, hi) < r32) p[0][r] = -INFINITY; if (crow(r, hi) > r32) p[4][r] = -INFINITY; }
    float rm;
    { float a = MX3(p[0][0], p[0][1], p[0][2]);
#pragma unroll
      for (int j = 0; j < 5; ++j)
#pragma unroll
          for (int r = (j == 0 ? 3 : 0); r + 1 < 16; r += 2) a = MX3(a, p[j][r], p[j][r + 1]);
      a = __builtin_fmaxf(a, p[0][15]);
      auto rr = __builtin_amdgcn_permlane32_swap(__float_as_uint(a), __float_as_uint(a), false, false); rm = __builtin_fmaxf(__uint_as_float(rr[0]), __uint_as_float(rr[1])); }
    float mhat = 0.f;
    if (__builtin_expect(__any(rm > (float)THRL), 0)) { mhat = __builtin_fmaxf(rm, 0.f);
#pragma unroll
        for (int j = 0; j < 5; ++j)
#pragma unroll
            for (int r = 0; r < 16; ++r) p[j][r] -= mhat; }
    float l_reg = 0.f;
#pragma unroll
    for (int j = 0; j < 5; ++j) {
        float sacc = 0.f;
#pragma unroll
        for (int r = 0; r < 16; ++r) { p[j][r] = __builtin_amdgcn_exp2f(p[j][r]); sacc += p[j][r]; }
        l_reg += sacc;
        pw[j][0] = (u32x4){cvtpk_s(p[j][0], p[j][1]), cvtpk_s(p[j][2], p[j][3]), cvtpk_s(p[j][4], p[j][5]), cvtpk_s(p[j][6], p[j][7])};
        pw[j][1] = (u32x4){cvtpk_s(p[j][8], p[j][9]), cvtpk_s(p[j][10], p[j][11]), cvtpk_s(p[j][12], p[j][13]), cvtpk_s(p[j][14], p[j][15])};
    }
    l_out = l_reg; m_out = mhat;
    asm volatile("s_waitcnt lgkmcnt(0)\n\ts_barrier" ::: "memory");
}
__device__ __forceinline__ void band_pass2(const int tid, char* shm, const bool first, const bool last_unit, const bool cont_next  , const int rot, const u32x4 (&pw)[5][2], f32x16 (&o)[2]) {
    const int lane = tid & 63, hi = lane >> 5; const int wid = __builtin_amdgcn_readfirstlane(tid >> 6);
    const lds_cptr shm3 = (lds_cptr)shm;
    const lds_cptr vp0 = shm3 + BK_V + ((lane >> 4) & 1) * 32 + (lane & 3) * 8 + (4 * hi + ((lane & 15) >> 2)) * 64;
    if (last_unit) asm volatile("s_waitcnt vmcnt(0)" ::: "memory"); else if (cont_next) asm volatile("s_waitcnt vmcnt(8)" ::: "memory"); else asm volatile("s_waitcnt vmcnt(10)" ::: "memory");
    asm volatile("s_waitcnt lgkmcnt(0)\n\ts_barrier" ::: "memory");
    o[0] = f32x16{}; o[1] = f32x16{};
#pragma unroll
    for (int j = 0; j < 5; ++j) {
        const int s = wid + j;
        if (first && s < 4) continue;
        const lds_cptr vp = vp0 + ring6(s >> 1, rot) * SLOTB + (s & 1) * 2048;
#pragma unroll
        for (int d0 = 0; d0 < 2; ++d0) {
            const s16x4 l0 = vtr(vp + d0 * 4096), h0 = vtr(vp + d0 * 4096 + 512), l1 = vtr(vp + d0 * 4096 + 1024), h1 = vtr(vp + d0 * 4096 + 1024 + 512);
            const bf16x8 v0 = (bf16x8){l0[0], l0[1], l0[2], l0[3], h0[0], h0[1], h0[2], h0[3]}, v1 = (bf16x8){l1[0], l1[1], l1[2], l1[3], h1[0], h1[1], h1[2], h1[3]};
            o[d0] = __builtin_amdgcn_mfma_f32_32x32x16_bf16(__builtin_bit_cast(bf16x8, pw[j][0]), v0, o[d0], 0, 0, 0);
            o[d0] = __builtin_amdgcn_mfma_f32_32x32x16_bf16(__builtin_bit_cast(bf16x8, pw[j][1]), v1, o[d0], 0, 0, 0);
        }
    }
    asm volatile("s_waitcnt lgkmcnt(0)\n\ts_barrier" ::: "memory");
}
#undef SBAR
#undef WAIT_BAR
#undef MX3
}

constexpr int NWAVES = 8;
constexpr size_t MiB = 1u << 20;
constexpr size_t WS_CTL = 0, CTL_ZERO_BYTES = 1 * MiB;
constexpr size_t WS_ROPE = 1 * MiB;
constexpr size_t WS_SS = 2 * MiB;
constexpr size_t SS_B_OFF = (size_t)MTOK * 4;
constexpr size_t WS_KMEAN = 4 * MiB;
constexpr size_t WS_STAT = 5 * MiB;
constexpr size_t WS_EDGE = 16 * MiB;
constexpr size_t WS_W = 32 * MiB;
constexpr size_t W_QKVA = 0, W_OA = W_QKVA + (size_t)9216 * 1024, W_UP0 = W_OA + (size_t)1024 * 1024, W_DN0 = W_UP0 + (size_t)NUP * 1024,
                 W_QKVB = W_DN0 + (size_t)1024 * DFF, W_OB = W_QKVB + (size_t)3072 * 1024, W_UP1 = W_OB + (size_t)1024 * 1024, W_DN1 = W_UP1 + (size_t)NUP * 1024,
                 W_END = W_DN1 + (size_t)1024 * DFF;
static_assert(W_END * 2 <= 64 * MiB, "weights fit 64 MiB");
constexpr size_t WS_XN = 96 * MiB;
constexpr size_t WS_Q = 160 * MiB, WS_K = 224 * MiB, WS_V = 288 * MiB, WS_ATT = 352 * MiB;
constexpr size_t WS_HH = 160 * MiB;
constexpr size_t WS_END = 416 * MiB;
static_assert(WS_HH + (size_t)MTOK * DFF * 2 <= WS_ATT, "Hh overlay");

constexpr int RING_BYTES = 131072, XLDS_OFF = RING_BYTES, XLDS_BYTES = XL_END, LDS_BYTES = 163840;
static_assert(attn::LDS_BYTES <= RING_BYTES && attn::BK_BYTES <= LDS_BYTES - 64 && XLDS_OFF + XLDS_BYTES <= LDS_BYTES, "LDS map");

struct Args { const float* in[15]; float* out; unsigned char* ws; int ph_lo, ph_hi; };
static_assert(sizeof(Args) == 15 * 8 + 8 + 8 + 8, "no padding");

__device__ __forceinline__ unsigned f2bf(float f) { unsigned u = __builtin_bit_cast(unsigned, f); return (u + 0x7fffu + ((u >> 16) & 1u)) >> 16; }
__device__ __forceinline__ unsigned pk2(float lo, float hi) { return f2bf(lo) | (f2bf(hi) << 16); }
__device__ __forceinline__ float wave_sum(float v) {
#pragma unroll
    for (int o = 1; o < 64; o <<= 1) v += __shfl_xor(v, o);
    return v;
}
__device__ __forceinline__ int dinv(int d) { return (d < 4) ? d : (d < 8) ? d + 4 : (d < 12) ? d - 4 : d; }
__device__ __forceinline__ int tileperm(int which_is_qk, int h, int d) { const int p = (which_is_qk && d < 16) ? dinv(d) : d; return (h >> 2) * 256 + (p >> 5) * 128 + (h & 3) * 32 + (p & 31); }
template <int KIND> __device__ __forceinline__ int permrow(int n) {
    if (KIND == 1) { const int which = n / 3072, g = (n % 3072) / 1024, h = (n % 1024) / 64, d = n % 64; return g * 3072 + which * 1024 + tileperm(which < 2, h, d); }
    if (KIND == 2) { const int which = n / 1024, h = (n % 1024) / 64, d = n % 64; return which * 1024 + tileperm(which < 2, h, d); }
    if (KIND == 3) { const int isval = n >= DFF, j = n - isval * DFF; return 256 * (j >> 7) + 128 * isval + (j & 127); }
    return n;
}
template <int KIND> __device__ __forceinline__ void transpose_item(const float* W, int K, int N, bf16* WT, LAS float* scr, int item, int lane, const float* gk = nullptr) {
    const int nblk = N / 32, kb = item / nblk, nb = item % nblk, k0 = 64 * kb, n0 = 32 * nb;
    float wv[32];
#pragma unroll
    for (int i = 0; i < 32; ++i) wv[i] = __builtin_nontemporal_load(&W[(size_t)(k0 + 2 * i + (lane >> 5)) * N + n0 + (lane & 31)]);
#pragma unroll
    for (int i = 0; i < 32; ++i) scr[(2 * i + (lane >> 5)) * 33 + (lane & 31)] = wv[i];
    asm volatile("s_waitcnt lgkmcnt(0)" ::: "memory");
    const int c = lane & 7;
    f32x4 ga = (f32x4){1.f, 1.f, 1.f, 1.f}, gb = ga;
    if (gk) { ga = *(const f32x4*)(gk + k0 + 8 * c); gb = *(const f32x4*)(gk + k0 + 8 * c + 4); }
#pragma unroll
    for (int j = 0; j < 4; ++j) { const int n = (lane >> 3) + 8 * j; const LAS float* s = scr + (8 * c) * 33 + n;
        u32x4 o; o.x = pk2(s[0 * 33] * ga[0], s[1 * 33] * ga[1]); o.y = pk2(s[2 * 33] * ga[2], s[3 * 33] * ga[3]); o.z = pk2(s[4 * 33] * gb[0], s[5 * 33] * gb[1]); o.w = pk2(s[6 * 33] * gb[2], s[7 * 33] * gb[3]);
        *(u32x4*)(WT + (size_t)permrow<KIND>(n0 + n) * K + k0 + 8 * c) = o; }
    asm volatile("s_waitcnt lgkmcnt(0)" ::: "memory");
}

template <class T> __device__ __forceinline__ T* uptr(T* p) {
    const unsigned long long v = (unsigned long long)p; const unsigned lo = __builtin_amdgcn_readfirstlane((unsigned)v), hi = __builtin_amdgcn_readfirstlane((unsigned)(v >> 32));
    return (T*)(__attribute__((address_space(1))) T*)(((unsigned long long)hi << 32) | lo); }
struct Frame {
    LAS unsigned char* lds; char* lds_generic;
    int tid, wave, vcu, bx, G;
    unsigned long long karg; float* out; unsigned char* ws;
    __device__ __forceinline__ const float* inp(int k) const {
        typedef unsigned long long __attribute__((address_space(4))) const* kp_t;
        return (const float*)(const __attribute__((address_space(1))) float*)(((kp_t)karg)[k]); }
};
#define FLANE (F.tid & 63)

__device__ __forceinline__ void phase_prologue(Frame& F) {
    LAS float* scr = (LAS float*)(F.lds + F.wave * 16384);
    const int gw = F.vcu * NWAVES + F.wave, NGW = F.G * NWAVES;
    bf16* WB = (bf16*)(F.ws + WS_W);
    constexpr int I_QKVA = 16 * (9216 / 32), I_O = 16 * 32, I_UP = 16 * (NUP / 32), I_DN = (DFF / 64) * 32, I_QKVB = 16 * (3072 / 32);
    constexpr int NITEMS = I_QKVA + I_O + I_UP + I_DN + I_QKVB + I_O + I_UP + I_DN;
    for (int it = gw; it < NITEMS; it += NGW) {
        int r = it;
        if (r < I_QKVA) { transpose_item<1>(F.inp(2), 1024, 9216, WB + W_QKVA, scr, r, FLANE, F.inp(1)); continue; } r -= I_QKVA;
        if (r < I_O) { transpose_item<0>(F.inp(5), 1024, 1024, WB + W_OA, scr, r, FLANE); continue; } r -= I_O;
        if (r < I_UP) { transpose_item<3>(F.inp(11), 1024, NUP, WB + W_UP0, scr, r, FLANE, F.inp(10)); continue; } r -= I_UP;
        if (r < I_DN) { transpose_item<0>(F.inp(14), DFF, 1024, WB + W_DN0, scr, r, FLANE); continue; } r -= I_DN;
        if (r < I_QKVB) { transpose_item<2>(F.inp(6), 1024, 3072, WB + W_QKVB, scr, r, FLANE, F.inp(1) + 1024); continue; } r -= I_QKVB;
        if (r < I_O) { transpose_item<0>(F.inp(9), 1024, 1024, WB + W_OB, scr, r, FLANE); continue; } r -= I_O;
        if (r < I_UP) { transpose_item<3>(F.inp(11) + (size_t)1024 * NUP, 1024, NUP, WB + W_UP1, scr, r, FLANE, F.inp(10) + 1024); continue; } r -= I_UP;
        transpose_item<0>(F.inp(14) + (size_t)DFF * 1024, DFF, 1024, WB + W_DN1, scr, r, FLANE);
    }
    { float* km = (float*)(F.ws + WS_KMEAN); for (int i = (F.vcu * NWAVES + F.wave) * 64 + FLANE; i < BATCH * NHEADS * 16 * 64; i += F.G * NWAVES * 64) km[i] = 0.f; }
    {
        float* cosT = (float*)(F.ws + WS_ROPE); float* sinT = cosT + SEQ * 8;
        const int gt = (F.vcu * NWAVES + F.wave) * 64 + FLANE;
        if (gt < SEQ * 8) { const int pos = gt >> 3, i = gt & 7;
            const float inv = (i == 0) ? 1.0f : (i == 1) ? 1.939227432e-01f : (i == 2) ? 3.760603070e-02f : (i == 3) ? 7.292664610e-03f : (i == 4) ? 1.414213562e-03f : (i == 5) ? 2.742481884e-04f : (i == 6) ? 5.318295734e-05f : 1.031338525e-05f;
            const float ang = (float)pos * inv; cosT[gt] = cosf(ang); sinT[gt] = sinf(ang); }
    }
    {
        const float* x = F.inp(0); bf16* XN = (bf16*)(F.ws + WS_XN); float* SS = (float*)(F.ws + WS_SS);
        for (int m0 = gw * 4; m0 < MTOK; m0 += NGW * 4) {
            f32x4 v[4][4]; float s[4];
#pragma unroll
            for (int r = 0; r < 4; ++r) { const f32x4* xr = (const f32x4*)(x + (size_t)(m0 + r) * DMODEL) + FLANE;
#pragma unroll
                for (int j = 0; j < 4; ++j) v[r][j] = __builtin_nontemporal_load(&xr[64 * j]); }
#pragma unroll
            for (int r = 0; r < 4; ++r) { s[r] = (dot4(v[r][0]) + dot4(v[r][1])) + (dot4(v[r][2]) + dot4(v[r][3])); s[r] = wave_sum(s[r]); }
#pragma unroll
            for (int r = 0; r < 4; ++r) {
                unsigned long long* o8 = (unsigned long long*)(XN + (size_t)(m0 + r) * DMODEL) + FLANE;
#pragma unroll
                for (int j = 0; j < 4; ++j) { const f32x4 y = v[r][j]; o8[64 * j] = (unsigned long long)pk2(y[0], y[1]) | ((unsigned long long)pk2(y[2], y[3]) << 32); }
                if (FLANE == 0) { SS[m0 + r] = s[r]; SS[MTOK + m0 + r] = 0.f; }
            }
        }
    }
}

template <bool KMSUM> __device__ __forceinline__ void phase_gemm_qkv(Frame& F, const bf16* Wt, const float* qg, const float* kg) {
    Wt = uptr(Wt); qg = uptr(qg); kg = uptr(kg);
    pg8::Gemm g{(const bf16*)(F.ws + WS_XN), Wt, MTOK, 3072, 1024}; pg8::StaticOrder S; S.init(MTOK, 3072, F.G, F.bx);
    const float* cosT = (const float*)(F.ws + WS_ROPE);
    EpiQKV<KMSUM> E{(float*)(F.ws + WS_KMEAN), (bf16*)(F.ws + WS_Q), (WS_K - WS_Q) / 2, (const float*)(F.ws + WS_SS), qg, kg, cosT, cosT + SEQ * 8};
    static_assert(WS_V - WS_K == WS_K - WS_Q, "Q|K|V equally spaced");
    pg8::gemm_phase<EpiQKV<KMSUM>, pg8::StaticOrder>(F.tid, F.lds, F.lds + XLDS_OFF, g, S, E);
}
__device__ __forceinline__ void fixup_tile(Frame& F, const int pm, const float* cw, const float* cb);
template <bool RES_F32, bool OUT_F32, bool FIX = false> __device__ __forceinline__ void phase_gemm_res(Frame& F, const bf16* A, const bf16* Wt, int K, const void* resid, void* out, bool has_ss, size_t ssoff, const float* cw = nullptr, const float* cb = nullptr) {
    A = uptr(A); Wt = uptr(Wt); resid = (const void*)uptr((const char*)resid); out = (void*)uptr((char*)out); K = __builtin_amdgcn_readfirstlane(K);
    pg8::Gemm g{A, Wt, MTOK, 1024, K}; pg8::StaticOrder S; S.init(MTOK, 1024, F.G, F.bx);
    if (FIX) {
        const int gt = (F.vcu * NWAVES + F.wave) * 64 + FLANE, NT = F.G * NWAVES * 64;
        { float* ssb = (float*)(F.ws + WS_SS + SS_B_OFF); for (int i = gt; i < MTOK; i += NT) ssb[i] = 0.f; }
        cw = uptr(cw); cb = uptr(cb);
        for (int i = 0; ; ++i) { pg8::Unit u; if (!S.next(i, u)) break; fixup_tile(F, u.pm, cw, cb); }
        asm volatile("s_waitcnt vmcnt(0)" ::: "memory"); __syncthreads();
    }
    EpiRes<RES_F32, OUT_F32> E{resid, out, has_ss ? (float*)(F.ws + WS_SS + ssoff) : nullptr};
    pg8::gemm_phase<EpiRes<RES_F32, OUT_F32>, pg8::StaticOrder>(F.tid, F.lds, F.lds + XLDS_OFF, g, S, E);
}
__device__ __forceinline__ void phase_gemm_up(Frame& F, const bf16* Wt, const float* cw, const float* cb) {
    Wt = uptr(Wt); cw = uptr(cw); cb = uptr(cb);
    pg8::Gemm g{(const bf16*)(F.ws + WS_XN), Wt, MTOK, NUP, 1024}; pg8::StaticOrder S; S.init(MTOK, NUP, F.G, F.bx, 4);
    { const int gt = (F.vcu * NWAVES + F.wave) * 64 + FLANE, NT = F.G * NWAVES * 64; float* ssa = (float*)(F.ws + WS_SS); for (int i = gt; i < MTOK; i += NT) ssa[i] = 0.f; }
    EpiUpConv E{(const float*)(F.ws + WS_SS + SS_B_OFF), cw, cb, (bf16*)(F.ws + WS_HH), (float*)(F.ws + WS_EDGE)};
    pg8::gemm_phase<EpiUpConv, pg8::StaticOrder>(F.tid, F.lds, F.lds + XLDS_OFF, g, S, E);
}
__device__ __forceinline__ void fixup_tile(Frame& F, const int pm, const float* cw, const float* cb) {
    if ((pm & 15) == 0) return;
    const float* edge = (const float*)(F.ws + WS_EDGE); bf16* Hh = (bf16*)(F.ws + WS_HH);
    constexpr int NJ = DFF / 4;
    for (int it = F.tid; it < NJ; it += NWAVES * 64) {
        const int j = it * 4;
        const int pg = 256 * (j >> 7) + (j & 127);
        f32x4 uc[2][2];
#pragma unroll
        for (int bj = 0; bj < 2; ++bj) {
            const int lc = bj * DFF + j, pc = pg + bj * 128;
            const f32x4 w0 = *(const f32x4*)(cw + lc), w1 = *(const f32x4*)(cw + NUP + lc), w2 = *(const f32x4*)(cw + 2 * NUP + lc), bb = *(const f32x4*)(cb + lc);
            const float* ep = edge + (size_t)(pm - 1) * EDGE_ROWS * NUP + pc; const float* ec = edge + (size_t)pm * EDGE_ROWS * NUP + pc;
            const f32x4 u254 = *(const f32x4*)(ep + 2 * (size_t)NUP), u255 = *(const f32x4*)(ep + 3 * (size_t)NUP), u0 = *(const f32x4*)(ec), u1 = *(const f32x4*)(ec + NUP);
            uc[bj][0] = bb + w0 * u254 + w1 * u255 + w2 * u0;
            uc[bj][1] = bb + w0 * u255 + w1 * u0 + w2 * u1;
        }
#pragma unroll
        for (int r = 0; r < 2; ++r) {
            u32x2 w; w.x = pg8::cvt_pk_bf16(silu_mul(uc[0][r][0], uc[1][r][0]), silu_mul(uc[0][r][1], uc[1][r][1]));
            w.y = pg8::cvt_pk_bf16(silu_mul(uc[0][r][2], uc[1][r][2]), silu_mul(uc[0][r][3], uc[1][r][3]));
            *(u32x2*)(Hh + (size_t)(pm * 256 + r) * DFF + j) = w;
        }
    }
}
__device__ __forceinline__ void phase_kmean(Frame& F) {
    const bf16* Kb = (const bf16*)(F.ws + WS_K); float* KM = (float*)(F.ws + WS_KMEAN);
    const int gw = F.vcu * NWAVES + F.wave, NGW = F.G * NWAVES;
    { float* ssb = (float*)(F.ws + WS_SS + SS_B_OFF); for (int i = gw * 64 + FLANE; i < MTOK; i += NGW * 64) ssb[i] = 0.f; }
    for (int task = gw; task < BATCH * NHEADS * 16; task += NGW) {
        const int b = task >> 8, h = (task >> 4) & 15, n = task & 15;
        const int sub = FLANE >> 3, ch = FLANE & 7;
        const bf16* base = Kb + (size_t)(b * SEQ + n * 256 + sub) * DMODEL + h * 64 + ch * 8;
        float a[8];
#pragma unroll
        for (int e = 0; e < 8; ++e) a[e] = 0.f;
#pragma unroll 8
        for (int i = 0; i < 32; ++i) {
            const u32x4 v = *(const u32x4*)(base + (size_t)i * 8 * DMODEL);
#pragma unroll
            for (int e = 0; e < 4; ++e) { a[2 * e] += __uint_as_float(v[e] << 16); a[2 * e + 1] += __uint_as_float(v[e] & 0xffff0000u); }
        }
#pragma unroll
        for (int e = 0; e < 8; ++e) { a[e] += __shfl_xor(a[e], 8); a[e] += __shfl_xor(a[e], 16); a[e] += __shfl_xor(a[e], 32); a[e] *= (1.0f / 256.0f); }
        if (sub == 0) { float* o = KM + (size_t)task * 64 + ch * 8; *(f32x4*)o = (f32x4){a[0], a[1], a[2], a[3]}; *(f32x4*)(o + 4) = (f32x4){a[4], a[5], a[6], a[7]}; }
    }
}
template <int OUT> __device__ __forceinline__ void band_job(Frame& F, int i, int dil, int gidx, attn::Job& J, bool& first) {
    const bf16* Q = (const bf16*)(F.ws + WS_Q); const bf16* K = (const bf16*)(F.ws + WS_K); const bf16* V = (const bf16*)(F.ws + WS_V);
    bf16* num0 = (bf16*)F.out; bf16* num1 = (bf16*)F.out + (size_t)MTOK * DMODEL;
    float* st0 = (float*)(F.ws + WS_STAT); float* st1 = (float*)(F.ws + WS_STAT) + (size_t)MTOK * 32;
    const int u = F.vcu * 8 + i;
    const int nblk = 16 / dil;
    const int bh = u >> 4, b = bh >> 4, h = bh & 15, sub = u & 15, r = sub / nblk, blk = sub % nblk;
    const size_t tok0 = (size_t)b * SEQ + r;
    J.Q = Q + tok0 * DMODEL + h * 64; J.K = K + tok0 * DMODEL + h * 64; J.V = V + tok0 * DMODEL + h * 64;
    J.rs = (long)dil * DMODEL; J.q0 = 256 * blk; J.k0 = J.q0 - 128; J.NT = 6; J.ob = 0; J.kmean = nullptr;
    J.srs = (long)dil * 32;
    J.O = ((OUT == attn::OUT_MERGE) ? (bf16*)(F.ws + WS_ATT) : (gidx == 0 ? num0 : num1)) + tok0 * DMODEL + h * 64;
    J.stat = (OUT == attn::OUT_PART) ? (gidx == 0 ? st0 : st1) + (tok0 * 16 + h) * 2 : nullptr;
    J.num0 = num0 + tok0 * DMODEL + h * 64; J.num1 = num1 + tok0 * DMODEL + h * 64;
    J.stat0 = st0 + (tok0 * 16 + h) * 2; J.stat1 = st1 + (tok0 * 16 + h) * 2;
    first = (blk == 0);
}
template <int OUT> __device__ __forceinline__ void phase_band(Frame& F, int dil, int gidx) {
    if (F.vcu * 8 >= BATCH * NHEADS * 16) return;
    attn::Job J; bool first;
    band_job<OUT>(F, 0, dil, gidx, J, first);
    bool cont = false; int rot = 0;
    { int t_ = F.tid; asm volatile("" : "+v"(t_)); attn::band_issue_kq(t_, J, F.lds_generic, first, false, 0); attn::band_issue_v(t_, J, F.lds_generic, first, false, 0); }
    for (int i = 0; i < 8; ++i) {
        int t_ = F.tid; asm volatile("" : "+v"(t_));
        float l_reg, mhat; attn::f32x16 o[2]; attn::u32x4 pw[5][2];
        attn::band_pass1(t_, F.lds_generic, first, cont, rot, pw, l_reg, mhat);
        attn::Job Jn = J; bool firstn = first;
        bool contn = false; int rotn = 0;
        if (i + 1 < 8) { band_job<OUT>(F, i + 1, dil, gidx, Jn, firstn);
            contn = !firstn;
            rotn = contn ? (rot >= 2 ? rot - 2 : rot + 4) : 0;
            attn::band_issue_kq(t_, Jn, F.lds_generic, firstn, contn, rotn); }
        attn::band_pass2(t_, F.lds_generic, first, i == 7, contn, rot, pw, o);
        if (i + 1 < 8) attn::band_issue_v(t_, Jn, F.lds_generic, firstn, contn, rotn);
        { const int lane = t_ & 63, wid = __builtin_amdgcn_readfirstlane(t_ >> 6);
          attn::unit_epilogue<OUT>(J, (float*)(F.lds_generic + attn::BK_WS) + wid * 64, (unsigned short*)(F.lds_generic + attn::BK_OST) + wid * 1024, wid, lane, l_reg, mhat, o); }
        J = Jn; first = firstn; cont = contn; rot = rotn;
    }
}
__device__ __forceinline__ void moba_job(Frame& F, int i, attn::Job& J) {
    const bf16* Q = (const bf16*)(F.ws + WS_Q); const bf16* K = (const bf16*)(F.ws + WS_K); const bf16* V = (const bf16*)(F.ws + WS_V);
    const int bh = F.vcu >> 1, b = bh >> 4, h = bh & 15;
    const int s = (F.vcu & 1) * 4 + (i >> 1), ob = (i & 1) ? 15 - s : s;
    const size_t tok0 = (size_t)b * SEQ;
    J.Q = Q + tok0 * DMODEL + h * 64; J.K = K + tok0 * DMODEL + h * 64; J.V = V + tok0 * DMODEL + h * 64;
    J.rs = DMODEL; J.q0 = 256 * ob; J.k0 = 0; J.NT = 4 * (ob + 1); J.ob = ob; J.kmean = (const float*)(F.ws + WS_KMEAN) + (size_t)bh * 16 * 64;
    J.O = (bf16*)(F.ws + WS_ATT) + tok0 * DMODEL + h * 64; J.stat = nullptr; J.num0 = J.num1 = nullptr; J.stat0 = J.stat1 = nullptr; J.srs = 32;
}
__device__ __forceinline__ void phase_moba(Frame& F) {
    if ((F.vcu >> 1) >= BATCH * NHEADS) return;
    float gq = __builtin_fabsf(F.inp(7)[FLANE]), gk = __builtin_fabsf(F.inp(8)[FLANE]);
#pragma unroll
    for (int o_ = 1; o_ < 64; o_ <<= 1) { gq = __builtin_fmaxf(gq, __shfl_xor(gq, o_)); gk = __builtin_fmaxf(gk, __shfl_xor(gk, o_)); }
    const float kbound = 8.0f * 1.02f * gk;
    const bool fixed_ok = (QSCALE * 8.0f * 1.02f * gq * kbound) <= 60.0f;
    attn::Job J; moba_job(F, 0, J); J.kbound = kbound;
    { int t_ = F.tid; asm volatile("" : "+v"(t_)); attn::ring_issue(t_, J, F.lds_generic); }
    for (int i = 0; i < 8; ++i) {
        int t_ = F.tid; asm volatile("" : "+v"(t_));
        float l_reg, mhat; attn::f32x16 o[2];
        if (fixed_ok) attn::attn_unit<true, true>(t_, J, F.lds_generic, l_reg, mhat, o); else attn::attn_unit<true, false>(t_, J, F.lds_generic, l_reg, mhat, o);
        attn::Job Jn = J;
        if (i + 1 < 8) { moba_job(F, i + 1, Jn); attn::ring_issue(t_, Jn, F.lds_generic); }
        { const int lane = t_ & 63, wid = __builtin_amdgcn_readfirstlane(t_ >> 6);
          attn::unit_epilogue<attn::OUT_FINAL>(J, (float*)(F.lds_generic + attn::LDS_WS) + wid * 64, (unsigned short*)(F.lds_generic + attn::LDS_OST) + wid * 1024, wid, lane, l_reg, mhat, o); }
        J = Jn;
    }
}

#define XB_TMO      128
#define XB_XCNT(j)  (256  + 64 * (j))
#define XB_XSUB(j)  (1280 + 64 * (j))
#define XB_XGEN(j)  (2304 + 64 * (j))
#define XB_TOP      3328
#define XB_TOPGEN   3392
#define XCD_BAR_WORDS 3456
#define XB_SPIN_CAP (1u << 18)

__device__ __forceinline__ unsigned xb_ld(unsigned* p)              { return __hip_atomic_load(p, __ATOMIC_RELAXED, __HIP_MEMORY_SCOPE_AGENT); }
__device__ __forceinline__ unsigned xb_add(unsigned* p, unsigned v) { return __hip_atomic_fetch_add(p, v, __ATOMIC_RELAXED, __HIP_MEMORY_SCOPE_AGENT); }
__device__ __forceinline__ unsigned xb_xcc_id() { return (unsigned)__builtin_amdgcn_s_getreg((3 << 11) | 20) & 0xFu; }
#define XB_SPIN(cond, bar) do { unsigned _sp = 0; while (cond) { __builtin_amdgcn_s_sleep(1); \
    if ((++_sp & 255u) == 0u) { if (xb_ld(&(bar)[XB_TMO])) break; if (_sp > XB_SPIN_CAP) { atomicAdd(&(bar)[XB_TMO], 1u); break; } } } } while (0)

struct XcdBarrier {
    unsigned* bar; unsigned x;
    volatile LAS unsigned* st;
};

__device__ __forceinline__ XcdBarrier xcd_barrier_post(unsigned* bar, volatile LAS unsigned* st, int tid) {
    XcdBarrier b; b.bar = bar; b.x = xb_xcc_id(); b.st = st;
    if (tid == 0) (void)xb_add(&bar[XB_XCNT(b.x)], 1u);
    return b;
}
__device__ __forceinline__ void xcd_barrier_complete(unsigned* bar, unsigned x, unsigned& nloc, unsigned& nx) {
    const unsigned G = gridDim.x * gridDim.y * gridDim.z;
    unsigned sum, cnt, mine, sp = 0u;
    for (;;) {
        sum = 0u; cnt = 0u; mine = 0u;
#pragma unroll
        for (unsigned j = 0; j < 16; ++j) { const unsigned c = xb_ld(&bar[XB_XCNT(j)]); sum += c; cnt += (c > 0u) ? 1u : 0u; mine = (j == x) ? c : mine; }
        if (sum == G) break;
        __builtin_amdgcn_s_sleep(1);
        if ((++sp & 255u) == 0u) { if (xb_ld(&bar[XB_TMO])) break; if (sp > XB_SPIN_CAP) { atomicAdd(&bar[XB_TMO], 1u); break; } }
    }
    nloc = mine > 0u ? mine : 1u; nx = cnt > 0u ? cnt : 1u;
}

__device__ __forceinline__ void xcd_barrier(const XcdBarrier& b, int tid) {
    asm volatile("s_waitcnt vmcnt(0)" ::: "memory");
    __syncthreads();
    if (tid == 0) {
        unsigned* bar = b.bar;
        __builtin_amdgcn_s_waitcnt(0);
        unsigned nloc = b.st[0], nx = b.st[1];
        if (nloc == 0u) { xcd_barrier_complete(bar, b.x, nloc, nx); b.st[0] = nloc; b.st[1] = nx; }
        const unsigned old = xb_add(&bar[XB_XSUB(b.x)], 1u);
        const unsigned gen = old / nloc;
        if (old + 1u == (gen + 1u) * nloc) {
            __builtin_amdgcn_fence(__ATOMIC_RELEASE, "agent");
            asm volatile("s_waitcnt vmcnt(0)" ::: "memory");
            const unsigned og = xb_add(&bar[XB_TOP], 1u);
            const unsigned tg = og / nx;
            if (og + 1u == (tg + 1u) * nx) xb_add(&bar[XB_TOPGEN], 1u);
            else XB_SPIN(xb_ld(&bar[XB_TOPGEN]) == tg, bar);
            __builtin_amdgcn_fence(__ATOMIC_ACQUIRE, "agent");
            xb_add(&bar[XB_XGEN(b.x)], 1u);
            asm volatile("s_waitcnt vmcnt(0)" ::: "memory");
        } else {
            XB_SPIN(xb_ld(&bar[XB_XGEN(b.x)]) == gen, bar);
            __builtin_amdgcn_fence(__ATOMIC_ACQUIRE, "agent");
            asm volatile("s_waitcnt vmcnt(0)" ::: "memory");
        }
    }
    __syncthreads();
}

constexpr int N_PHASES = 18;
constexpr int CW_BAR = 4096;
constexpr int BARST_OFF = XLDS_OFF + XLDS_BYTES;
static_assert(BARST_OFF + 64 <= LDS_BYTES && (CW_BAR + XCD_BAR_WORDS) * 4 <= (int)CTL_ZERO_BYTES, "barrier state placement");
__device__ __forceinline__ void frame_setup(Frame& F, int wave0, unsigned char* lds) {
    { int t_ = wave0 * 64 + fresh_lane(); asm volatile("" : "+v"(t_)); F.tid = t_; }
    { int b_ = blockIdx.x, g_ = gridDim.x; asm volatile("" : "+s"(b_), "+s"(g_)); F.bx = b_; F.G = g_; }
    F.wave = __builtin_amdgcn_readfirstlane(F.tid >> 6);
    F.vcu = (F.G % 8 == 0) ? (F.bx % 8) * (F.G / 8) + F.bx / 8 : F.bx;
    { unsigned long long k_ = (unsigned long long)__builtin_amdgcn_kernarg_segment_ptr(); asm volatile("" : "+s"(k_)); F.karg = k_; F.out = (float*)F.inp(15); F.ws = (unsigned char*)F.inp(16); }
    F.lds = (LAS unsigned char*)lds; F.lds_generic = (char*)lds;
}
template <int PH> __device__ __forceinline__ void run_phase(Frame& F) {
    const bf16* WB = (const bf16*)(F.ws + WS_W);
    const bf16* ATT = (const bf16*)(F.ws + WS_ATT); const bf16* HH = (const bf16*)(F.ws + WS_HH);
    constexpr int L = (PH >= 11) ? 1 : 0;
    if constexpr (PH == 0) phase_prologue(F);
    else if constexpr (PH == 1 || PH == 3 || PH == 5) { constexpr int g = PH >> 1; phase_gemm_qkv<false>(F, WB + W_QKVA + (size_t)g * 3072 * 1024, F.inp(3) + 64 * g, F.inp(4) + 64 * g); }
    else if constexpr (PH == 11) phase_gemm_qkv<true>(F, WB + W_QKVB, F.inp(7), F.inp(8));
    else if constexpr (PH == 2) phase_band<attn::OUT_PART>(F, 1, 0);
    else if constexpr (PH == 4) phase_band<attn::OUT_PART>(F, 4, 1);
    else if constexpr (PH == 6) phase_band<attn::OUT_MERGE>(F, 16, 2);
    else if constexpr (PH == 7) phase_gemm_res<false, false>(F, ATT, WB + W_OA, 1024, F.ws + WS_XN, F.ws + WS_XN, true, SS_B_OFF);
    else if constexpr (PH == 10) phase_gemm_res<false, false, true>(F, HH, WB + W_DN0, DFF, F.ws + WS_XN, F.ws + WS_XN, true, 0, F.inp(12), F.inp(13));
    else if constexpr (PH == 14) phase_gemm_res<false, false>(F, ATT, WB + W_OB, 1024, F.ws + WS_XN, F.ws + WS_XN, true, SS_B_OFF);
    else if constexpr (PH == 17) phase_gemm_res<false, true, true>(F, HH, WB + W_DN1, DFF, F.ws + WS_XN, F.out, false, 0, F.inp(12) + (size_t)3 * NUP, F.inp(13) + (size_t)NUP);
    else if constexpr (PH == 8 || PH == 15) phase_gemm_up(F, WB + (L ? W_UP1 : W_UP0), F.inp(12) + (size_t)L * 3 * NUP, F.inp(13) + (size_t)L * NUP);
    else if constexpr (PH == 13) phase_moba(F);
}
template <unsigned PHASE_MASK> __global__ void __launch_bounds__(NWAVES * 64, 2) fwd_kernel(const Args args) {
    extern __shared__ __attribute__((aligned(16))) unsigned char lds[];
    const int lo = args.ph_lo, hi = args.ph_hi;
    const int wave0 = __builtin_amdgcn_readfirstlane(threadIdx.x >> 6);
    constexpr bool FUSED = (PHASE_MASK & (PHASE_MASK - 1u)) != 0u;
    volatile LAS unsigned* bst = (volatile LAS unsigned*)((LAS unsigned char*)lds + BARST_OFF);
    XcdBarrier xb; xb.bar = nullptr; xb.x = 0; xb.st = bst;
    if constexpr (FUSED) {
        if (threadIdx.x < 16) bst[threadIdx.x] = 0u;
        __syncthreads();
        xb = xcd_barrier_post((unsigned*)(args.ws + WS_CTL) + CW_BAR, bst, (int)threadIdx.x);
    }
#define PHASE_FENCE() asm volatile("; phase boundary" ::: "v8", "v9", "v10", "v11", "v12", "v13", "v14", "v15", "v16", "v17", "v18", "v19", "v20", "v21", "v22", "v23", "v24", "v25", "v26", "v27", "v28", "v29", "v30", "v31", "v32", "v33", "v34", "v35", "v36", "v37", "v38", "v39", "v40", "v41", "v42", "v43", "v44", "v45", "v46", "v47", "v48", "v49", "v50", "v51", "v52", "v53", "v54", "v55", "v56", "v57", "v58", "v59", "v60", "v61", "v62", "v63", "v64", "v65", "v66", "v67", "v68", "v69", "v70", "v71", "v72", "v73", "v74", "v75", "v76", "v77", "v78", "v79", "v80", "v81", "v82", "v83", "v84", "v85", "v86", "v87", "v88", "v89", "v90", "v91", "v92", "v93", "v94", "v95", "v96", "v97", "v98", "v99", "v100", "v101", "v102", "v103", "v104", "v105", "v106", "v107", "v108", "v109", "v110", "v111", "v112", "v113", "v114", "v115", "v116", "v117", "v118", "v119", "v120", "v121", "v122", "v123", "v124", "v125", "v126", "v127", "v128", "v129", "v130", "v131", "v132", "v133", "v134", "v135", "v136", "v137", "v138", "v139", "v140", "v141", "v142", "v143", "v144", "v145", "v146", "v147", "v148", "v149", "v150", "v151", "v152", "v153", "v154", "v155", "v156", "v157", "v158", "v159", "v160", "v161", "v162", "v163", "v164", "v165", "v166", "v167", "v168", "v169", "v170", "v171", "v172", "v173", "v174", "v175", "v176", "v177", "v178", "v179", "v180", "v181", "v182", "v183", "v184", "v185", "v186", "v187", "v188", "v189", "v190", "v191", "v192", "v193", "v194", "v195", "v196", "v197", "v198", "v199", "v200", "v201", "v202", "v203", "v204", "v205", "v206", "v207", "v208", "v209", "v210", "v211", "v212", "v213", "v214", "v215", "v216", "v217", "v218", "v219", "v220", "v221", "v222", "v223", "v224", "v225", "v226", "v227", "v228", "v229", "v230", "v231", "v232", "v233", "v234", "v235", "v236", "v237", "v238", "v239", "v240", "v241", "v242", "v243", "v244", "v245", "v246", "v247", "v248", "v249", "v250", "v251", "v252", "v253", "v254", "v255", "s36", "s37", "s38", "s39", "s40", "s41", "s42", "s43", "s44", "s45", "s46", "s47", "s48", "s49", "s50", "s51", "s52", "s53", "s54", "s55", "s56", "s57", "s58", "s59", "s60", "s61", "s62", "s63", "s64", "s65", "s66", "s67", "s68", "s69", "s70", "s71", "s72", "s73", "s74", "s75", "s76", "s77", "s78", "s79", "s80", "s81", "s82", "s83", "s84", "s85", "s86", "s87", "s88", "s89", "s90", "s91", "s92", "s93", "s94", "s95", "s96", "s97", "s98", "s99", "s100", "s101", "memory")
#define TID_NOW() (wave0 * 64 + fresh_lane())
#ifndef PROBE_DUP
#define PROBE_DUP 0u
#endif
#ifndef MK_CG_FIRST
#define MK_CG_FIRST 0
#endif
#define PHASE(k) if constexpr (((PHASE_MASK >> (k)) & 1u) != 0u) { PHASE_FENCE(); if (lo <= (k) && (k) < hi) { { Frame F; frame_setup(F, wave0, lds); run_phase<(k)>(F); } \
        if constexpr (((PROBE_DUP >> (k)) & 1u) != 0u) { Frame F; frame_setup(F, wave0, lds); run_phase<(k)>(F); } \
        if constexpr (FUSED && (k) + 1 < N_PHASES) { if ((k) + 1 < hi) { if (MK_CG_FIRST && (k) == 0) cg::this_grid().sync(); else xcd_barrier(xb, TID_NOW()); } } } }
    PHASE(0) PHASE(1) PHASE(2) PHASE(3) PHASE(4) PHASE(5) PHASE(6) PHASE(7) PHASE(8) PHASE(10) PHASE(11) PHASE(13) PHASE(14) PHASE(15) PHASE(17)
#undef TID_NOW
#undef PHASE
}

constexpr unsigned PM_ALL = 0x3ffffu;
typedef void (*kern_t)(const Args);
#ifndef MK_SPLIT
#define MK_SPLIT 0
#endif
#if MK_SPLIT
static kern_t kernel_of_phase(int ph) {
    switch (ph) {
#define KP(k) case k: return fwd_kernel<(1u << k)>;
    KP(0) KP(1) KP(2) KP(3) KP(4) KP(5) KP(6) KP(7) KP(8) KP(9) KP(10) KP(11) KP(12) KP(13) KP(14) KP(15) KP(16)
#undef KP
    default: return fwd_kernel<(1u << 17)>;
    }
}
#endif
extern "C" void kernel_launch(void* const* d_in, const int* in_sizes, int n_in, void* d_out, int out_size, void* d_ws, size_t ws_size, hipStream_t stream) {
    static int grid = 0;
    if (grid == 0) {
        if (n_in != 15 || out_size != MTOK * DMODEL || ws_size < WS_END) { fprintf(stderr, "kernel_launch: unexpected shapes (n_in %d, out %d, ws %zu)\n", n_in, out_size, ws_size); grid = -1; return; }
        int dev = 0, cus = 0;
        if (hipGetDevice(&dev) != hipSuccess || hipDeviceGetAttribute(&cus, hipDeviceAttributeMultiprocessorCount, dev) != hipSuccess) { grid = -1; return; }
#if MK_SPLIT
        for (int ph = 0; ph < N_PHASES; ++ph)
            if (hipFuncSetAttribute((const void*)kernel_of_phase(ph), hipFuncAttributeMaxDynamicSharedMemorySize, LDS_BYTES) != hipSuccess) { fprintf(stderr, "kernel_launch: hipFuncSetAttribute failed\n"); grid = -1; return; }
#else
        if (hipFuncSetAttribute((const void*)fwd_kernel<PM_ALL>, hipFuncAttributeMaxDynamicSharedMemorySize, LDS_BYTES) != hipSuccess) { fprintf(stderr, "kernel_launch: hipFuncSetAttribute failed\n"); grid = -1; return; }
        int per_cu = 0;
        if (hipOccupancyMaxActiveBlocksPerMultiprocessor(&per_cu, (const void*)fwd_kernel<PM_ALL>, NWAVES * 64, LDS_BYTES) != hipSuccess || per_cu < 1) fprintf(stderr, "kernel_launch: occupancy query says %d blocks/CU\n", per_cu);
        (void)hipGetLastError();
#endif
        grid = cus;
    }
    if (grid < 0) return;
    Args a{};
    for (int i = 0; i < 15; ++i) a.in[i] = (const float*)d_in[i];
    a.out = (float*)d_out; a.ws = (unsigned char*)d_ws;
#if MK_SPLIT
    for (int ph = 0; ph < N_PHASES; ++ph) { a.ph_lo = ph; a.ph_hi = ph + 1; hipLaunchKernelGGL(kernel_of_phase(ph), dim3(grid), dim3(NWAVES * 64), LDS_BYTES, stream, a); }
#else
    a.ph_lo = 0; a.ph_hi = N_PHASES;
    if (hipMemsetAsync((char*)d_ws + WS_CTL, 0, 65536, stream) != hipSuccess) { fprintf(stderr, "kernel_launch: memset failed\n"); return; }
    void* kargs[] = {&a};
    hipError_t e = hipLaunchCooperativeKernel((const void*)fwd_kernel<PM_ALL>, dim3(grid), dim3(NWAVES * 64), kargs, LDS_BYTES, stream);
    if (e != hipSuccess) fprintf(stderr, "cooperative launch failed: %s (grid %d)\n", hipGetErrorString(e), grid);
#endif
}
```
